# Optimizing an MI355X kernel written in HIP

```python
import jax, jax.numpy as jnp
from jax import lax
import numpy as np

D_MODEL = 2048
BATCH = 1
SEQ = 8192
DEPTH = 1

D_MIX = 2 * D_MODEL
D_A = D_MIX // 2
CHUNK_A = 128
N_GROUPS_A = 16
D_HEAD_A = D_A // N_GROUPS_A
D_SSM = D_MIX - D_A
SSM_HEAD_DIM = 64
N_SSM_HEADS = D_SSM // SSM_HEAD_DIM
N_SSM_GROUPS = 8
HEADS_PER_GROUP = N_SSM_HEADS // N_SSM_GROUPS
D_STATE = 128
SSM_CONV = 4
SSD_CHUNK = 128
D_XBC = D_SSM + 2 * N_SSM_GROUPS * D_STATE
D_IN = 2 * D_A + D_SSM + D_XBC + N_SSM_HEADS
D_FF = 5632
FFN_CONV = 3
D_PLE = 256
EPS = 1e-6

kernel_name = "hybrid_gmlp_ssd_convffn_ple"


def rms_norm(x, g):
    xf = x.astype(jnp.float32)
    y = xf * lax.rsqrt(jnp.mean(xf * xf, axis=-1, keepdims=True) + EPS)
    return (y * g.astype(jnp.float32)).astype(x.dtype)


def causal_dwconv(x, w, b):
    k_w = w.shape[0]
    s = x.shape[1]
    xp = jnp.pad(x, ((0, 0), (k_w - 1, 0), (0, 0)))
    y = b
    for k in range(k_w):
        y = y + xp[:, k:k + s] * w[k]
    return y


def gmlp_chunk_mixer(uv, ln_g, ln_b, w_s, b_s):
    bn, s, _ = uv.shape
    uv = jax.nn.gelu(uv)
    u, v = jnp.split(uv, 2, axis=-1)
    v = v.reshape(bn, s // CHUNK_A, CHUNK_A, N_GROUPS_A, D_HEAD_A)
    vf = v.astype(jnp.float32)
    mu = jnp.mean(vf, axis=-1, keepdims=True)
    var = jnp.mean(jnp.square(vf - mu), axis=-1, keepdims=True)
    g = ln_g.reshape(N_GROUPS_A, D_HEAD_A).astype(jnp.float32)
    bb = ln_b.reshape(N_GROUPS_A, D_HEAD_A).astype(jnp.float32)
    vn = ((vf - mu) * lax.rsqrt(var + EPS) * g + bb).astype(uv.dtype)
    mask = jnp.tril(jnp.ones((CHUNK_A, CHUNK_A), dtype=bool))
    ws = jnp.where(mask[None], w_s, jnp.zeros_like(w_s))
    sg = jnp.einsum('gts,bcsgd->bctgd', ws, vn) + b_s.T[:, :, None]
    return u * sg.reshape(bn, s, D_A)


def ssd_chunked(xs, dt, a, bm, cm, d_skip):
    bn, s, _ = xs.shape
    nc = s // SSD_CHUNK
    shp = (bn, nc, SSD_CHUNK, N_SSM_GROUPS, HEADS_PER_GROUP)
    x5 = xs.reshape(shp + (SSM_HEAD_DIM,))
    dt5 = dt.reshape(shp)
    b5 = bm.reshape(bn, nc, SSD_CHUNK, N_SSM_GROUPS, D_STATE)
    c5 = cm.reshape(bn, nc, SSD_CHUNK, N_SSM_GROUPS, D_STATE)
    a_dt = dt5 * a.reshape(N_SSM_GROUPS, HEADS_PER_GROUP)
    x_dt = x5 * dt5[..., None]
    a_cs = jnp.cumsum(a_dt, axis=2)
    a_t = jnp.moveaxis(a_cs, 2, -1)
    diff = a_t[..., :, None] - a_t[..., None, :]
    mask = jnp.tril(jnp.ones((SSD_CHUNK, SSD_CHUNK), dtype=bool))
    l_mat = jnp.exp(jnp.where(mask, diff, -jnp.inf))
    scores = jnp.einsum('bclgn,bcsgn->bcgls', c5, b5)
    y_diag = jnp.einsum('bcgrls,bcsgrp->bclgrp', scores[:, :, :, None] * l_mat, x_dt)
    decay_states = jnp.exp(a_cs[:, :, -1:] - a_cs)
    states = jnp.einsum('bclgn,bclgrp->bcgrpn', b5, x_dt * decay_states[..., None])
    chunk_decay = jnp.exp(a_cs[:, :, -1])

    def step(h, inp):
        dec, st = inp
        return dec[..., None, None] * h + st, h

    h0 = jnp.zeros((bn, N_SSM_GROUPS, HEADS_PER_GROUP, SSM_HEAD_DIM, D_STATE), jnp.float32)
    _, h_in = lax.scan(step, h0, (jnp.moveaxis(chunk_decay, 1, 0), jnp.moveaxis(states, 1, 0)))
    h_in = jnp.moveaxis(h_in, 0, 1)
    y_off = jnp.einsum('bclgn,bcgrpn->bclgrp', c5, h_in) * jnp.exp(a_cs)[..., None]
    y = y_diag + y_off + d_skip.reshape(N_SSM_GROUPS, HEADS_PER_GROUP, 1) * x5
    return y.reshape(bn, s, D_SSM)


def mamba2_mixer(z, xbc, dt_raw, conv_w, conv_b, dt_bias, a_log, d_skip, norm_g):
    bn, s, _ = z.shape
    xbc = jax.nn.silu(causal_dwconv(xbc, conv_w, conv_b))
    n_bc = N_SSM_GROUPS * D_STATE
    xs = xbc[..., :D_SSM].astype(jnp.float32)
    bm = xbc[..., D_SSM:D_SSM + n_bc].astype(jnp.float32)
    cm = xbc[..., D_SSM + n_bc:].astype(jnp.float32)
    dt = jax.nn.softplus(dt_raw.astype(jnp.float32) + dt_bias.astype(jnp.float32))
    a = -jnp.exp(a_log.astype(jnp.float32))
    y = ssd_chunked(xs, dt, a, bm, cm, d_skip.astype(jnp.float32))
    y = y * jax.nn.silu(z.astype(jnp.float32))
    yg = y.reshape(bn, s, N_SSM_GROUPS, D_SSM // N_SSM_GROUPS)
    yg = yg * lax.rsqrt(jnp.mean(yg * yg, axis=-1, keepdims=True) + EPS)
    y = yg.reshape(bn, s, D_SSM) * norm_g.astype(jnp.float32)
    return y.astype(z.dtype)


def setup_inputs(seed: int = 0) -> dict:
    key = jax.random.key(seed)
    ks = jax.random.split(key, 32)
    f32 = jnp.float32
    nrm = lambda k, shape, scale: jax.random.normal(k, shape, f32) * scale
    gain = lambda k, n: 1.0 + 0.05 * jax.random.normal(k, (DEPTH, n), f32)
    dt0 = jnp.exp(jax.random.uniform(ks[5], (DEPTH, N_SSM_HEADS), f32,
                                     np.log(1e-3).astype(np.float32), np.log(1e-1).astype(np.float32)))
    dt_bias = dt0 + jnp.log(-jnp.expm1(-dt0))
    return {
        "x": jax.random.normal(ks[0], (BATCH, SEQ, D_MODEL), f32),
        "p": jax.random.normal(ks[1], (DEPTH, BATCH, SEQ, D_PLE), f32),
        "norm_mix_g": gain(ks[2], D_MODEL),
        "w_in": nrm(ks[3], (DEPTH, D_MODEL, D_IN), D_MODEL ** -0.5),
        "ln_a_g": gain(ks[4], D_A),
        "ln_a_b": nrm(ks[6], (DEPTH, D_A), 0.02),
        "w_s": nrm(ks[7], (DEPTH, N_GROUPS_A, CHUNK_A, CHUNK_A), CHUNK_A ** -0.5),
        "b_s": 1.0 + nrm(ks[8], (DEPTH, N_GROUPS_A, CHUNK_A), 0.1),
        "norm_a_g": gain(ks[9], D_A),
        "conv_ssm_w": nrm(ks[10], (DEPTH, SSM_CONV, D_XBC), SSM_CONV ** -0.5),
        "conv_ssm_b": nrm(ks[11], (DEPTH, D_XBC), 0.02),
        "dt_bias": dt_bias,
        "a_log": jnp.log(jax.random.uniform(ks[12], (DEPTH, N_SSM_HEADS), f32, 1.0, 16.0)),
        "d_skip": 1.0 + nrm(ks[13], (DEPTH, N_SSM_HEADS), 0.1),
        "ssm_norm_g": gain(ks[14], D_SSM),
        "w_out": nrm(ks[15], (DEPTH, D_MIX, D_MODEL), D_MIX ** -0.5),
        "norm_ffn_g": gain(ks[16], D_MODEL),
        "w_up": nrm(ks[17], (DEPTH, D_MODEL, 2 * D_FF), D_MODEL ** -0.5),
        "conv_ffn_w": nrm(ks[18], (DEPTH, FFN_CONV, 2 * D_FF), FFN_CONV ** -0.5),
        "conv_ffn_b": nrm(ks[19], (DEPTH, 2 * D_FF), 0.02),
        "w_down": nrm(ks[20], (DEPTH, D_FF, D_MODEL), D_FF ** -0.5),
        "norm_ple_g": gain(ks[21], D_MODEL),
        "w_ple_gate": nrm(ks[22], (DEPTH, D_MODEL, D_MODEL), D_MODEL ** -0.5),
        "w_ple": nrm(ks[23], (DEPTH, D_PLE, D_MODEL), D_PLE ** -0.5),
        "norm_final_g": 1.0 + 0.05 * jax.random.normal(ks[24], (D_MODEL,), f32),
    }


def reference(x, p, norm_mix_g, w_in, ln_a_g, ln_a_b, w_s, b_s, norm_a_g,
              conv_ssm_w, conv_ssm_b, dt_bias, a_log, d_skip, ssm_norm_g, w_out,
              norm_ffn_g, w_up, conv_ffn_w, conv_ffn_b, w_down,
              norm_ple_g, w_ple_gate, w_ple, norm_final_g):
    h = x
    o_z = 2 * D_A
    o_xbc = o_z + D_SSM
    o_dt = o_xbc + D_XBC
    for i in range(DEPTH):
        a = rms_norm(h, norm_mix_g[i])
        proj = a @ w_in[i]
        y_a = gmlp_chunk_mixer(proj[..., :o_z], ln_a_g[i], ln_a_b[i], w_s[i], b_s[i])
        y_a = rms_norm(y_a, norm_a_g[i])
        y_b = mamba2_mixer(proj[..., o_z:o_xbc], proj[..., o_xbc:o_dt], proj[..., o_dt:],
                           conv_ssm_w[i], conv_ssm_b[i], dt_bias[i], a_log[i], d_skip[i],
                           ssm_norm_g[i])
        h = h + jnp.concatenate([y_a, y_b], axis=-1) @ w_out[i]
        f = rms_norm(h, norm_ffn_g[i])
        hid = causal_dwconv(f @ w_up[i], conv_ffn_w[i], conv_ffn_b[i])
        gate, up = jnp.split(hid, 2, axis=-1)
        h = h + (jax.nn.silu(gate) * up) @ w_down[i]
        g_ple = jax.nn.sigmoid(rms_norm(h, norm_ple_g[i]) @ w_ple_gate[i])
        h = h + g_ple * (p[i] @ w_ple[i])
    return rms_norm(h, norm_final_g)
```

```cpp
#include <hip/hip_runtime.h>
#include <hip/hip_cooperative_groups.h>
#include <cstdio>
#include <cstdint>
namespace cg = cooperative_groups;

#ifndef MK_LAUNCHES
#define MK_LAUNCHES 1
#endif

#define LAS __attribute__((address_space(3)))
typedef unsigned short bf16_t;
typedef short bf16x8 __attribute__((ext_vector_type(8)));
typedef float f32x4 __attribute__((ext_vector_type(4)));
typedef float f32x2 __attribute__((ext_vector_type(2)));
typedef float f32x16 __attribute__((ext_vector_type(16)));
typedef unsigned u32x4 __attribute__((ext_vector_type(4)));
typedef unsigned u32x2 __attribute__((ext_vector_type(2)));

constexpr int S = 8192, D = 2048, DIN = 10272, DA = 2048, DSSM = 2048, DXBC = 4096, NH = 32, NGRP = 8, NST = 128;
constexpr int DFF = 5632, DPLE = 256, DMIX = 4096, NCH = 64, CH = 128, NGA = 16;
constexpr float EPS = 1e-6f;
constexpr int NPH = 10;

constexpr size_t MiB = 1u << 20;
constexpr size_t WS_WUP = 1 * MiB;
constexpr size_t WS_WDN = 45 * MiB;
constexpr size_t WS_WPG = 67 * MiB;
constexpr size_t WS_WPLE = 75 * MiB;
constexpr size_t WS_WIN = 76 * MiB;
constexpr size_t WS_WOUT = 117 * MiB;
constexpr size_t WS_UV = 133 * MiB;
constexpr size_t WS_ACT = 133 * MiB;
constexpr size_t WS_ZS = 197 * MiB;
constexpr size_t WS_XBC = 229 * MiB;
constexpr size_t WS_HG = 229 * MiB;
constexpr size_t WS_H2G = 229 * MiB;
constexpr size_t WS_A = 293 * MiB;
constexpr size_t WS_ST = 293 * MiB;
constexpr size_t WS_E = 293 * MiB;
constexpr size_t WS_P16 = 325 * MiB;
constexpr size_t WS_DT = 329 * MiB;
constexpr size_t WS_SSQA = 330 * MiB;
constexpr size_t WS_SSQ1 = 331 * MiB;
constexpr size_t WS_SSQ2 = WS_SSQ1 + 256 * 1024;
constexpr size_t WS_SSQ3 = WS_SSQ2 + 256 * 1024;
constexpr size_t WS_CDEC = WS_SSQ3 + 256 * 1024;
constexpr size_t WS_GSCR = 332 * MiB;
constexpr size_t WS_END = 348 * MiB;

constexpr int LDS_BYTES = 163840;

struct Params {
    const float* in[25];
    float* out;
    unsigned char* ws;
};

__device__ __forceinline__ unsigned f2bf(float f) { unsigned u = __builtin_bit_cast(unsigned, f); return (u + 0x7fffu + ((u >> 16) & 1u)) >> 16; }
__device__ __forceinline__ unsigned pk2(float lo, float hi) { return f2bf(lo) | (f2bf(hi) << 16); }
__device__ __forceinline__ float bf2f(unsigned short b) { return __builtin_bit_cast(float, ((unsigned)b) << 16); }
__device__ __forceinline__ float bflo(unsigned w) { return __builtin_bit_cast(float, w << 16); }
__device__ __forceinline__ float bfhi(unsigned w) { return __builtin_bit_cast(float, w & 0xffff0000u); }
__device__ __forceinline__ float fast_sigmoid(float x) { return __builtin_amdgcn_rcpf(1.0f + __builtin_amdgcn_exp2f(-1.4426950408889634f * x)); }
__device__ __forceinline__ float silu_f(float x) { return x * fast_sigmoid(x); }
__device__ __forceinline__ float gelu_tanh_f(float x) { const float t = x + 0.044715f * x * x * x; return x * __builtin_amdgcn_rcpf(1.0f + __builtin_amdgcn_exp2f(-2.3022081986f * t)); }
__device__ __forceinline__ float wave_sum(float v) {
#pragma unroll
    for (int o = 1; o < 64; o <<= 1) v += __shfl_xor(v, o);
    return v;
}

namespace pg8 {
constexpr int BM = 256, BK = 64, HALF = 128, HTB = HALF * BK * 2, STAGE_BYTES = 8 * HTB, NXCD = 8, WGM = 8;
__host__ __device__ __forceinline__ int lds_byte(int r, int c) { const int st = (r >> 4) * 2 + (c >> 5), rr = r & 15, cc = c & 31, ob = rr * 64 + cc * 2; return st * 1024 + (ob ^ (((ob >> 9) & 1) << 5)); }
__host__ __device__ __forceinline__ void stage_rc(int b, int& R, int& C) { const int st = b / 1024, sb = b % 1024, swz = sb ^ (((sb >> 9) & 1) << 5); R = (st >> 1) * 16 + swz / 64; C = (st & 1) * 32 + (swz % 64) / 2; }
__host__ __device__ __forceinline__ int perm32(int rho) { const int n = rho >> 4, i = rho & 15; return 8 * (i >> 2) + 4 * n + (i & 3); }

struct Unit { int pm, pn; };
struct Gemm { const bf16_t* A; const bf16_t* Bt; int K; };

struct StaticOrder {
    int nM, nN, nwg, G, c;
    __device__ void init(int nM_, int nN_, int G_, int c_) { nM = nM_; nN = nN_; nwg = nM * nN; G = G_; c = c_; }
    __device__ bool next(int i, Unit& u) const {
        const long L = (long)i * G + c; if (L >= nwg) return false;
        int wgid = (int)L; { const int q = nwg / NXCD, r = nwg % NXCD, xcd = wgid % NXCD, off = wgid / NXCD; wgid = (xcd < r ? xcd * (q + 1) : r * (q + 1) + (xcd - r) * q) + off; }
        const int nig = WGM * nN, gid = wgid / nig, fm = gid * WGM, gsz = (nM - fm) < WGM ? (nM - fm) : WGM;
        u.pm = fm + ((wgid % nig) % gsz); u.pn = (wgid % nig) / gsz; return true;
    }
};

__device__ __forceinline__ unsigned cvt_pk_bf16(float lo, float hi) { unsigned r; asm volatile("v_cvt_pk_bf16_f32 %0, %1, %2" : "=v"(r) : "v"(lo), "v"(hi)); return r; }

template <class Epi, bool ALIGN_EPI, bool SP2>
__device__ __forceinline__ void gemm_phase(LAS unsigned char* lds, const Gemm g, const StaticOrder& S, const Epi& E) {
    const int tid = threadIdx.x, wid = __builtin_amdgcn_readfirstlane(tid >> 6), lane = tid & 63, wr = wid >> 2, wc = wid & 3, fr = lane & 15, fq = lane >> 4;
    const int K = g.K, nt = K / BK;
    unsigned voffA[2], voffB[2];
#pragma unroll
    for (int i = 0; i < 2; ++i) { int R, C; stage_rc(tid * 16 + i * 8192, R, C); const int Rb = (R & ~31) + perm32(R & 31);
        voffA[i] = (unsigned)(R * K + C) * 2u; voffB[i] = (unsigned)(Rb * K + C) * 2u; }
    const size_t kstep = (size_t)(BK * 2);
    const size_t hstep = (size_t)HALF * K * 2;
    const size_t tstep = 2 * hstep;
    const unsigned ldsw = (unsigned)wid * 1024u;
    const int aoff = lds_byte(wr * 64 + fr, fq * 8), boff = lds_byte(wc * 32 + fr, fq * 8);
#define PG8_SA(b, h) (((b) * 2 + (h)) * HTB)
#define PG8_SB(b, h) ((4 + (b) * 2 + (h)) * HTB)
#define PG8_STAGE(bufoff, gbase, voff) do { _Pragma("unroll") for (int _i = 0; _i < 2; ++_i) \
        __builtin_amdgcn_global_load_lds((const unsigned*)((const char*)(gbase) + (voff)[_i]), (LAS unsigned*)(lds + (bufoff) + ldsw + _i * 8192), 16, 0, 0); } while (0)
#define PG8_LDA(dst, b, h) do { _Pragma("unroll") for (int m = 0; m < 4; ++m) _Pragma("unroll") for (int k = 0; k < 2; ++k) dst[m][k] = *(const LAS bf16x8*)(lds + PG8_SA(b, h) + aoff + m * 2048 + k * 1024); } while (0)
#define PG8_LDB(dst, b, h) do { _Pragma("unroll") for (int n = 0; n < 2; ++n) _Pragma("unroll") for (int k = 0; k < 2; ++k) dst[n][k] = *(const LAS bf16x8*)(lds + PG8_SB(b, h) + boff + n * 2048 + k * 1024); } while (0)
#define PG8_MMA(ai, bj, At, Bt) do { __builtin_amdgcn_s_setprio(1); _Pragma("unroll") for (int m = 0; m < 4; ++m) _Pragma("unroll") for (int n = 0; n < 2; ++n) _Pragma("unroll") for (int k = 0; k < 2; ++k) \
        acc[ai][bj][m][n] = __builtin_amdgcn_mfma_f32_16x16x32_bf16(Bt[n][k], At[m][k], acc[ai][bj][m][n], 0, 0, 0); __builtin_amdgcn_s_setprio(0); } while (0)
#define PG8_WAIT_V(n) asm volatile("s_waitcnt vmcnt(" #n ")" ::: "memory")
#define PG8_WAIT_L(n) asm volatile("s_waitcnt lgkmcnt(" #n ")" ::: "memory")
#define PG8_BAR __builtin_amdgcn_s_barrier()
#define PG8_SCHED __builtin_amdgcn_sched_barrier(0)
    Unit cur, nxt; int ui = 0;
    if (!S.next(0, cur)) return;
    f32x4 acc[2][2][4][2];
#pragma unroll
    for (int a = 0; a < 2; ++a)
#pragma unroll
        for (int b = 0; b < 2; ++b)
#pragma unroll
            for (int m = 0; m < 4; ++m)
#pragma unroll
                for (int n = 0; n < 2; ++n) acc[a][b][m][n] = (f32x4){0.f, 0.f, 0.f, 0.f};
    bf16x8 At[4][2], B0[2][2], B1[2][2];
    const char* cA = (const char*)g.A + (size_t)cur.pm * tstep; const char* cB = (const char*)g.Bt + (size_t)cur.pn * tstep;
    if constexpr (SP2) {
        PG8_STAGE(PG8_SB(0, 0), cB, voffB); PG8_STAGE(PG8_SB(0, 1), cB + hstep, voffB); PG8_STAGE(PG8_SA(0, 0), cA, voffA); PG8_STAGE(PG8_SA(0, 1), cA + hstep, voffA);
        if (wr == 1) PG8_BAR;
        PG8_WAIT_V(2); PG8_BAR;
        PG8_STAGE(PG8_SB(1, 0), cB + kstep, voffB); PG8_STAGE(PG8_SA(1, 0), cA + kstep, voffA); PG8_STAGE(PG8_SB(1, 1), cB + hstep + kstep, voffB);
        PG8_WAIT_V(6); PG8_BAR;
    } else {
        PG8_STAGE(PG8_SB(0, 0), cB, voffB); PG8_STAGE(PG8_SA(0, 0), cA, voffA); PG8_STAGE(PG8_SB(0, 1), cB + hstep, voffB); PG8_STAGE(PG8_SA(0, 1), cA + hstep, voffA);
        if (wr == 1) PG8_BAR;
        PG8_WAIT_V(4); PG8_BAR;
        PG8_STAGE(PG8_SB(1, 0), cB + kstep, voffB); PG8_STAGE(PG8_SA(1, 0), cA + kstep, voffA); PG8_STAGE(PG8_SB(1, 1), cB + hstep + kstep, voffB);
        PG8_WAIT_V(6); PG8_BAR;
    }
    for (;;) {
        const bool has_next = S.next(ui + 1, nxt);
        const char* nA = has_next ? (const char*)g.A + (size_t)nxt.pm * tstep : cA; const char* nB = has_next ? (const char*)g.Bt + (size_t)nxt.pn * tstep : cB;
#pragma nounroll
        for (int t = 0; t < nt; t += 2) {
            const bool last = (t == nt - 2);
            const char* a1 = cA + (size_t)(t + 1) * kstep;
            const char* a2 = last ? nA : cA + (size_t)(t + 2) * kstep; const char* b2 = last ? nB : cB + (size_t)(t + 2) * kstep;
            const char* a3 = a2 + kstep; const char* b3 = b2 + kstep;
            if constexpr (SP2) {
            PG8_LDB(B0, 0, 0); PG8_LDB(B1, 0, 1); PG8_SCHED; PG8_LDA(At, 0, 0); PG8_STAGE(PG8_SA(1, 1), a1 + hstep, voffA);
            PG8_WAIT_V(8); PG8_WAIT_L(0); PG8_BAR; PG8_MMA(0, 0, At, B0); PG8_MMA(0, 1, At, B1); PG8_BAR; PG8_SCHED;
            PG8_LDA(At, 0, 1); PG8_STAGE(PG8_SB(0, 0), b2, voffB); PG8_STAGE(PG8_SB(0, 1), b2 + hstep, voffB); PG8_STAGE(PG8_SA(0, 0), a2, voffA);
            PG8_WAIT_V(8); PG8_WAIT_L(0); PG8_BAR; PG8_MMA(1, 0, At, B0); PG8_MMA(1, 1, At, B1); PG8_BAR; PG8_SCHED;
            PG8_LDB(B0, 1, 0); PG8_LDB(B1, 1, 1); PG8_SCHED; PG8_LDA(At, 1, 0); PG8_STAGE(PG8_SA(0, 1), a2 + hstep, voffA);
            PG8_WAIT_V(8); PG8_WAIT_L(0); PG8_BAR; PG8_MMA(0, 0, At, B0); PG8_MMA(0, 1, At, B1); PG8_BAR; PG8_SCHED;
            PG8_LDA(At, 1, 1); PG8_STAGE(PG8_SB(1, 0), b3, voffB); PG8_STAGE(PG8_SB(1, 1), b3 + hstep, voffB); PG8_STAGE(PG8_SA(1, 0), a3, voffA);
            PG8_WAIT_V(8); PG8_WAIT_L(0); PG8_BAR; PG8_MMA(1, 0, At, B0); PG8_MMA(1, 1, At, B1); PG8_BAR; PG8_SCHED;
            } else {
            PG8_LDB(B0, 0, 0); PG8_SCHED; PG8_LDA(At, 0, 0); PG8_STAGE(PG8_SA(1, 1), a1 + hstep, voffA);
            PG8_WAIT_L(8); PG8_BAR; PG8_WAIT_L(0); PG8_MMA(0, 0, At, B0); PG8_BAR; PG8_SCHED;
            PG8_LDB(B1, 0, 1); PG8_STAGE(PG8_SB(0, 0), b2, voffB);
            PG8_BAR; PG8_WAIT_L(0); PG8_MMA(0, 1, At, B1); PG8_BAR;
            PG8_LDA(At, 0, 1); PG8_STAGE(PG8_SA(0, 0), a2, voffA);
            PG8_BAR; PG8_WAIT_L(0); PG8_MMA(1, 0, At, B0); PG8_BAR; PG8_SCHED;
            PG8_STAGE(PG8_SB(0, 1), b2 + hstep, voffB);
            PG8_WAIT_V(6); PG8_BAR; PG8_MMA(1, 1, At, B1); PG8_BAR;
            PG8_LDB(B0, 1, 0); PG8_SCHED; PG8_LDA(At, 1, 0); PG8_STAGE(PG8_SA(0, 1), a2 + hstep, voffA);
            PG8_WAIT_L(8); PG8_BAR; PG8_WAIT_L(0); PG8_MMA(0, 0, At, B0); PG8_BAR; PG8_SCHED;
            PG8_LDB(B1, 1, 1); PG8_STAGE(PG8_SB(1, 0), b3, voffB);
            PG8_BAR; PG8_WAIT_L(0); PG8_MMA(0, 1, At, B1); PG8_BAR;
            PG8_LDA(At, 1, 1); PG8_STAGE(PG8_SA(1, 0), a3, voffA);
            PG8_BAR; PG8_WAIT_L(0); PG8_MMA(1, 0, At, B0); PG8_BAR; PG8_SCHED;
            PG8_STAGE(PG8_SB(1, 1), b3 + hstep, voffB);
            PG8_WAIT_V(6); PG8_BAR; PG8_MMA(1, 1, At, B1); PG8_BAR;
            }
        }
        if constexpr (ALIGN_EPI) { if (wr == 0) PG8_BAR; }
        if constexpr (!Epi::AFTER_DRAIN) { E(acc, cur, wr, wc, fr, fq); }
        if (!has_next) break;
#pragma unroll
        for (int a = 0; a < 2; ++a)
#pragma unroll
            for (int b = 0; b < 2; ++b)
#pragma unroll
                for (int m = 0; m < 4; ++m)
#pragma unroll
                    for (int n = 0; n < 2; ++n) acc[a][b][m][n] = (f32x4){0.f, 0.f, 0.f, 0.f};
        cur = nxt; cA = nA; cB = nB; ++ui;
        if constexpr (ALIGN_EPI) { if (wr == 1) PG8_BAR; }
    }
    PG8_WAIT_V(0);
    if constexpr (!ALIGN_EPI) { if (wr == 0) PG8_BAR; }
    PG8_BAR;
    if constexpr (Epi::AFTER_DRAIN) { E.fused(acc, cur, wr, wc, fr, fq, lds, wid, lane); }
#undef PG8_SA
#undef PG8_SB
#undef PG8_STAGE
#undef PG8_LDA
#undef PG8_LDB
#undef PG8_MMA
#undef PG8_WAIT_V
#undef PG8_WAIT_L
#undef PG8_BAR
#undef PG8_SCHED
}
}
using pg8::Unit; using pg8::cvt_pk_bf16;
typedef f32x4 AccT[2][2][4][2];

__device__ __forceinline__ u32x4 pack8(const f32x4 v0, const f32x4 v1) { u32x4 w; w.x = cvt_pk_bf16(v0[0], v0[1]); w.y = cvt_pk_bf16(v0[2], v0[3]); w.z = cvt_pk_bf16(v1[0], v1[1]); w.w = cvt_pk_bf16(v1[2], v1[3]); return w; }

struct EpiProj {
    static constexpr bool AFTER_DRAIN = false;
    bf16_t *uv, *zs, *xbc;
    __device__ __forceinline__ void operator()(const AccT& acc, const Unit& u, int wr, int wc, int fr, int fq) const {
        const int row0 = u.pm * 256 + wr * 64 + fr; const int ct = wc * 32 + 8 * fq;
        bf16_t* base; int ld, mode;
        if (u.pn < 16) { base = uv + u.pn * 256; ld = DMIX; mode = 0; }
        else if (u.pn < 24) { base = zs + (u.pn - 16) * 256; ld = DSSM; mode = 1; }
        else { base = xbc + (u.pn - 24) * 256; ld = DXBC; mode = 2; }
#pragma unroll
        for (int ai = 0; ai < 2; ++ai)
#pragma unroll
            for (int m = 0; m < 4; ++m) { bf16_t* rowp = base + (size_t)(row0 + ai * 128 + m * 16) * ld + ct;
#pragma unroll
                for (int bj = 0; bj < 2; ++bj) { f32x4 v0 = acc[ai][bj][m][0], v1 = acc[ai][bj][m][1];
                    if (mode == 0) {
#pragma unroll
                        for (int j = 0; j < 4; ++j) { v0[j] = gelu_tanh_f(v0[j]); v1[j] = gelu_tanh_f(v1[j]); } }
                    else if (mode == 1) {
#pragma unroll
                        for (int j = 0; j < 4; ++j) { v0[j] = silu_f(v0[j]); v1[j] = silu_f(v1[j]); } }
                    *(u32x4*)(rowp + bj * 128) = pack8(v0, v1); } }
    }
};
struct EpiPlain {
    static constexpr bool AFTER_DRAIN = false;
    bf16_t* O; int ld;
    __device__ __forceinline__ void operator()(const AccT& acc, const Unit& u, int wr, int wc, int fr, int fq) const {
        const int row0 = u.pm * 256 + wr * 64 + fr; const int col0 = u.pn * 256 + wc * 32 + 8 * fq;
#pragma unroll
        for (int ai = 0; ai < 2; ++ai)
#pragma unroll
            for (int m = 0; m < 4; ++m) { bf16_t* rowp = O + (size_t)(row0 + ai * 128 + m * 16) * ld + col0;
#pragma unroll
                for (int bj = 0; bj < 2; ++bj) *(u32x4*)(rowp + bj * 128) = pack8(acc[ai][bj][m][0], acc[ai][bj][m][1]); }
    }
};
struct EpiResid {
    static constexpr bool AFTER_DRAIN = true;
    const float* base; float* out; bf16_t* hn; bf16_t* halo; const float* gain; float* ssq;
    __device__ __forceinline__ void fused(AccT& acc, const Unit& u, int wr, int wc, int fr, int fq, LAS unsigned char* lds, int wid, int lane) const {
        asm volatile("" : "+v"(fr), "+v"(fq));
        LAS float* P = (LAS float*)lds;
        const int col0 = u.pn * 256 + wc * 32 + 8 * fq;
#pragma unroll
        for (int ai = 0; ai < 2; ++ai)
#pragma unroll
            for (int m = 0; m < 4; ++m) { const int rl = ai * 128 + wr * 64 + m * 16 + fr; const int row = u.pm * 256 + rl; const size_t off = (size_t)row * D + col0;
                float ss = 0.f;
                bf16_t* hrow = nullptr;
                if (halo) { const int r6 = row & 63; if (r6 >= 62) { if ((row >> 6) <= 126) hrow = halo + (size_t)(4 * (row >> 6) + (row & 1)) * D; } else if (r6 < 2 && row >= 64) hrow = halo + (size_t)(4 * ((row >> 6) - 1) + 2 + (row & 1)) * D; }
#pragma unroll
                for (int bj = 0; bj < 2; ++bj) { const f32x4 b0 = *(const f32x4*)(base + off + bj * 128), b1 = *(const f32x4*)(base + off + bj * 128 + 4);
                    const f32x4 v0 = acc[ai][bj][m][0] + b0, v1 = acc[ai][bj][m][1] + b1;
                    *(f32x4*)(out + off + bj * 128) = v0; *(f32x4*)(out + off + bj * 128 + 4) = v1;
                    ss += (v0[0] * v0[0] + v0[1] * v0[1]) + (v0[2] * v0[2] + v0[3] * v0[3]) + (v1[0] * v1[0] + v1[1] * v1[1]) + (v1[2] * v1[2] + v1[3] * v1[3]);
                    const f32x4 g0 = *(const f32x4*)(gain + col0 + bj * 128), g1 = *(const f32x4*)(gain + col0 + bj * 128 + 4);
                    const u32x4 w = pack8(v0 * g0, v1 * g1);
                    *(u32x4*)(hn + off + bj * 128) = w;
                    if (hrow) *(u32x4*)(hrow + col0 + bj * 128) = w; }
                ss += __shfl_xor(ss, 16); ss += __shfl_xor(ss, 32);
                if (fq == 0) P[rl * 4 + wc] = ss;
                asm volatile("" ::: "memory"); }
        __syncthreads();
        if (threadIdx.x < 256) { const int t = threadIdx.x; ssq[(size_t)(u.pm * 256 + t) * 8 + u.pn] = (P[t * 4 + 0] + P[t * 4 + 1]) + (P[t * 4 + 2] + P[t * 4 + 3]); }
        __syncthreads();
    }
};
struct EpiPle {
    static constexpr bool AFTER_DRAIN = true;
    float* out; const bf16_t* Eb; const float* ssq_in; float* ssq;
    __device__ __forceinline__ void fused(AccT& acc, const Unit& u, int wr, int wc, int fr, int fq, LAS unsigned char* lds, int wid, int lane) const {
        asm volatile("" : "+v"(fr), "+v"(fq));
        LAS float* P = (LAS float*)lds;
        const int col0 = u.pn * 256 + wc * 32 + 8 * fq;
#pragma unroll
        for (int ai = 0; ai < 2; ++ai)
#pragma unroll
            for (int m = 0; m < 4; ++m) { const int rl = ai * 128 + wr * 64 + m * 16 + fr; const int row = u.pm * 256 + rl; const size_t off = (size_t)row * D + col0;
                const f32x4 q0 = *(const f32x4*)(ssq_in + (size_t)row * 8), q1 = *(const f32x4*)(ssq_in + (size_t)row * 8 + 4);
                const float rinv = 1.0f / sqrtf(((q0[0] + q0[1]) + (q0[2] + q0[3]) + (q1[0] + q1[1]) + (q1[2] + q1[3])) * (1.0f / D) + EPS);
                float ss = 0.f;
#pragma unroll
                for (int bj = 0; bj < 2; ++bj) { const f32x4 b0 = *(const f32x4*)(out + off + bj * 128), b1 = *(const f32x4*)(out + off + bj * 128 + 4);
                    const u32x4 ew = *(const u32x4*)(Eb + off + bj * 128);
                    f32x4 e0 = {bflo(ew.x), bfhi(ew.x), bflo(ew.y), bfhi(ew.y)}, e1 = {bflo(ew.z), bfhi(ew.z), bflo(ew.w), bfhi(ew.w)};
                    f32x4 v0, v1;
#pragma unroll
                    for (int j = 0; j < 4; ++j) { v0[j] = b0[j] + fast_sigmoid(acc[ai][bj][m][0][j] * rinv) * e0[j]; v1[j] = b1[j] + fast_sigmoid(acc[ai][bj][m][1][j] * rinv) * e1[j]; }
                    *(f32x4*)(out + off + bj * 128) = v0; *(f32x4*)(out + off + bj * 128 + 4) = v1;
                    ss += (v0[0] * v0[0] + v0[1] * v0[1]) + (v0[2] * v0[2] + v0[3] * v0[3]) + (v1[0] * v1[0] + v1[1] * v1[1]) + (v1[2] * v1[2] + v1[3] * v1[3]); }
                ss += __shfl_xor(ss, 16); ss += __shfl_xor(ss, 32);
                if (fq == 0) P[rl * 4 + wc] = ss;
                asm volatile("" ::: "memory"); }
        __syncthreads();
        if (threadIdx.x < 256) { const int t = threadIdx.x; ssq[(size_t)(u.pm * 256 + t) * 8 + u.pn] = (P[t * 4 + 0] + P[t * 4 + 1]) + (P[t * 4 + 2] + P[t * 4 + 3]); }
        __syncthreads();
    }
};
struct EpiFfn {
    static constexpr bool AFTER_DRAIN = false;
    bf16_t* act; const float* ssq1; const float* cw; const float* cb;
    __device__ __forceinline__ int grow_of(const Unit& u, int rl) const {
        if (u.pm < 32) return u.pm * 256 + rl;
        const int R = (u.pm - 32) * 256 + rl; int q = (R >> 2) + 1; if (q > 127) q = 127; return 64 * q - 2 + (R & 3);
    }
    __device__ __forceinline__ void operator()(AccT& acc, const Unit& u, int wr, int wc, int fr, int fq) const {
        asm volatile("" : "+v"(fr), "+v"(fq));
        const bool halo = u.pm >= 32;
        const int lane = fq * 16 + fr;
        const int s1 = (lane & 48) | ((fr + 15) & 15), s2 = (lane & 48) | ((fr + 14) & 15);
#pragma unroll
        for (int ai = 0; ai < 2; ++ai)
#pragma unroll
            for (int m = 0; m < 4; ++m) {
                const int gr = grow_of(u, ai * 128 + wr * 64 + m * 16 + fr);
                const f32x4 q0 = *(const f32x4*)(ssq1 + (size_t)gr * 8), q1 = *(const f32x4*)(ssq1 + (size_t)gr * 8 + 4);
                const float rinv = 1.0f / sqrtf(((q0[0] + q0[1]) + (q0[2] + q0[3]) + (q1[0] + q1[1]) + (q1[2] + q1[3])) * (1.0f / D) + EPS);
#pragma unroll
                for (int bj = 0; bj < 2; ++bj)
#pragma unroll
                    for (int n = 0; n < 2; ++n) acc[ai][bj][m][n] = acc[ai][bj][m][n] * rinv;
                asm volatile("" ::: "memory");
            }
#pragma unroll
        for (int n = 0; n < 2; ++n) {
            const int gc = u.pn * 128 + wc * 32 + 8 * fq + 4 * n;
#pragma unroll
            for (int bj = 0; bj < 2; ++bj) {
                const int cc = bj * DFF + gc;
                asm volatile("" ::: "memory");
                const f32x4 w0 = *(const f32x4*)(cw + cc), w1 = *(const f32x4*)(cw + 2 * DFF + cc), w2 = *(const f32x4*)(cw + 4 * DFF + cc), bb = *(const f32x4*)(cb + cc);
#pragma unroll
                for (int ai = 0; ai < 2; ++ai) {
                    f32x4 p1 = {0.f, 0.f, 0.f, 0.f}, p2 = p1;
#pragma unroll
                    for (int m = 0; m < 4; ++m) {
                        f32x4 v = acc[ai][bj][m][n];
                        asm volatile("" : "+v"(v));
                        f32x4 r1, r2, hh;
#pragma unroll
                        for (int j = 0; j < 4; ++j) { r1[j] = __shfl(v[j], s1); r2[j] = __shfl(v[j], s2); }
#pragma unroll
                        for (int j = 0; j < 4; ++j) { const float x1 = fr >= 1 ? r1[j] : p1[j], x2 = fr >= 2 ? r2[j] : p2[j]; hh[j] = bb[j] + w2[j] * v[j] + w1[j] * x1 + w0[j] * x2; }
                        asm volatile("" : "+v"(hh));
                        acc[ai][bj][m][n] = hh; p1 = r1; p2 = r2;
                    }
                }
            }
            asm volatile("" ::: "memory");
#pragma unroll
            for (int ai = 0; ai < 2; ++ai)
#pragma unroll
                for (int m = 0; m < 4; ++m) {
                    const int rl = ai * 128 + wr * 64 + m * 16 + fr;
                    bool st;
                    if (!halo) st = !(m == 0 && fr < 2) || (u.pm == 0 && ai == 0 && wr == 0);
                    else st = ((fr & 3) >= 2) && ((((u.pm - 32) * 256 + rl) >> 2) + 1 <= 127);
                    if (st) { const f32x4 hg_ = acc[ai][0][m][n], hu_ = acc[ai][1][m][n];
                        u32x2 w; w.x = cvt_pk_bf16(silu_f(hg_[0]) * hu_[0], silu_f(hg_[1]) * hu_[1]); w.y = cvt_pk_bf16(silu_f(hg_[2]) * hu_[2], silu_f(hg_[3]) * hu_[3]);
                        *(u32x2*)(act + (size_t)grow_of(u, rl) * DFF + gc) = w; }
                }
        }
    }
};

struct Ctx {
    LAS unsigned char* lds;
    int tid, lane, wave, nb, bid;
    const float* const* in;
    float* out;
    unsigned char* ws;
};

template <int MODE>
__device__ __forceinline__ void prep_w_item(const float* __restrict__ W, int K, int N, bf16_t* __restrict__ Wt, int item, int lane) {
    const int nkb = K / 64, nb = item / nkb, kb = item % nkb;
    const int n4 = nb * 256 + lane * 4; if (n4 >= N) return;
    int orow = n4;
    if (MODE == 1) orow = (n4 < DFF) ? 256 * (n4 >> 7) + (n4 & 127) : 256 * ((n4 - DFF) >> 7) + 128 + ((n4 - DFF) & 127);
    const float* src = W + (size_t)(kb * 64) * N + n4;
    bf16_t* dst = Wt + (size_t)orow * K + kb * 64;
#pragma unroll 2
    for (int it = 0; it < 8; ++it) {
        f32x4 v[8];
#pragma unroll
        for (int j = 0; j < 8; ++j) v[j] = *(const f32x4*)(src + (size_t)(it * 8 + j) * N);
#pragma unroll
        for (int q = 0; q < 4; ++q) { u32x4 o; o.x = pk2(v[0][q], v[1][q]); o.y = pk2(v[2][q], v[3][q]); o.z = pk2(v[4][q], v[5][q]); o.w = pk2(v[6][q], v[7][q]);
            *(u32x4*)(dst + (size_t)q * K + it * 8) = o; }
    }
}
__device__ __forceinline__ void phase_prep(const Ctx& c) {
    const int gw = c.bid * 8 + c.wave, NGW = c.nb * 8;
    const float* w_in = c.in[3]; const float* w_out = c.in[15]; const float* w_up = c.in[17]; const float* w_dn = c.in[20]; const float* w_pg = c.in[22]; const float* w_ple = c.in[23];
    constexpr int I_IN = 41 * (D / 64), I_OUT = 8 * (DMIX / 64), I_UP = 44 * (D / 64), I_DN = 8 * (DFF / 64), I_PG = 8 * (D / 64), I_PLE = 8 * (DPLE / 64);
    constexpr int NIT = I_IN + I_OUT + I_UP + I_DN + I_PG + I_PLE;
    for (int it = gw; it < NIT; it += NGW) {
        int r = it;
        if (r < I_IN) { prep_w_item<0>(w_in, D, DIN, (bf16_t*)(c.ws + WS_WIN), r, c.lane); continue; } r -= I_IN;
        if (r < I_UP) { prep_w_item<1>(w_up, D, 2 * DFF, (bf16_t*)(c.ws + WS_WUP), r, c.lane); continue; } r -= I_UP;
        if (r < I_OUT) { prep_w_item<0>(w_out, DMIX, D, (bf16_t*)(c.ws + WS_WOUT), r, c.lane); continue; } r -= I_OUT;
        if (r < I_DN) { prep_w_item<0>(w_dn, DFF, D, (bf16_t*)(c.ws + WS_WDN), r, c.lane); continue; } r -= I_DN;
        if (r < I_PG) { prep_w_item<0>(w_pg, D, D, (bf16_t*)(c.ws + WS_WPG), r, c.lane); continue; } r -= I_PG;
        prep_w_item<0>(w_ple, DPLE, D, (bf16_t*)(c.ws + WS_WPLE), r, c.lane);
    }
    const float* x = c.in[0]; const float* g = c.in[2]; bf16_t* A = (bf16_t*)(c.ws + WS_A);
    for (int m = gw; m < S; m += NGW) {
        const float* xr = x + (size_t)m * D + 8 * c.lane; f32x4 v[4][2]; float s = 0.f;
#pragma unroll
        for (int j = 0; j < 4; ++j) { v[j][0] = *(const f32x4*)(xr + 512 * j); v[j][1] = *(const f32x4*)(xr + 512 * j + 4);
#pragma unroll
            for (int e = 0; e < 4; ++e) s += v[j][0][e] * v[j][0][e] + v[j][1][e] * v[j][1][e]; }
        const float rinv = 1.0f / sqrtf(wave_sum(s) * (1.0f / D) + EPS);
#pragma unroll
        for (int j = 0; j < 4; ++j) { const f32x4 g0 = *(const f32x4*)(g + 8 * c.lane + 512 * j), g1 = *(const f32x4*)(g + 8 * c.lane + 512 * j + 4);
            const f32x4 a0 = v[j][0] * rinv * g0, a1 = v[j][1] * rinv * g1;
            u32x4 o; o.x = pk2(a0[0], a0[1]); o.y = pk2(a0[2], a0[3]); o.z = pk2(a1[0], a1[1]); o.w = pk2(a1[2], a1[3]);
            *(u32x4*)(A + (size_t)m * D + 8 * c.lane + 512 * j) = o; }
    }
    const float* p = c.in[1]; bf16_t* P16 = (bf16_t*)(c.ws + WS_P16);
    for (size_t i = ((size_t)c.bid * 512 + c.tid) * 8; i < (size_t)S * DPLE; i += (size_t)c.nb * 512 * 8) {
        const f32x4 a0 = *(const f32x4*)(p + i), a1 = *(const f32x4*)(p + i + 4);
        u32x4 o; o.x = pk2(a0[0], a0[1]); o.y = pk2(a0[2], a0[3]); o.z = pk2(a1[0], a1[1]); o.w = pk2(a1[2], a1[3]);
        *(u32x4*)(P16 + i) = o;
    }
}

__device__ __forceinline__ void phase_dt(const Ctx& c) {
    const bf16_t* A = (const bf16_t*)(c.ws + WS_A); const bf16_t* Wdt = (const bf16_t*)(c.ws + WS_WIN) + (size_t)10240 * D;
    float* dt = (float*)(c.ws + WS_DT); const float* dtb = c.in[11];
    LAS float* red = (LAS float*)c.lds;
    const int r = c.lane & 31, h = c.lane >> 5;
    for (int item = c.bid; item < S / 32; item += c.nb) {
        const int row0 = item * 32;
        f32x16 acc; for (int i = 0; i < 16; ++i) acc[i] = 0.f;
        const bf16_t* ap = A + (size_t)(row0 + r) * D + c.wave * 256 + 8 * h;
        const bf16_t* bp = Wdt + (size_t)r * D + c.wave * 256 + 8 * h;
#pragma unroll 4
        for (int s = 0; s < 16; ++s) { const bf16x8 af = *(const bf16x8*)(ap + 16 * s), bfr = *(const bf16x8*)(bp + 16 * s);
            acc = __builtin_amdgcn_mfma_f32_32x32x16_bf16(af, bfr, acc, 0, 0, 0); }
#pragma unroll
        for (int i = 0; i < 16; ++i) red[(c.wave * 32 + ((i & 3) + 8 * (i >> 2) + 4 * h)) * 32 + r] = acc[i];
        __syncthreads();
        for (int o = c.tid; o < 1024; o += 512) { float s = 0.f;
#pragma unroll
            for (int w = 0; w < 8; ++w) s += red[w * 1024 + o];
            const int hd = o & 31; const float xv = s + dtb[hd];
            const float sp = xv > 20.f ? xv : log1pf(__expf(xv));
            dt[(size_t)(row0 + (o >> 5)) * 32 + hd] = sp; }
        __syncthreads();
    }
}

template <int W>
__device__ __forceinline__ void stage_conv_tile(const Ctx& c, LAS unsigned char* dst, int pitchB, int col0, int t0, const LAS float* scale) {
    const bf16_t* xbc = (const bf16_t*)(c.ws + WS_XBC); const float* cw = c.in[9]; const float* cb = c.in[10];
    constexpr int NCHK = W / 8, NGRPS = 512 / NCHK, RPT = 128 / NGRPS;
    const int ch = c.tid % NCHK, grp = c.tid / NCHK; const int cc = col0 + ch * 8;
    float w[4][8], b[8];
#pragma unroll
    for (int k = 0; k < 4; ++k) { const f32x4 a0 = *(const f32x4*)(cw + (size_t)k * DXBC + cc), a1 = *(const f32x4*)(cw + (size_t)k * DXBC + cc + 4);
#pragma unroll
        for (int e = 0; e < 4; ++e) { w[k][e] = a0[e]; w[k][4 + e] = a1[e]; } }
    { const f32x4 a0 = *(const f32x4*)(cb + cc), a1 = *(const f32x4*)(cb + cc + 4);
#pragma unroll
      for (int e = 0; e < 4; ++e) { b[e] = a0[e]; b[4 + e] = a1[e]; } }
    const int r0 = grp * RPT;
    float x0[8], x1[8], x2[8];
#pragma unroll
    for (int e = 0; e < 8; ++e) { x0[e] = 0.f; x1[e] = 0.f; x2[e] = 0.f; }
    {
        const int t = t0 + r0;
        if (t - 3 >= 0) { const u32x4 q = *(const u32x4*)(xbc + (size_t)(t - 3) * DXBC + cc); x0[0] = bflo(q.x); x0[1] = bfhi(q.x); x0[2] = bflo(q.y); x0[3] = bfhi(q.y); x0[4] = bflo(q.z); x0[5] = bfhi(q.z); x0[6] = bflo(q.w); x0[7] = bfhi(q.w); }
        if (t - 2 >= 0) { const u32x4 q = *(const u32x4*)(xbc + (size_t)(t - 2) * DXBC + cc); x1[0] = bflo(q.x); x1[1] = bfhi(q.x); x1[2] = bflo(q.y); x1[3] = bfhi(q.y); x1[4] = bflo(q.z); x1[5] = bfhi(q.z); x1[6] = bflo(q.w); x1[7] = bfhi(q.w); }
        if (t - 1 >= 0) { const u32x4 q = *(const u32x4*)(xbc + (size_t)(t - 1) * DXBC + cc); x2[0] = bflo(q.x); x2[1] = bfhi(q.x); x2[2] = bflo(q.y); x2[3] = bfhi(q.y); x2[4] = bflo(q.z); x2[5] = bfhi(q.z); x2[6] = bflo(q.w); x2[7] = bfhi(q.w); }
    }
#pragma unroll
    for (int i = 0; i < RPT; ++i) {
        const int rl = r0 + i, t = t0 + rl;
        const u32x4 q = *(const u32x4*)(xbc + (size_t)t * DXBC + cc);
        float x3[8]; x3[0] = bflo(q.x); x3[1] = bfhi(q.x); x3[2] = bflo(q.y); x3[3] = bfhi(q.y); x3[4] = bflo(q.z); x3[5] = bfhi(q.z); x3[6] = bflo(q.w); x3[7] = bfhi(q.w);
        float sc = 1.f; if (scale) sc = scale[rl * 4 + (ch * 8) / 64];
        float o[8];
#pragma unroll
        for (int e = 0; e < 8; ++e) { const float hsum = b[e] + w[0][e] * x0[e] + w[1][e] * x1[e] + w[2][e] * x2[e] + w[3][e] * x3[e]; o[e] = silu_f(hsum) * sc; x0[e] = x1[e]; x1[e] = x2[e]; x2[e] = x3[e]; }
        u32x4 ov; ov.x = pk2(o[0], o[1]); ov.y = pk2(o[2], o[3]); ov.z = pk2(o[4], o[5]); ov.w = pk2(o[6], o[7]);
        *(LAS u32x4*)(dst + rl * pitchB + ch * 16) = ov;
    }
}

__device__ __forceinline__ void ssd_tables(const Ctx& c, int ck, int g, LAS float* sdt, LAS float* sacs) {
    const float* dt = (const float*)(c.ws + WS_DT); const float* alog = c.in[12];
    { const int l = c.tid >> 2, h = c.tid & 3; const float dv = dt[(size_t)(ck * 128 + l) * 32 + g * 4 + h]; sdt[l * 4 + h] = dv; sacs[l * 4 + h] = dv * (-__expf(alog[g * 4 + h])); }
    __syncthreads();
    if (c.wave < 4) { const int h = c.wave; const float v0 = sacs[(2 * c.lane) * 4 + h], v1 = sacs[(2 * c.lane + 1) * 4 + h]; float s = v0 + v1;
#pragma unroll
        for (int d = 1; d < 64; d <<= 1) { const float t = __shfl_up(s, d); if (c.lane >= d) s += t; }
        const float ex = s - (v0 + v1);
        sacs[(2 * c.lane) * 4 + h] = ex + v0; sacs[(2 * c.lane + 1) * 4 + h] = s; }
    __syncthreads();
}

constexpr int XS_PITCH = 576, BC_PITCH = 320;
constexpr int L_XS = 0, L_B = 128 * XS_PITCH, L_C = L_B + 128 * BC_PITCH, L_TAB = L_C + 128 * BC_PITCH;
constexpr int L_SDT = L_TAB, L_SACS = L_TAB + 2048, L_SW = L_TAB + 4096, L_MISC = L_TAB + 6144;
static_assert(L_MISC + 2048 <= LDS_BYTES, "mixer LDS map");

__device__ __forceinline__ void ssd_a_item(const Ctx& c, int ck, int g) {
    LAS float* sdt = (LAS float*)(c.lds + L_SDT); LAS float* sacs = (LAS float*)(c.lds + L_SACS); LAS float* sw = (LAS float*)(c.lds + L_SW);
    ssd_tables(c, ck, g, sdt, sacs);
    { const int l = c.tid >> 2, h = c.tid & 3; sw[l * 4 + h] = sdt[l * 4 + h] * __expf(sacs[127 * 4 + h] - sacs[l * 4 + h]); }
    if (c.tid < 4) ((float*)(c.ws + WS_CDEC))[ck * 32 + g * 4 + c.tid] = __expf(sacs[127 * 4 + c.tid]);
    __syncthreads();
    stage_conv_tile<256>(c, c.lds + L_XS, XS_PITCH, g * 256, ck * 128, sw);
    stage_conv_tile<128>(c, c.lds + L_B, BC_PITCH, DSSM + g * 128, ck * 128, nullptr);
    __syncthreads();
    bf16_t* st = (bf16_t*)(c.ws + WS_ST) + (size_t)(ck * 32 + g * 4) * 64 * 128;
    for (int o = c.tid; o < 4 * 64 * 128; o += 512) { const int n = o & 127, hp = o >> 7; float s = 0.f;
        for (int l = 0; l < 128; ++l) s += bf2f(*(LAS bf16_t*)(c.lds + L_B + l * BC_PITCH + n * 2)) * bf2f(*(LAS bf16_t*)(c.lds + L_XS + l * XS_PITCH + hp * 2));
        st[o] = (bf16_t)f2bf(s); }
    __syncthreads();
}

__device__ __forceinline__ void gmlp_item(const Ctx& c, int ck, int g) {
    bf16_t* uv = (bf16_t*)(c.ws + WS_UV);
    LAS float* vn = (LAS float*)c.lds;
    LAS float* ssq = (LAS float*)(c.lds + 65536);
    const float* lng = c.in[4] + g * 128; const float* lnb = c.in[5] + g * 128; const float* Ws = c.in[6] + (size_t)g * 128 * 128; const float* bs = c.in[7] + g * 128; const float* nag = c.in[8] + g * 128;
    for (int s = c.wave; s < 128; s += 8) {
        const bf16_t* vr = uv + (size_t)(ck * 128 + s) * DMIX + DA + g * 128;
        const float a0 = bf2f(vr[c.lane]), a1 = bf2f(vr[c.lane + 64]);
        const float mu = wave_sum(a0 + a1) * (1.0f / 128.0f); const float d0 = a0 - mu, d1 = a1 - mu;
        const float var = wave_sum(d0 * d0 + d1 * d1) * (1.0f / 128.0f); const float rs = 1.0f / sqrtf(var + EPS);
        vn[s * 128 + c.lane] = d0 * rs * lng[c.lane] + lnb[c.lane]; vn[s * 128 + c.lane + 64] = d1 * rs * lng[c.lane + 64] + lnb[c.lane + 64];
    }
    __syncthreads();
    const int d = c.tid & 127;
    for (int j = 0; j < 32; ++j) {
        const int t = (c.tid >> 7) + 4 * j; float sg = bs[t]; const float* wr_ = Ws + t * 128;
        for (int s = 0; s <= t; ++s) sg += wr_[s] * vn[s * 128 + d];
        bf16_t* up = uv + (size_t)(ck * 128 + t) * DMIX + g * 128 + d;
        const float y = bf2f(*up) * sg;
        *up = (bf16_t)f2bf(y * nag[d]);
        const float q = wave_sum(y * y);
        if (c.lane == 0) ssq[t * 2 + (c.wave & 1)] = q;
    }
    __syncthreads();
    if (c.tid < 128) ((float*)(c.ws + WS_SSQA))[(size_t)(ck * 128 + c.tid) * 16 + g] = ssq[c.tid * 2] + ssq[c.tid * 2 + 1];
    __syncthreads();
}

__device__ __forceinline__ void phase_mix_a(const Ctx& c) {
    for (int it = c.bid; it < NCH * NGA + NCH * NGRP; it += c.nb) {
        if (it < NCH * NGA) gmlp_item(c, it >> 4, it & 15);
        else { const int r = it - NCH * NGA; ssd_a_item(c, r >> 3, r & 7); }
    }
}

__device__ __forceinline__ void phase_scan(const Ctx& c) {
    unsigned* st = (unsigned*)(c.ws + WS_ST); const float* cdec = (const float*)(c.ws + WS_CDEC);
    for (int e = c.bid * 512 + c.tid; e < 32 * 64 * 64; e += c.nb * 512) {
        const int head = e >> 12; float h0 = 0.f, h1 = 0.f;
#pragma unroll 8
        for (int ck = 0; ck < NCH; ++ck) { const size_t idx = (size_t)ck * (32 * 64 * 64) + e; const unsigned w = st[idx]; const float dc = cdec[ck * 32 + head];
            st[idx] = pk2(h0, h1); h0 = dc * h0 + bflo(w); h1 = dc * h1 + bfhi(w); }
    }
    bf16_t* uv = (bf16_t*)(c.ws + WS_UV); const float* sq = (const float*)(c.ws + WS_SSQA);
    for (int i = c.bid * 512 + c.tid; i < S * (DA / 8); i += c.nb * 512) { const int row = i >> 8, ch = i & 255;
        const f32x4 q0 = *(const f32x4*)(sq + row * 16), q1 = *(const f32x4*)(sq + row * 16 + 4), q2 = *(const f32x4*)(sq + row * 16 + 8), q3 = *(const f32x4*)(sq + row * 16 + 12);
        float s = 0.f;
#pragma unroll
        for (int e = 0; e < 4; ++e) s += q0[e] + q1[e] + q2[e] + q3[e];
        const float rinv = 1.0f / sqrtf(s * (1.0f / DA) + EPS);
        u32x4* pp = (u32x4*)(uv + (size_t)row * DMIX + ch * 8); const u32x4 w = *pp; u32x4 o;
        o.x = pk2(bflo(w.x) * rinv, bfhi(w.x) * rinv); o.y = pk2(bflo(w.y) * rinv, bfhi(w.y) * rinv); o.z = pk2(bflo(w.z) * rinv, bfhi(w.z) * rinv); o.w = pk2(bflo(w.w) * rinv, bfhi(w.w) * rinv);
        *pp = o; }
}

__device__ __forceinline__ void ssd_c_item(const Ctx& c, int ck, int g) {
    LAS float* sdt = (LAS float*)(c.lds + L_SDT); LAS float* sacs = (LAS float*)(c.lds + L_SACS); LAS float* part = (LAS float*)(c.lds + L_SW);
    ssd_tables(c, ck, g, sdt, sacs);
    stage_conv_tile<256>(c, c.lds + L_XS, XS_PITCH, g * 256, ck * 128, nullptr);
    stage_conv_tile<128>(c, c.lds + L_B, BC_PITCH, DSSM + g * 128, ck * 128, nullptr);
    stage_conv_tile<128>(c, c.lds + L_C, BC_PITCH, DSSM + NGRP * NST + g * 128, ck * 128, nullptr);
    __syncthreads();
    float* G = (float*)(c.ws + WS_GSCR) + (size_t)c.bid * 16384;
    for (int o = c.tid; o < 16384; o += 512) { const int s = o & 127, l = o >> 7; float a = 0.f;
        if (s <= l) for (int n = 0; n < 128; ++n) a += bf2f(*(LAS bf16_t*)(c.lds + L_C + l * BC_PITCH + n * 2)) * bf2f(*(LAS bf16_t*)(c.lds + L_B + s * BC_PITCH + n * 2));
        __hip_atomic_store(G + o, a, __ATOMIC_RELAXED, __HIP_MEMORY_SCOPE_AGENT); }
    asm volatile("s_waitcnt vmcnt(0)" ::: "memory");
    __syncthreads();
    const bf16_t* hin = (const bf16_t*)(c.ws + WS_ST) + (size_t)(ck * 32 + g * 4) * 64 * 128;
    const bf16_t* zs = (const bf16_t*)(c.ws + WS_ZS); bf16_t* cat = (bf16_t*)(c.ws + WS_UV); const float* dsk = c.in[13]; const float* ng = c.in[14];
    const int hp = c.tid & 255, h = hp >> 6; const float Dh = dsk[g * 4 + h];
    for (int j = 0; j < 64; ++j) { const int l = (c.tid >> 8) + 2 * j; const float al = sacs[l * 4 + h];
        float y = 0.f;
        for (int s = 0; s <= l; ++s) y += __hip_atomic_load(G + l * 128 + s, __ATOMIC_RELAXED, __HIP_MEMORY_SCOPE_AGENT) * __expf(al - sacs[s * 4 + h]) * sdt[s * 4 + h] * bf2f(*(LAS bf16_t*)(c.lds + L_XS + s * XS_PITCH + hp * 2));
        float yo = 0.f;
        for (int n = 0; n < 128; ++n) yo += bf2f(*(LAS bf16_t*)(c.lds + L_C + l * BC_PITCH + n * 2)) * bf2f(hin[hp * 128 + n]);
        y += __expf(al) * yo + Dh * bf2f(*(LAS bf16_t*)(c.lds + L_XS + l * XS_PITCH + hp * 2));
        const size_t row = (size_t)ck * 128 + l;
        y *= bf2f(zs[row * DSSM + g * 256 + hp]);
        const float q = wave_sum(y * y);
        if (c.lane == 0) part[l * 4 + (c.wave & 3)] = q;
        cat[row * DMIX + DA + g * 256 + hp] = (bf16_t)f2bf(y);
    }
    __syncthreads();
    for (int j = 0; j < 64; ++j) { const int l = (c.tid >> 8) + 2 * j; const size_t row = (size_t)ck * 128 + l;
        const float rinv = 1.0f / sqrtf(((part[l * 4] + part[l * 4 + 1]) + (part[l * 4 + 2] + part[l * 4 + 3])) * (1.0f / 256.0f) + EPS);
        bf16_t* pp = cat + row * DMIX + DA + g * 256 + hp;
        *pp = (bf16_t)f2bf(bf2f(*pp) * rinv * ng[g * 256 + hp]); }
    __syncthreads();
}

__device__ __forceinline__ void phase_mix_c(const Ctx& c) {
    for (int it = c.bid; it < NCH * NGRP; it += c.nb) ssd_c_item(c, it >> 3, it & 7);
}

__device__ __forceinline__ void phase_final(const Ctx& c) {
    const int gw = c.bid * 8 + c.wave, NGW = c.nb * 8; const float* g = c.in[24]; const float* sq = (const float*)(c.ws + WS_SSQ3);
    for (int m = gw; m < S; m += NGW) {
        const f32x4 q0 = *(const f32x4*)(sq + (size_t)m * 8), q1 = *(const f32x4*)(sq + (size_t)m * 8 + 4);
        const float rinv = 1.0f / sqrtf(((q0[0] + q0[1]) + (q0[2] + q0[3]) + (q1[0] + q1[1]) + (q1[2] + q1[3])) * (1.0f / D) + EPS);
        float* orow = c.out + (size_t)m * D + 4 * c.lane;
#pragma unroll
        for (int j = 0; j < 8; ++j) { const f32x4 v = *(const f32x4*)(orow + 256 * j), gg = *(const f32x4*)(g + 4 * c.lane + 256 * j); *(f32x4*)(orow + 256 * j) = v * rinv * gg; }
    }
}

__global__ void __launch_bounds__(512, 2) mega_fwd(Params P, int ph_lo, int ph_hi) {
    extern __shared__ __attribute__((aligned(16))) unsigned char lds_raw[];
    Ctx c;
    c.lds = (LAS unsigned char*)lds_raw; c.tid = threadIdx.x; c.lane = c.tid & 63; c.wave = __builtin_amdgcn_readfirstlane(c.tid >> 6);
    c.nb = gridDim.x; c.bid = blockIdx.x; c.in = P.in; c.out = P.out; c.ws = P.ws;
    unsigned char* ws = P.ws;
#ifndef PH_MASK
#define PH_MASK 0x3ff
#endif
#define IN(k) (((PH_MASK >> (k)) & 1) && ph_lo <= (k) && (k) < ph_hi)
#define SEAM(k) do { if (IN(k) && IN((k) + 1)) cg::this_grid().sync(); } while (0)
    if (IN(0)) phase_prep(c);
    SEAM(0);
    if (IN(1)) {
        pg8::Gemm g{(const bf16_t*)(ws + WS_A), (const bf16_t*)(ws + WS_WIN), D}; pg8::StaticOrder So; So.init(32, 40, c.nb, c.bid);
        EpiProj E{(bf16_t*)(ws + WS_UV), (bf16_t*)(ws + WS_ZS), (bf16_t*)(ws + WS_XBC)};
        pg8::gemm_phase<EpiProj, true, true>(c.lds, g, So, E);
        phase_dt(c);
    }
    SEAM(1);
    if (IN(2)) phase_mix_a(c);
    SEAM(2);
    if (IN(3)) phase_scan(c);
    SEAM(3);
    if (IN(4)) phase_mix_c(c);
    SEAM(4);
    if (IN(5)) {
        { pg8::Gemm g{(const bf16_t*)(ws + WS_UV), (const bf16_t*)(ws + WS_WOUT), DMIX}; pg8::StaticOrder So; So.init(32, 8, c.nb, c.bid);
          EpiResid E{P.in[0], P.out, (bf16_t*)(ws + WS_HG), (bf16_t*)(ws + WS_HG) + (size_t)S * D, P.in[16], (float*)(ws + WS_SSQ1)};
          pg8::gemm_phase<EpiResid, false, true>(c.lds, g, So, E); }
        { pg8::Gemm g{(const bf16_t*)(ws + WS_P16), (const bf16_t*)(ws + WS_WPLE), DPLE}; pg8::StaticOrder So; So.init(32, 8, c.nb, c.bid);
          EpiPlain E{(bf16_t*)(ws + WS_E), D};
          pg8::gemm_phase<EpiPlain, true, true>(c.lds, g, So, E); }
    }
    SEAM(5);
    if (IN(6)) {
        pg8::Gemm g{(const bf16_t*)(ws + WS_HG), (const bf16_t*)(ws + WS_WUP), D}; pg8::StaticOrder So; So.init(34, 44, c.nb, c.bid);
        EpiFfn E{(bf16_t*)(ws + WS_ACT), (const float*)(ws + WS_SSQ1), P.in[18], P.in[19]};
        pg8::gemm_phase<EpiFfn, true, true>(c.lds, g, So, E);
    }
    SEAM(6);
    if (IN(7)) {
        pg8::Gemm g{(const bf16_t*)(ws + WS_ACT), (const bf16_t*)(ws + WS_WDN), DFF}; pg8::StaticOrder So; So.init(32, 8, c.nb, c.bid);
        EpiResid E{P.out, P.out, (bf16_t*)(ws + WS_H2G), nullptr, P.in[21], (float*)(ws + WS_SSQ2)};
        pg8::gemm_phase<EpiResid, false, true>(c.lds, g, So, E);
    }
    SEAM(7);
    if (IN(8)) {
        pg8::Gemm g{(const bf16_t*)(ws + WS_H2G), (const bf16_t*)(ws + WS_WPG), D}; pg8::StaticOrder So; So.init(32, 8, c.nb, c.bid);
        EpiPle E{P.out, (const bf16_t*)(ws + WS_E), (const float*)(ws + WS_SSQ2), (float*)(ws + WS_SSQ3)};
        pg8::gemm_phase<EpiPle, false, true>(c.lds, g, So, E);
    }
    SEAM(8);
    if (IN(9)) phase_final(c);
#undef IN
#undef SEAM
}

extern "C" void kernel_launch(void* const* d_in, const int* in_sizes, int n_in, void* d_out, int out_size, void* d_ws, size_t ws_size, hipStream_t stream) {
    static int grid = 0;
    if (grid == 0) {
        if (n_in != 25 || out_size != S * D || ws_size < WS_END) { fprintf(stderr, "kernel_launch: unexpected shapes (n_in %d out %d ws %zu)\n", n_in, out_size, ws_size); grid = -1; return; }
        int dev = 0, cus = 0, per_cu = 0;
        (void)hipGetDevice(&dev); (void)hipDeviceGetAttribute(&cus, hipDeviceAttributeMultiprocessorCount, dev);
        if (hipFuncSetAttribute((const void*)mega_fwd, hipFuncAttributeMaxDynamicSharedMemorySize, LDS_BYTES) != hipSuccess) { fprintf(stderr, "kernel_launch: hipFuncSetAttribute failed\n"); grid = -1; return; }
        (void)hipOccupancyMaxActiveBlocksPerMultiprocessor(&per_cu, (const void*)mega_fwd, 512, LDS_BYTES);
        if (per_cu < 1) { fprintf(stderr, "kernel_launch: occupancy query says %d blocks/CU\n", per_cu); per_cu = 1; }
        (void)hipGetLastError();
        grid = cus;
        fprintf(stderr, "kernel_launch: grid %d (cus %d, per_cu %d)\n", grid, cus, per_cu);
    }
    if (grid < 0) return;
    Params P{};
    for (int i = 0; i < 25; ++i) P.in[i] = (const float*)d_in[i];
    P.out = (float*)d_out; P.ws = (unsigned char*)d_ws;
#if MK_LAUNCHES == 1
    int lo = 0, hi = NPH;
    void* args[] = {&P, &lo, &hi};
    hipError_t e = hipLaunchCooperativeKernel((const void*)mega_fwd, dim3(grid), dim3(512), args, LDS_BYTES, stream);
    if (e != hipSuccess) fprintf(stderr, "kernel_launch: cooperative launch failed: %s\n", hipGetErrorString(e));
#else
    for (int k = 0; k < NPH; ++k) {
        int lo = k, hi = k + 1;
        void* args[] = {&P, &lo, &hi};
        hipError_t e = hipLaunchCooperativeKernel((const void*)mega_fwd, dim3(grid), dim3(512), args, LDS_BYTES, stream);
        if (e != hipSuccess) { fprintf(stderr, "kernel_launch: launch %d failed: %s\n", k, hipGetErrorString(e)); break; }
    }
#endif
}
```

```cpp
#include <hip/hip_runtime.h>
#include <hip/hip_cooperative_groups.h>
#include <cstdio>
#include <cstdint>
namespace cg = cooperative_groups;

#ifndef MK_LAUNCHES
#define MK_LAUNCHES 1
#endif

#define LAS __attribute__((address_space(3)))
typedef unsigned short bf16_t;
typedef short bf16x8 __attribute__((ext_vector_type(8)));
typedef float f32x4 __attribute__((ext_vector_type(4)));
typedef float f32x2 __attribute__((ext_vector_type(2)));
typedef float f32x16 __attribute__((ext_vector_type(16)));
typedef unsigned u32x4 __attribute__((ext_vector_type(4)));
typedef unsigned u32x2 __attribute__((ext_vector_type(2)));

constexpr int S = 8192, D = 2048, DIN = 10272, DA = 2048, DSSM = 2048, DXBC = 4096, NH = 32, NGRP = 8, NST = 128;
constexpr int DFF = 5632, DPLE = 256, DMIX = 4096, NCH = 64, CH = 128, NGA = 16;
constexpr float EPS = 1e-6f;
constexpr int NPH = 10;

constexpr size_t MiB = 1u << 20;
constexpr size_t WS_WUP = 1 * MiB;
constexpr size_t WS_WDN = 45 * MiB;
constexpr size_t WS_WPG = 67 * MiB;
constexpr size_t WS_WPLE = 75 * MiB;
constexpr size_t WS_WIN = 76 * MiB;
constexpr size_t WS_WOUT = 117 * MiB;
constexpr size_t WS_UV = 133 * MiB;
constexpr size_t WS_ACT = 133 * MiB;
constexpr size_t WS_ZS = 197 * MiB;
constexpr size_t WS_XBC = 229 * MiB;
constexpr size_t WS_HG = 229 * MiB;
constexpr size_t WS_H2G = 229 * MiB;
constexpr size_t WS_A = 293 * MiB;
constexpr size_t WS_ST = 293 * MiB;
constexpr size_t WS_E = 293 * MiB;
constexpr size_t WS_P16 = 325 * MiB;
constexpr size_t WS_DT = 329 * MiB;
constexpr size_t WS_SSQA = 330 * MiB;
constexpr size_t WS_SSQ1 = 331 * MiB;
constexpr size_t WS_SSQ2 = WS_SSQ1 + 256 * 1024;
constexpr size_t WS_SSQ3 = WS_SSQ2 + 256 * 1024;
constexpr size_t WS_CDEC = WS_SSQ3 + 256 * 1024;
constexpr size_t WS_GSCR = 332 * MiB;
constexpr size_t WS_END = 348 * MiB;

constexpr int LDS_BYTES = 163840;

struct Params {
    const float* in[25];
    float* out;
    unsigned char* ws;
};

__device__ __forceinline__ unsigned f2bf(float f) { unsigned u = __builtin_bit_cast(unsigned, f); return (u + 0x7fffu + ((u >> 16) & 1u)) >> 16; }
__device__ __forceinline__ unsigned pk2(float lo, float hi) { return f2bf(lo) | (f2bf(hi) << 16); }
__device__ __forceinline__ float bf2f(unsigned short b) { return __builtin_bit_cast(float, ((unsigned)b) << 16); }
__device__ __forceinline__ float bflo(unsigned w) { return __builtin_bit_cast(float, w << 16); }
__device__ __forceinline__ float bfhi(unsigned w) { return __builtin_bit_cast(float, w & 0xffff0000u); }
__device__ __forceinline__ float fast_sigmoid(float x) { return __builtin_amdgcn_rcpf(1.0f + __builtin_amdgcn_exp2f(-1.4426950408889634f * x)); }
__device__ __forceinline__ float silu_f(float x) { return x * fast_sigmoid(x); }
__device__ __forceinline__ float gelu_tanh_f(float x) { const float t = x + 0.044715f * x * x * x; return x * __builtin_amdgcn_rcpf(1.0f + __builtin_amdgcn_exp2f(-2.3022081986f * t)); }
__device__ __forceinline__ float wave_sum(float v) {
#pragma unroll
    for (int o = 1; o < 64; o <<= 1) v += __shfl_xor(v, o);
    return v;
}

namespace pg8 {
constexpr int BM = 256, BK = 64, HALF = 128, HTB = HALF * BK * 2, STAGE_BYTES = 8 * HTB, NXCD = 8, WGM = 8;
__host__ __device__ __forceinline__ int lds_byte(int r, int c) { const int st = (r >> 4) * 2 + (c >> 5), rr = r & 15, cc = c & 31, ob = rr * 64 + cc * 2; return st * 1024 + (ob ^ (((ob >> 9) & 1) << 5)); }
__host__ __device__ __forceinline__ void stage_rc(int b, int& R, int& C) { const int st = b / 1024, sb = b % 1024, swz = sb ^ (((sb >> 9) & 1) << 5); R = (st >> 1) * 16 + swz / 64; C = (st & 1) * 32 + (swz % 64) / 2; }
__host__ __device__ __forceinline__ int perm32(int rho) { const int n = rho >> 4, i = rho & 15; return 8 * (i >> 2) + 4 * n + (i & 3); }

struct Unit { int pm, pn; };
struct Gemm { const bf16_t* A; const bf16_t* Bt; int K; };

struct StaticOrder {
    int nM, nN, nwg, G, c;
    __device__ void init(int nM_, int nN_, int G_, int c_) { nM = nM_; nN = nN_; nwg = nM * nN; G = G_; c = c_; }
    __device__ bool next(int i, Unit& u) const {
        const long L = (long)i * G + c; if (L >= nwg) return false;
        int wgid = (int)L; { const int q = nwg / NXCD, r = nwg % NXCD, xcd = wgid % NXCD, off = wgid / NXCD; wgid = (xcd < r ? xcd * (q + 1) : r * (q + 1) + (xcd - r) * q) + off; }
        const int nig = WGM * nN, gid = wgid / nig, fm = gid * WGM, gsz = (nM - fm) < WGM ? (nM - fm) : WGM;
        u.pm = fm + ((wgid % nig) % gsz); u.pn = (wgid % nig) / gsz; return true;
    }
};

__device__ __forceinline__ unsigned cvt_pk_bf16(float lo, float hi) { unsigned r; asm volatile("v_cvt_pk_bf16_f32 %0, %1, %2" : "=v"(r) : "v"(lo), "v"(hi)); return r; }

template <class Epi, bool ALIGN_EPI, bool SP2>
__device__ __forceinline__ void gemm_phase(LAS unsigned char* lds, const Gemm g, const StaticOrder& S, const Epi& E) {
    const int tid = threadIdx.x, wid = __builtin_amdgcn_readfirstlane(tid >> 6), lane = tid & 63, wr = wid >> 2, wc = wid & 3, fr = lane & 15, fq = lane >> 4;
    const int K = g.K, nt = K / BK;
    unsigned voffA[2], voffB[2];
#pragma unroll
    for (int i = 0; i < 2; ++i) { int R, C; stage_rc(tid * 16 + i * 8192, R, C); const int Rb = (R & ~31) + perm32(R & 31);
        voffA[i] = (unsigned)(R * K + C) * 2u; voffB[i] = (unsigned)(Rb * K + C) * 2u; }
    const size_t kstep = (size_t)(BK * 2);
    const size_t hstep = (size_t)HALF * K * 2;
    const size_t tstep = 2 * hstep;
    const unsigned ldsw = (unsigned)wid * 1024u;
    const int aoff = lds_byte(wr * 64 + fr, fq * 8), boff = lds_byte(wc * 32 + fr, fq * 8);
#define PG8_SA(b, h) (((b) * 2 + (h)) * HTB)
#define PG8_SB(b, h) ((4 + (b) * 2 + (h)) * HTB)
#define PG8_STAGE(bufoff, gbase, voff) do { _Pragma("unroll") for (int _i = 0; _i < 2; ++_i) \
        __builtin_amdgcn_global_load_lds((const unsigned*)((const char*)(gbase) + (voff)[_i]), (LAS unsigned*)(lds + (bufoff) + ldsw + _i * 8192), 16, 0, 0); } while (0)
#define PG8_LDA(dst, b, h) do { _Pragma("unroll") for (int m = 0; m < 4; ++m) _Pragma("unroll") for (int k = 0; k < 2; ++k) dst[m][k] = *(const LAS bf16x8*)(lds + PG8_SA(b, h) + aoff + m * 2048 + k * 1024); } while (0)
#define PG8_LDB(dst, b, h) do { _Pragma("unroll") for (int n = 0; n < 2; ++n) _Pragma("unroll") for (int k = 0; k < 2; ++k) dst[n][k] = *(const LAS bf16x8*)(lds + PG8_SB(b, h) + boff + n * 2048 + k * 1024); } while (0)
#define PG8_MMA(ai, bj, At, Bt) do { __builtin_amdgcn_s_setprio(1); _Pragma("unroll") for (int m = 0; m < 4; ++m) _Pragma("unroll") for (int n = 0; n < 2; ++n) _Pragma("unroll") for (int k = 0; k < 2; ++k) \
        acc[ai][bj][m][n] = __builtin_amdgcn_mfma_f32_16x16x32_bf16(Bt[n][k], At[m][k], acc[ai][bj][m][n], 0, 0, 0); __builtin_amdgcn_s_setprio(0); } while (0)
#define PG8_WAIT_V(n) asm volatile("s_waitcnt vmcnt(" #n ")" ::: "memory")
#define PG8_WAIT_L(n) asm volatile("s_waitcnt lgkmcnt(" #n ")" ::: "memory")
#define PG8_BAR __builtin_amdgcn_s_barrier()
#define PG8_SCHED __builtin_amdgcn_sched_barrier(0)
    Unit cur, nxt; int ui = 0;
    if (!S.next(0, cur)) return;
    f32x4 acc[2][2][4][2];
#pragma unroll
    for (int a = 0; a < 2; ++a)
#pragma unroll
        for (int b = 0; b < 2; ++b)
#pragma unroll
            for (int m = 0; m < 4; ++m)
#pragma unroll
                for (int n = 0; n < 2; ++n) acc[a][b][m][n] = (f32x4){0.f, 0.f, 0.f, 0.f};
    bf16x8 At[4][2], B0[2][2], B1[2][2];
    const char* cA = (const char*)g.A + (size_t)cur.pm * tstep; const char* cB = (const char*)g.Bt + (size_t)cur.pn * tstep;
    if constexpr (SP2) {
        PG8_STAGE(PG8_SB(0, 0), cB, voffB); PG8_STAGE(PG8_SB(0, 1), cB + hstep, voffB); PG8_STAGE(PG8_SA(0, 0), cA, voffA); PG8_STAGE(PG8_SA(0, 1), cA + hstep, voffA);
        if (wr == 1) PG8_BAR;
        PG8_WAIT_V(2); PG8_BAR;
        PG8_STAGE(PG8_SB(1, 0), cB + kstep, voffB); PG8_STAGE(PG8_SA(1, 0), cA + kstep, voffA); PG8_STAGE(PG8_SB(1, 1), cB + hstep + kstep, voffB);
        PG8_WAIT_V(6); PG8_BAR;
    } else {
        PG8_STAGE(PG8_SB(0, 0), cB, voffB); PG8_STAGE(PG8_SA(0, 0), cA, voffA); PG8_STAGE(PG8_SB(0, 1), cB + hstep, voffB); PG8_STAGE(PG8_SA(0, 1), cA + hstep, voffA);
        if (wr == 1) PG8_BAR;
        PG8_WAIT_V(4); PG8_BAR;
        PG8_STAGE(PG8_SB(1, 0), cB + kstep, voffB); PG8_STAGE(PG8_SA(1, 0), cA + kstep, voffA); PG8_STAGE(PG8_SB(1, 1), cB + hstep + kstep, voffB);
        PG8_WAIT_V(6); PG8_BAR;
    }
    for (;;) {
        const bool has_next = S.next(ui + 1, nxt);
        const char* nA = has_next ? (const char*)g.A + (size_t)nxt.pm * tstep : cA; const char* nB = has_next ? (const char*)g.Bt + (size_t)nxt.pn * tstep : cB;
#pragma nounroll
        for (int t = 0; t < nt; t += 2) {
            const bool last = (t == nt - 2);
            const char* a1 = cA + (size_t)(t + 1) * kstep;
            const char* a2 = last ? nA : cA + (size_t)(t + 2) * kstep; const char* b2 = last ? nB : cB + (size_t)(t + 2) * kstep;
            const char* a3 = a2 + kstep; const char* b3 = b2 + kstep;
            if constexpr (SP2) {
            PG8_LDB(B0, 0, 0); PG8_LDB(B1, 0, 1); PG8_SCHED; PG8_LDA(At, 0, 0); PG8_STAGE(PG8_SA(1, 1), a1 + hstep, voffA);
            PG8_WAIT_V(8); PG8_WAIT_L(0); PG8_BAR; PG8_MMA(0, 0, At, B0); PG8_MMA(0, 1, At, B1); PG8_BAR; PG8_SCHED;
            PG8_LDA(At, 0, 1); PG8_STAGE(PG8_SB(0, 0), b2, voffB); PG8_STAGE(PG8_SB(0, 1), b2 + hstep, voffB); PG8_STAGE(PG8_SA(0, 0), a2, voffA);
            PG8_WAIT_V(8); PG8_WAIT_L(0); PG8_BAR; PG8_MMA(1, 0, At, B0); PG8_MMA(1, 1, At, B1); PG8_BAR; PG8_SCHED;
            PG8_LDB(B0, 1, 0); PG8_LDB(B1, 1, 1); PG8_SCHED; PG8_LDA(At, 1, 0); PG8_STAGE(PG8_SA(0, 1), a2 + hstep, voffA);
            PG8_WAIT_V(8); PG8_WAIT_L(0); PG8_BAR; PG8_MMA(0, 0, At, B0); PG8_MMA(0, 1, At, B1); PG8_BAR; PG8_SCHED;
            PG8_LDA(At, 1, 1); PG8_STAGE(PG8_SB(1, 0), b3, voffB); PG8_STAGE(PG8_SB(1, 1), b3 + hstep, voffB); PG8_STAGE(PG8_SA(1, 0), a3, voffA);
            PG8_WAIT_V(8); PG8_WAIT_L(0); PG8_BAR; PG8_MMA(1, 0, At, B0); PG8_MMA(1, 1, At, B1); PG8_BAR; PG8_SCHED;
            } else {
            PG8_LDB(B0, 0, 0); PG8_SCHED; PG8_LDA(At, 0, 0); PG8_STAGE(PG8_SA(1, 1), a1 + hstep, voffA);
            PG8_WAIT_L(8); PG8_BAR; PG8_WAIT_L(0); PG8_MMA(0, 0, At, B0); PG8_BAR; PG8_SCHED;
            PG8_LDB(B1, 0, 1); PG8_STAGE(PG8_SB(0, 0), b2, voffB);
            PG8_BAR; PG8_WAIT_L(0); PG8_MMA(0, 1, At, B1); PG8_BAR;
            PG8_LDA(At, 0, 1); PG8_STAGE(PG8_SA(0, 0), a2, voffA);
            PG8_BAR; PG8_WAIT_L(0); PG8_MMA(1, 0, At, B0); PG8_BAR; PG8_SCHED;
            PG8_STAGE(PG8_SB(0, 1), b2 + hstep, voffB);
            PG8_WAIT_V(6); PG8_BAR; PG8_MMA(1, 1, At, B1); PG8_BAR;
            PG8_LDB(B0, 1, 0); PG8_SCHED; PG8_LDA(At, 1, 0); PG8_STAGE(PG8_SA(0, 1), a2 + hstep, voffA);
            PG8_WAIT_L(8); PG8_BAR; PG8_WAIT_L(0); PG8_MMA(0, 0, At, B0); PG8_BAR; PG8_SCHED;
            PG8_LDB(B1, 1, 1); PG8_STAGE(PG8_SB(1, 0), b3, voffB);
            PG8_BAR; PG8_WAIT_L(0); PG8_MMA(0, 1, At, B1); PG8_BAR;
            PG8_LDA(At, 1, 1); PG8_STAGE(PG8_SA(1, 0), a3, voffA);
            PG8_BAR; PG8_WAIT_L(0); PG8_MMA(1, 0, At, B0); PG8_BAR; PG8_SCHED;
            PG8_STAGE(PG8_SB(1, 1), b3 + hstep, voffB);
            PG8_WAIT_V(6); PG8_BAR; PG8_MMA(1, 1, At, B1); PG8_BAR;
            }
        }
        if constexpr (ALIGN_EPI) { if (wr == 0) PG8_BAR; }
        if constexpr (!Epi::AFTER_DRAIN) { E(acc, cur, wr, wc, fr, fq); }
        if (!has_next) break;
#pragma unroll
        for (int a = 0; a < 2; ++a)
#pragma unroll
            for (int b = 0; b < 2; ++b)
#pragma unroll
                for (int m = 0; m < 4; ++m)
#pragma unroll
                    for (int n = 0; n < 2; ++n) acc[a][b][m][n] = (f32x4){0.f, 0.f, 0.f, 0.f};
        cur = nxt; cA = nA; cB = nB; ++ui;
        if constexpr (ALIGN_EPI) { if (wr == 1) PG8_BAR; }
    }
    PG8_WAIT_V(0);
    if constexpr (!ALIGN_EPI) { if (wr == 0) PG8_BAR; }
    PG8_BAR;
    if constexpr (Epi::AFTER_DRAIN) { E.fused(acc, cur, wr, wc, fr, fq, lds, wid, lane); }
#undef PG8_SA
#undef PG8_SB
#undef PG8_STAGE
#undef PG8_LDA
#undef PG8_LDB
#undef PG8_MMA
#undef PG8_WAIT_V
#undef PG8_WAIT_L
#undef PG8_BAR
#undef PG8_SCHED
}
}
using pg8::Unit; using pg8::cvt_pk_bf16;
typedef f32x4 AccT[2][2][4][2];

__device__ __forceinline__ u32x4 pack8(const f32x4 v0, const f32x4 v1) { u32x4 w; w.x = cvt_pk_bf16(v0[0], v0[1]); w.y = cvt_pk_bf16(v0[2], v0[3]); w.z = cvt_pk_bf16(v1[0], v1[1]); w.w = cvt_pk_bf16(v1[2], v1[3]); return w; }

struct EpiProj {
    static constexpr bool AFTER_DRAIN = false;
    bf16_t *uv, *zs, *xbc;
    __device__ __forceinline__ void operator()(const AccT& acc, const Unit& u, int wr, int wc, int fr, int fq) const {
        const int row0 = u.pm * 256 + wr * 64 + fr; const int ct = wc * 32 + 8 * fq;
        bf16_t* base; int ld, mode;
        if (u.pn < 16) { base = uv + u.pn * 256; ld = DMIX; mode = 0; }
        else if (u.pn < 24) { base = zs + (u.pn - 16) * 256; ld = DSSM; mode = 1; }
        else { base = xbc + (u.pn - 24) * 256; ld = DXBC; mode = 2; }
#pragma unroll
        for (int ai = 0; ai < 2; ++ai)
#pragma unroll
            for (int m = 0; m < 4; ++m) { bf16_t* rowp = base + (size_t)(row0 + ai * 128 + m * 16) * ld + ct;
#pragma unroll
                for (int bj = 0; bj < 2; ++bj) { f32x4 v0 = acc[ai][bj][m][0], v1 = acc[ai][bj][m][1];
                    if (mode == 0) {
#pragma unroll
                        for (int j = 0; j < 4; ++j) { v0[j] = gelu_tanh_f(v0[j]); v1[j] = gelu_tanh_f(v1[j]); } }
                    else if (mode == 1) {
#pragma unroll
                        for (int j = 0; j < 4; ++j) { v0[j] = silu_f(v0[j]); v1[j] = silu_f(v1[j]); } }
                    *(u32x4*)(rowp + bj * 128) = pack8(v0, v1); } }
    }
};
struct EpiPlain {
    static constexpr bool AFTER_DRAIN = false;
    bf16_t* O; int ld;
    __device__ __forceinline__ void operator()(const AccT& acc, const Unit& u, int wr, int wc, int fr, int fq) const {
        const int row0 = u.pm * 256 + wr * 64 + fr; const int col0 = u.pn * 256 + wc * 32 + 8 * fq;
#pragma unroll
        for (int ai = 0; ai < 2; ++ai)
#pragma unroll
            for (int m = 0; m < 4; ++m) { bf16_t* rowp = O + (size_t)(row0 + ai * 128 + m * 16) * ld + col0;
#pragma unroll
                for (int bj = 0; bj < 2; ++bj) *(u32x4*)(rowp + bj * 128) = pack8(acc[ai][bj][m][0], acc[ai][bj][m][1]); }
    }
};
struct EpiResid {
    static constexpr bool AFTER_DRAIN = true;
    const float* base; float* out; bf16_t* hn; bf16_t* halo; const float* gain; float* ssq;
    __device__ __forceinline__ void fused(AccT& acc, const Unit& u, int wr, int wc, int fr, int fq, LAS unsigned char* lds, int wid, int lane) const {
        asm volatile("" : "+v"(fr), "+v"(fq));
        LAS float* P = (LAS float*)lds;
        const int col0 = u.pn * 256 + wc * 32 + 8 * fq;
#pragma unroll
        for (int ai = 0; ai < 2; ++ai)
#pragma unroll
            for (int m = 0; m < 4; ++m) { const int rl = ai * 128 + wr * 64 + m * 16 + fr; const int row = u.pm * 256 + rl; const size_t off = (size_t)row * D + col0;
                float ss = 0.f;
                bf16_t* hrow = nullptr;
                if (halo) { const int r6 = row & 63; if (r6 >= 62) { if ((row >> 6) <= 126) hrow = halo + (size_t)(4 * (row >> 6) + (row & 1)) * D; } else if (r6 < 2 && row >= 64) hrow = halo + (size_t)(4 * ((row >> 6) - 1) + 2 + (row & 1)) * D; }
#pragma unroll
                for (int bj = 0; bj < 2; ++bj) { const f32x4 b0 = *(const f32x4*)(base + off + bj * 128), b1 = *(const f32x4*)(base + off + bj * 128 + 4);
                    const f32x4 v0 = acc[ai][bj][m][0] + b0, v1 = acc[ai][bj][m][1] + b1;
                    *(f32x4*)(out + off + bj * 128) = v0; *(f32x4*)(out + off + bj * 128 + 4) = v1;
                    ss += (v0[0] * v0[0] + v0[1] * v0[1]) + (v0[2] * v0[2] + v0[3] * v0[3]) + (v1[0] * v1[0] + v1[1] * v1[1]) + (v1[2] * v1[2] + v1[3] * v1[3]);
                    const f32x4 g0 = *(const f32x4*)(gain + col0 + bj * 128), g1 = *(const f32x4*)(gain + col0 + bj * 128 + 4);
                    const u32x4 w = pack8(v0 * g0, v1 * g1);
                    *(u32x4*)(hn + off + bj * 128) = w;
                    if (hrow) *(u32x4*)(hrow + col0 + bj * 128) = w; }
                ss += __shfl_xor(ss, 16); ss += __shfl_xor(ss, 32);
                if (fq == 0) P[rl * 4 + wc] = ss;
                asm volatile("" ::: "memory"); }
        __syncthreads();
        if (threadIdx.x < 256) { const int t = threadIdx.x; ssq[(size_t)(u.pm * 256 + t) * 8 + u.pn] = (P[t * 4 + 0] + P[t * 4 + 1]) + (P[t * 4 + 2] + P[t * 4 + 3]); }
        __syncthreads();
    }
};
struct EpiPle {
    static constexpr bool AFTER_DRAIN = true;
    float* out; const bf16_t* Eb; const float* ssq_in; float* ssq;
    __device__ __forceinline__ void fused(AccT& acc, const Unit& u, int wr, int wc, int fr, int fq, LAS unsigned char* lds, int wid, int lane) const {
        asm volatile("" : "+v"(fr), "+v"(fq));
        LAS float* P = (LAS float*)lds;
        const int col0 = u.pn * 256 + wc * 32 + 8 * fq;
#pragma unroll
        for (int ai = 0; ai < 2; ++ai)
#pragma unroll
            for (int m = 0; m < 4; ++m) { const int rl = ai * 128 + wr * 64 + m * 16 + fr; const int row = u.pm * 256 + rl; const size_t off = (size_t)row * D + col0;
                const f32x4 q0 = *(const f32x4*)(ssq_in + (size_t)row * 8), q1 = *(const f32x4*)(ssq_in + (size_t)row * 8 + 4);
                const float rinv = 1.0f / sqrtf(((q0[0] + q0[1]) + (q0[2] + q0[3]) + (q1[0] + q1[1]) + (q1[2] + q1[3])) * (1.0f / D) + EPS);
                float ss = 0.f;
#pragma unroll
                for (int bj = 0; bj < 2; ++bj) { const f32x4 b0 = *(const f32x4*)(out + off + bj * 128), b1 = *(const f32x4*)(out + off + bj * 128 + 4);
                    const u32x4 ew = *(const u32x4*)(Eb + off + bj * 128);
                    f32x4 e0 = {bflo(ew.x), bfhi(ew.x), bflo(ew.y), bfhi(ew.y)}, e1 = {bflo(ew.z), bfhi(ew.z), bflo(ew.w), bfhi(ew.w)};
                    f32x4 v0, v1;
#pragma unroll
                    for (int j = 0; j < 4; ++j) { v0[j] = b0[j] + fast_sigmoid(acc[ai][bj][m][0][j] * rinv) * e0[j]; v1[j] = b1[j] + fast_sigmoid(acc[ai][bj][m][1][j] * rinv) * e1[j]; }
                    *(f32x4*)(out + off + bj * 128) = v0; *(f32x4*)(out + off + bj * 128 + 4) = v1;
                    ss += (v0[0] * v0[0] + v0[1] * v0[1]) + (v0[2] * v0[2] + v0[3] * v0[3]) + (v1[0] * v1[0] + v1[1] * v1[1]) + (v1[2] * v1[2] + v1[3] * v1[3]); }
                ss += __shfl_xor(ss, 16); ss += __shfl_xor(ss, 32);
                if (fq == 0) P[rl * 4 + wc] = ss;
                asm volatile("" ::: "memory"); }
        __syncthreads();
        if (threadIdx.x < 256) { const int t = threadIdx.x; ssq[(size_t)(u.pm * 256 + t) * 8 + u.pn] = (P[t * 4 + 0] + P[t * 4 + 1]) + (P[t * 4 + 2] + P[t * 4 + 3]); }
        __syncthreads();
    }
};
struct EpiFfn {
    static constexpr bool AFTER_DRAIN = false;
    bf16_t* act; const float* ssq1; const float* cw; const float* cb;
    __device__ __forceinline__ int grow_of(const Unit& u, int rl) const {
        if (u.pm < 32) return u.pm * 256 + rl;
        const int R = (u.pm - 32) * 256 + rl; int q = (R >> 2) + 1; if (q > 127) q = 127; return 64 * q - 2 + (R & 3);
    }
    __device__ __forceinline__ void operator()(AccT& acc, const Unit& u, int wr, int wc, int fr, int fq) const {
        asm volatile("" : "+v"(fr), "+v"(fq));
        const bool halo = u.pm >= 32;
        const int lane = fq * 16 + fr;
        const int s1 = (lane & 48) | ((fr + 15) & 15), s2 = (lane & 48) | ((fr + 14) & 15);
#pragma unroll
        for (int ai = 0; ai < 2; ++ai)
#pragma unroll
            for (int m = 0; m < 4; ++m) {
                const int gr = grow_of(u, ai * 128 + wr * 64 + m * 16 + fr);
                const f32x4 q0 = *(const f32x4*)(ssq1 + (size_t)gr * 8), q1 = *(const f32x4*)(ssq1 + (size_t)gr * 8 + 4);
                const float rinv = 1.0f / sqrtf(((q0[0] + q0[1]) + (q0[2] + q0[3]) + (q1[0] + q1[1]) + (q1[2] + q1[3])) * (1.0f / D) + EPS);
#pragma unroll
                for (int bj = 0; bj < 2; ++bj)
#pragma unroll
                    for (int n = 0; n < 2; ++n) acc[ai][bj][m][n] = acc[ai][bj][m][n] * rinv;
                asm volatile("" ::: "memory");
            }
#pragma unroll
        for (int n = 0; n < 2; ++n) {
            const int gc = u.pn * 128 + wc * 32 + 8 * fq + 4 * n;
#pragma unroll
            for (int bj = 0; bj < 2; ++bj) {
                const int cc = bj * DFF + gc;
                asm volatile("" ::: "memory");
                const f32x4 w0 = *(const f32x4*)(cw + cc), w1 = *(const f32x4*)(cw + 2 * DFF + cc), w2 = *(const f32x4*)(cw + 4 * DFF + cc), bb = *(const f32x4*)(cb + cc);
#pragma unroll
                for (int ai = 0; ai < 2; ++ai) {
                    f32x4 p1 = {0.f, 0.f, 0.f, 0.f}, p2 = p1;
#pragma unroll
                    for (int m = 0; m < 4; ++m) {
                        f32x4 v = acc[ai][bj][m][n];
                        asm volatile("" : "+v"(v));
                        f32x4 r1, r2, hh;
#pragma unroll
                        for (int j = 0; j < 4; ++j) { r1[j] = __shfl(v[j], s1); r2[j] = __shfl(v[j], s2); }
#pragma unroll
                        for (int j = 0; j < 4; ++j) { const float x1 = fr >= 1 ? r1[j] : p1[j], x2 = fr >= 2 ? r2[j] : p2[j]; hh[j] = bb[j] + w2[j] * v[j] + w1[j] * x1 + w0[j] * x2; }
                        asm volatile("" : "+v"(hh));
                        acc[ai][bj][m][n] = hh; p1 = r1; p2 = r2;
                    }
                }
            }
            asm volatile("" ::: "memory");
#pragma unroll
            for (int ai = 0; ai < 2; ++ai)
#pragma unroll
                for (int m = 0; m < 4; ++m) {
                    const int rl = ai * 128 + wr * 64 + m * 16 + fr;
                    bool st;
                    if (!halo) st = !(m == 0 && fr < 2) || (u.pm == 0 && ai == 0 && wr == 0);
                    else st = ((fr & 3) >= 2) && ((((u.pm - 32) * 256 + rl) >> 2) + 1 <= 127);
                    if (st) { const f32x4 hg_ = acc[ai][0][m][n], hu_ = acc[ai][1][m][n];
                        u32x2 w; w.x = cvt_pk_bf16(silu_f(hg_[0]) * hu_[0], silu_f(hg_[1]) * hu_[1]); w.y = cvt_pk_bf16(silu_f(hg_[2]) * hu_[2], silu_f(hg_[3]) * hu_[3]);
                        *(u32x2*)(act + (size_t)grow_of(u, rl) * DFF + gc) = w; }
                }
        }
    }
};

struct Ctx {
    LAS unsigned char* lds;
    int tid, lane, wave, nb, bid;
    const float* const* in;
    float* out;
    unsigned char* ws;
};

template <int MODE>
__device__ __forceinline__ void prep_w_item(const float* __restrict__ W, int K, int N, bf16_t* __restrict__ Wt, int item, int lane) {
    const int nkb = K / 64, nb = item / nkb, kb = item % nkb;
    const int n4 = nb * 256 + lane * 4; if (n4 >= N) return;
    int orow = n4;
    if (MODE == 1) orow = (n4 < DFF) ? 256 * (n4 >> 7) + (n4 & 127) : 256 * ((n4 - DFF) >> 7) + 128 + ((n4 - DFF) & 127);
    const float* src = W + (size_t)(kb * 64) * N + n4;
    bf16_t* dst = Wt + (size_t)orow * K + kb * 64;
#pragma unroll 2
    for (int it = 0; it < 8; ++it) {
        f32x4 v[8];
#pragma unroll
        for (int j = 0; j < 8; ++j) v[j] = *(const f32x4*)(src + (size_t)(it * 8 + j) * N);
#pragma unroll
        for (int q = 0; q < 4; ++q) { u32x4 o; o.x = pk2(v[0][q], v[1][q]); o.y = pk2(v[2][q], v[3][q]); o.z = pk2(v[4][q], v[5][q]); o.w = pk2(v[6][q], v[7][q]);
            *(u32x4*)(dst + (size_t)q * K + it * 8) = o; }
    }
}
__device__ __forceinline__ void phase_prep(const Ctx& c) {
    const int gw = c.bid * 8 + c.wave, NGW = c.nb * 8;
    const float* w_in = c.in[3]; const float* w_out = c.in[15]; const float* w_up = c.in[17]; const float* w_dn = c.in[20]; const float* w_pg = c.in[22]; const float* w_ple = c.in[23];
    constexpr int I_IN = 41 * (D / 64), I_OUT = 8 * (DMIX / 64), I_UP = 44 * (D / 64), I_DN = 8 * (DFF / 64), I_PG = 8 * (D / 64), I_PLE = 8 * (DPLE / 64);
    constexpr int NIT = I_IN + I_OUT + I_UP + I_DN + I_PG + I_PLE;
    for (int it = gw; it < NIT; it += NGW) {
        int r = it;
        if (r < I_IN) { prep_w_item<0>(w_in, D, DIN, (bf16_t*)(c.ws + WS_WIN), r, c.lane); continue; } r -= I_IN;
        if (r < I_UP) { prep_w_item<1>(w_up, D, 2 * DFF, (bf16_t*)(c.ws + WS_WUP), r, c.lane); continue; } r -= I_UP;
        if (r < I_OUT) { prep_w_item<0>(w_out, DMIX, D, (bf16_t*)(c.ws + WS_WOUT), r, c.lane); continue; } r -= I_OUT;
        if (r < I_DN) { prep_w_item<0>(w_dn, DFF, D, (bf16_t*)(c.ws + WS_WDN), r, c.lane); continue; } r -= I_DN;
        if (r < I_PG) { prep_w_item<0>(w_pg, D, D, (bf16_t*)(c.ws + WS_WPG), r, c.lane); continue; } r -= I_PG;
        prep_w_item<0>(w_ple, DPLE, D, (bf16_t*)(c.ws + WS_WPLE), r, c.lane);
    }
    const float* x = c.in[0]; const float* g = c.in[2]; bf16_t* A = (bf16_t*)(c.ws + WS_A);
    for (int m = gw; m < S; m += NGW) {
        const float* xr = x + (size_t)m * D + 8 * c.lane; f32x4 v[4][2]; float s = 0.f;
#pragma unroll
        for (int j = 0; j < 4; ++j) { v[j][0] = *(const f32x4*)(xr + 512 * j); v[j][1] = *(const f32x4*)(xr + 512 * j + 4);
#pragma unroll
            for (int e = 0; e < 4; ++e) s += v[j][0][e] * v[j][0][e] + v[j][1][e] * v[j][1][e]; }
        const float rinv = 1.0f / sqrtf(wave_sum(s) * (1.0f / D) + EPS);
#pragma unroll
        for (int j = 0; j < 4; ++j) { const f32x4 g0 = *(const f32x4*)(g + 8 * c.lane + 512 * j), g1 = *(const f32x4*)(g + 8 * c.lane + 512 * j + 4);
            const f32x4 a0 = v[j][0] * rinv * g0, a1 = v[j][1] * rinv * g1;
            u32x4 o; o.x = pk2(a0[0], a0[1]); o.y = pk2(a0[2], a0[3]); o.z = pk2(a1[0], a1[1]); o.w = pk2(a1[2], a1[3]);
            *(u32x4*)(A + (size_t)m * D + 8 * c.lane + 512 * j) = o; }
    }
    const float* p = c.in[1]; bf16_t* P16 = (bf16_t*)(c.ws + WS_P16);
    for (size_t i = ((size_t)c.bid * 512 + c.tid) * 8; i < (size_t)S * DPLE; i += (size_t)c.nb * 512 * 8) {
        const f32x4 a0 = *(const f32x4*)(p + i), a1 = *(const f32x4*)(p + i + 4);
        u32x4 o; o.x = pk2(a0[0], a0[1]); o.y = pk2(a0[2], a0[3]); o.z = pk2(a1[0], a1[1]); o.w = pk2(a1[2], a1[3]);
        *(u32x4*)(P16 + i) = o;
    }
}

__device__ __forceinline__ void phase_dt(const Ctx& c) {
    const bf16_t* A = (const bf16_t*)(c.ws + WS_A); const bf16_t* Wdt = (const bf16_t*)(c.ws + WS_WIN) + (size_t)10240 * D;
    float* dt = (float*)(c.ws + WS_DT); const float* dtb = c.in[11];
    LAS float* red = (LAS float*)c.lds;
    const int r = c.lane & 31, h = c.lane >> 5;
    for (int item = c.bid; item < S / 32; item += c.nb) {
        const int row0 = item * 32;
        f32x16 acc; for (int i = 0; i < 16; ++i) acc[i] = 0.f;
        const bf16_t* ap = A + (size_t)(row0 + r) * D + c.wave * 256 + 8 * h;
        const bf16_t* bp = Wdt + (size_t)r * D + c.wave * 256 + 8 * h;
#pragma unroll 4
        for (int s = 0; s < 16; ++s) { const bf16x8 af = *(const bf16x8*)(ap + 16 * s), bfr = *(const bf16x8*)(bp + 16 * s);
            acc = __builtin_amdgcn_mfma_f32_32x32x16_bf16(af, bfr, acc, 0, 0, 0); }
#pragma unroll
        for (int i = 0; i < 16; ++i) red[(c.wave * 32 + ((i & 3) + 8 * (i >> 2) + 4 * h)) * 32 + r] = acc[i];
        __syncthreads();
        for (int o = c.tid; o < 1024; o += 512) { float s = 0.f;
#pragma unroll
            for (int w = 0; w < 8; ++w) s += red[w * 1024 + o];
            const int hd = o & 31; const float xv = s + dtb[hd];
            const float sp = xv > 20.f ? xv : log1pf(__expf(xv));
            dt[(size_t)(row0 + (o >> 5)) * 32 + hd] = sp; }
        __syncthreads();
    }
}

template <int W>
__device__ __forceinline__ void stage_conv_tile(const Ctx& c, LAS unsigned char* dst, int pitchB, int col0, int t0, const LAS float* scale) {
    const bf16_t* xbc = (const bf16_t*)(c.ws + WS_XBC); const float* cw = c.in[9]; const float* cb = c.in[10];
    constexpr int NCHK = W / 8, NGRPS = 512 / NCHK, RPT = 128 / NGRPS;
    const int ch = c.tid % NCHK, grp = c.tid / NCHK; const int cc = col0 + ch * 8;
    float w[4][8], b[8];
#pragma unroll
    for (int k = 0; k < 4; ++k) { const f32x4 a0 = *(const f32x4*)(cw + (size_t)k * DXBC + cc), a1 = *(const f32x4*)(cw + (size_t)k * DXBC + cc + 4);
#pragma unroll
        for (int e = 0; e < 4; ++e) { w[k][e] = a0[e]; w[k][4 + e] = a1[e]; } }
    { const f32x4 a0 = *(const f32x4*)(cb + cc), a1 = *(const f32x4*)(cb + cc + 4);
#pragma unroll
      for (int e = 0; e < 4; ++e) { b[e] = a0[e]; b[4 + e] = a1[e]; } }
    const int r0 = grp * RPT;
    float x0[8], x1[8], x2[8];
#pragma unroll
    for (int e = 0; e < 8; ++e) { x0[e] = 0.f; x1[e] = 0.f; x2[e] = 0.f; }
    {
        const int t = t0 + r0;
        if (t - 3 >= 0) { const u32x4 q = *(const u32x4*)(xbc + (size_t)(t - 3) * DXBC + cc); x0[0] = bflo(q.x); x0[1] = bfhi(q.x); x0[2] = bflo(q.y); x0[3] = bfhi(q.y); x0[4] = bflo(q.z); x0[5] = bfhi(q.z); x0[6] = bflo(q.w); x0[7] = bfhi(q.w); }
        if (t - 2 >= 0) { const u32x4 q = *(const u32x4*)(xbc + (size_t)(t - 2) * DXBC + cc); x1[0] = bflo(q.x); x1[1] = bfhi(q.x); x1[2] = bflo(q.y); x1[3] = bfhi(q.y); x1[4] = bflo(q.z); x1[5] = bfhi(q.z); x1[6] = bflo(q.w); x1[7] = bfhi(q.w); }
        if (t - 1 >= 0) { const u32x4 q = *(const u32x4*)(xbc + (size_t)(t - 1) * DXBC + cc); x2[0] = bflo(q.x); x2[1] = bfhi(q.x); x2[2] = bflo(q.y); x2[3] = bfhi(q.y); x2[4] = bflo(q.z); x2[5] = bfhi(q.z); x2[6] = bflo(q.w); x2[7] = bfhi(q.w); }
    }
#pragma unroll
    for (int i = 0; i < RPT; ++i) {
        const int rl = r0 + i, t = t0 + rl;
        const u32x4 q = *(const u32x4*)(xbc + (size_t)t * DXBC + cc);
        float x3[8]; x3[0] = bflo(q.x); x3[1] = bfhi(q.x); x3[2] = bflo(q.y); x3[3] = bfhi(q.y); x3[4] = bflo(q.z); x3[5] = bfhi(q.z); x3[6] = bflo(q.w); x3[7] = bfhi(q.w);
        float sc = 1.f; if (scale) sc = scale[rl * 4 + (ch * 8) / 64];
        float o[8];
#pragma unroll
        for (int e = 0; e < 8; ++e) { const float hsum = b[e] + w[0][e] * x0[e] + w[1][e] * x1[e] + w[2][e] * x2[e] + w[3][e] * x3[e]; o[e] = silu_f(hsum) * sc; x0[e] = x1[e]; x1[e] = x2[e]; x2[e] = x3[e]; }
        u32x4 ov; ov.x = pk2(o[0], o[1]); ov.y = pk2(o[2], o[3]); ov.z = pk2(o[4], o[5]); ov.w = pk2(o[6], o[7]);
        *(LAS u32x4*)(dst + rl * pitchB + ch * 16) = ov;
    }
}

__device__ __forceinline__ void ssd_tables(const Ctx& c, int ck, int g, LAS float* sdt, LAS float* sacs) {
    const float* dt = (const float*)(c.ws + WS_DT); const float* alog = c.in[12];
    { const int l = c.tid >> 2, h = c.tid & 3; const float dv = dt[(size_t)(ck * 128 + l) * 32 + g * 4 + h]; sdt[l * 4 + h] = dv; sacs[l * 4 + h] = dv * (-__expf(alog[g * 4 + h])); }
    __syncthreads();
    if (c.wave < 4) { const int h = c.wave; const float v0 = sacs[(2 * c.lane) * 4 + h], v1 = sacs[(2 * c.lane + 1) * 4 + h]; float s = v0 + v1;
#pragma unroll
        for (int d = 1; d < 64; d <<= 1) { const float t = __shfl_up(s, d); if (c.lane >= d) s += t; }
        const float ex = s - (v0 + v1);
        sacs[(2 * c.lane) * 4 + h] = ex + v0; sacs[(2 * c.lane + 1) * 4 + h] = s; }
    __syncthreads();
}

constexpr int XS_PITCH = 576, BC_PITCH = 320;
constexpr int L_XS = 0, L_B = 128 * XS_PITCH, L_C = L_B + 128 * BC_PITCH, L_TAB = L_C + 128 * BC_PITCH;
constexpr int L_SDT = L_TAB, L_SACS = L_TAB + 2048, L_SW = L_TAB + 4096, L_MISC = L_TAB + 6144;
static_assert(L_MISC + 2048 <= LDS_BYTES, "mixer LDS map");

__device__ __forceinline__ void ssd_a_item(const Ctx& c, int ck, int g) {
    LAS float* sdt = (LAS float*)(c.lds + L_SDT); LAS float* sacs = (LAS float*)(c.lds + L_SACS); LAS float* sw = (LAS float*)(c.lds + L_SW);
    ssd_tables(c, ck, g, sdt, sacs);
    { const int l = c.tid >> 2, h = c.tid & 3; sw[l * 4 + h] = sdt[l * 4 + h] * __expf(sacs[127 * 4 + h] - sacs[l * 4 + h]); }
    if (c.tid < 4) ((float*)(c.ws + WS_CDEC))[ck * 32 + g * 4 + c.tid] = __expf(sacs[127 * 4 + c.tid]);
    __syncthreads();
    stage_conv_tile<256>(c, c.lds + L_XS, XS_PITCH, g * 256, ck * 128, sw);
    stage_conv_tile<128>(c, c.lds + L_B, BC_PITCH, DSSM + g * 128, ck * 128, nullptr);
    __syncthreads();
    bf16_t* st = (bf16_t*)(c.ws + WS_ST) + (size_t)(ck * 32 + g * 4) * 64 * 128;
    for (int o = c.tid; o < 4 * 64 * 128; o += 512) { const int n = o & 127, hp = o >> 7; float s = 0.f;
        for (int l = 0; l < 128; ++l) s += bf2f(*(LAS bf16_t*)(c.lds + L_B + l * BC_PITCH + n * 2)) * bf2f(*(LAS bf16_t*)(c.lds + L_XS + l * XS_PITCH + hp * 2));
        st[o] = (bf16_t)f2bf(s); }
    __syncthreads();
}

__device__ __forceinline__ void gmlp_item(const Ctx& c, int ck, int g) {
    bf16_t* uv = (bf16_t*)(c.ws + WS_UV);
    LAS float* vn = (LAS float*)c.lds;
    LAS float* ssq = (LAS float*)(c.lds + 65536);
    const float* lng = c.in[4] + g * 128; const float* lnb = c.in[5] + g * 128; const float* Ws = c.in[6] + (size_t)g * 128 * 128; const float* bs = c.in[7] + g * 128; const float* nag = c.in[8] + g * 128;
    for (int s = c.wave; s < 128; s += 8) {
        const bf16_t* vr = uv + (size_t)(ck * 128 + s) * DMIX + DA + g * 128;
        const float a0 = bf2f(vr[c.lane]), a1 = bf2f(vr[c.lane + 64]);
        const float mu = wave_sum(a0 + a1) * (1.0f / 128.0f); const float d0 = a0 - mu, d1 = a1 - mu;
        const float var = wave_sum(d0 * d0 + d1 * d1) * (1.0f / 128.0f); const float rs = 1.0f / sqrtf(var + EPS);
        vn[s * 128 + c.lane] = d0 * rs * lng[c.lane] + lnb[c.lane]; vn[s * 128 + c.lane + 64] = d1 * rs * lng[c.lane + 64] + lnb[c.lane + 64];
    }
    __syncthreads();
    const int d = c.tid & 127;
    for (int j = 0; j < 32; ++j) {
        const int t = (c.tid >> 7) + 4 * j; float sg = bs[t]; const float* wr_ = Ws + t * 128;
        for (int s = 0; s <= t; ++s) sg += wr_[s] * vn[s * 128 + d];
        bf16_t* up = uv + (size_t)(ck * 128 + t) * DMIX + g * 128 + d;
        const float y = bf2f(*up) * sg;
        *up = (bf16_t)f2bf(y * nag[d]);
        const float q = wave_sum(y * y);
        if (c.lane == 0) ssq[t * 2 + (c.wave & 1)] = q;
    }
    __syncthreads();
    if (c.tid < 128) ((float*)(c.ws + WS_SSQA))[(size_t)(ck * 128 + c.tid) * 16 + g] = ssq[c.tid * 2] + ssq[c.tid * 2 + 1];
    __syncthreads();
}

typedef short s16x4 __attribute__((ext_vector_type(4)));
typedef short v4i16_t __attribute__((ext_vector_type(4)));
__device__ __forceinline__ s16x4 ds_tr(LAS const unsigned char* p) { return __builtin_bit_cast(s16x4, __builtin_amdgcn_ds_read_tr16_b64_v4i16((LAS v4i16_t*)p)); }
__device__ __forceinline__ bf16x8 frag_tr(LAS const unsigned char* tile, int pitch, int k0, int c0, int lane) {
    const int hh = lane >> 5, blk = (lane >> 4) & 1, q = (lane & 15) >> 2, p = lane & 3;
    LAS const unsigned char* a = tile + (k0 + 8 * hh + q) * pitch + (c0 + 16 * blk + 4 * p) * 2;
    const s16x4 lo = ds_tr(a), hi = ds_tr(a + 4 * pitch);
    return __builtin_shufflevector(lo, hi, 0, 1, 2, 3, 4, 5, 6, 7);
}
__device__ __forceinline__ bf16x8 frag_tr_perm(LAS const unsigned char* tile, int pitch, int k0, int c0, int lane) {
    const int hh = lane >> 5, blk = (lane >> 4) & 1, q = (lane & 15) >> 2, p = lane & 3;
    LAS const unsigned char* a = tile + (k0 + 4 * hh + q) * pitch + (c0 + 16 * blk + 4 * p) * 2;
    const s16x4 lo = ds_tr(a), hi = ds_tr(a + 8 * pitch);
    return __builtin_shufflevector(lo, hi, 0, 1, 2, 3, 4, 5, 6, 7);
}
__device__ __forceinline__ bf16x8 frag_row(LAS const unsigned char* tile, int pitch, int r0, int k0, int lane) {
    return *(LAS const bf16x8*)(tile + (r0 + (lane & 31)) * pitch + (k0 + 8 * (lane >> 5)) * 2);
}
__device__ __forceinline__ bf16x8 pack_frag(const float* v) {
    u32x4 w; w.x = cvt_pk_bf16(v[0], v[1]); w.y = cvt_pk_bf16(v[2], v[3]); w.z = cvt_pk_bf16(v[4], v[5]); w.w = cvt_pk_bf16(v[6], v[7]);
    return __builtin_bit_cast(bf16x8, w);
}
#define MFMA32(a, b, c) __builtin_amdgcn_mfma_f32_32x32x16_bf16((a), (b), (c), 0, 0, 0)

__device__ __forceinline__ void gmlp_item_mfma(const Ctx& c, int ck, int g) {
    constexpr int VP = 320;
    bf16_t* uv = (bf16_t*)(c.ws + WS_UV);
    LAS unsigned char* vt = c.lds;
    LAS float* part = (LAS float*)(c.lds + 128 * VP);
    const float* lng = c.in[4] + g * 128; const float* lnb = c.in[5] + g * 128; const float* Ws = c.in[6] + (size_t)g * 128 * 128; const float* bs = c.in[7] + g * 128; const float* nag = c.in[8] + g * 128;
    const int lane = c.lane;
    { const f32x2 gg = *(const f32x2*)(lng + 2 * lane), bb = *(const f32x2*)(lnb + 2 * lane);
      for (int s = c.wave; s < 128; s += 8) {
        const unsigned w = *(const unsigned*)(uv + (size_t)(ck * 128 + s) * DMIX + DA + g * 128 + 2 * lane);
        const float a0 = bflo(w), a1 = bfhi(w);
        const float mu = wave_sum(a0 + a1) * (1.0f / 128.0f); const float d0 = a0 - mu, d1 = a1 - mu;
        const float var = wave_sum(d0 * d0 + d1 * d1) * (1.0f / 128.0f); const float rs = 1.0f / sqrtf(var + EPS);
        *(LAS unsigned*)(vt + s * VP + 4 * lane) = pk2(d0 * rs * gg[0] + bb[0], d1 * rs * gg[1] + bb[1]);
      } }
    __syncthreads();
    const int db = c.wave & 3, hh = lane >> 5, r = lane & 31;
#pragma unroll
    for (int tt = 0; tt < 2; ++tt) {
        const int tb = (c.wave < 4) ? (tt ? 3 : 0) : (tt ? 2 : 1);
        f32x16 acc; for (int i = 0; i < 16; ++i) acc[i] = 0.f;
        const int t = tb * 32 + r;
        const float* wrow = Ws + t * 128;
        for (int ks = 0; ks < 2 * (tb + 1); ++ks) {
            const int s0 = 16 * ks + 8 * hh;
            const f32x4 w0 = *(const f32x4*)(wrow + s0), w1 = *(const f32x4*)(wrow + s0 + 4);
            float wv[8];
#pragma unroll
            for (int j = 0; j < 4; ++j) { wv[j] = (s0 + j <= t) ? w0[j] : 0.f; wv[4 + j] = (s0 + 4 + j <= t) ? w1[j] : 0.f; }
            const bf16x8 bfrag = pack_frag(wv);
            const bf16x8 afrag = frag_tr(vt, VP, 16 * ks, db * 32, lane);
            acc = MFMA32(afrag, bfrag, acc);
        }
        const float bst = bs[t];
        bf16_t* urow = uv + (size_t)(ck * 128 + t) * DMIX + g * 128 + db * 32;
        float ss = 0.f;
#pragma unroll
        for (int gq = 0; gq < 4; ++gq) {
            const int dl = 8 * gq + 4 * hh;
            const u32x2 uw = *(const u32x2*)(urow + dl);
            const f32x4 na = *(const f32x4*)(nag + db * 32 + dl);
            const float y0 = bflo(uw.x) * (acc[4 * gq] + bst), y1 = bfhi(uw.x) * (acc[4 * gq + 1] + bst), y2 = bflo(uw.y) * (acc[4 * gq + 2] + bst), y3 = bfhi(uw.y) * (acc[4 * gq + 3] + bst);
            ss += (y0 * y0 + y1 * y1) + (y2 * y2 + y3 * y3);
            u32x2 o; o.x = pk2(y0 * na[0], y1 * na[1]); o.y = pk2(y2 * na[2], y3 * na[3]);
            *(u32x2*)(urow + dl) = o;
        }
        ss += __shfl_xor(ss, 32);
        if (hh == 0) part[t * 4 + db] = ss;
    }
    __syncthreads();
    if (c.tid < 128) ((float*)(c.ws + WS_SSQA))[(size_t)(ck * 128 + c.tid) * 16 + g] = (part[c.tid * 4] + part[c.tid * 4 + 1]) + (part[c.tid * 4 + 2] + part[c.tid * 4 + 3]);
    __syncthreads();
}

__device__ __forceinline__ void ssd_a_item_mfma(const Ctx& c, int ck, int g) {
    LAS float* sdt = (LAS float*)(c.lds + L_SDT); LAS float* sacs = (LAS float*)(c.lds + L_SACS); LAS float* sw = (LAS float*)(c.lds + L_SW);
    ssd_tables(c, ck, g, sdt, sacs);
    { const int l = c.tid >> 2, h = c.tid & 3; sw[l * 4 + h] = sdt[l * 4 + h] * __expf(sacs[127 * 4 + h] - sacs[l * 4 + h]); }
    if (c.tid < 4) ((float*)(c.ws + WS_CDEC))[ck * 32 + g * 4 + c.tid] = __expf(sacs[127 * 4 + c.tid]);
    __syncthreads();
    stage_conv_tile<256>(c, c.lds + L_XS, XS_PITCH, g * 256, ck * 128, sw);
    stage_conv_tile<128>(c, c.lds + L_B, BC_PITCH, DSSM + g * 128, ck * 128, nullptr);
    __syncthreads();
    const int lane = c.lane, h = c.wave >> 1, pb = c.wave & 1, hh = lane >> 5, r = lane & 31;
    f32x16 acc[4];
#pragma unroll
    for (int nb = 0; nb < 4; ++nb) for (int i = 0; i < 16; ++i) acc[nb][i] = 0.f;
#pragma unroll 2
    for (int ks = 0; ks < 8; ++ks) {
        const bf16x8 xf = frag_tr(c.lds + L_XS, XS_PITCH, 16 * ks, h * 64 + pb * 32, lane);
#pragma unroll
        for (int nb = 0; nb < 4; ++nb) { const bf16x8 bfg = frag_tr(c.lds + L_B, BC_PITCH, 16 * ks, nb * 32, lane); acc[nb] = MFMA32(bfg, xf, acc[nb]); }
    }
    bf16_t* st = (bf16_t*)(c.ws + WS_ST) + ((size_t)(ck * 32 + g * 4 + h) * 64 + pb * 32 + r) * 128;
#pragma unroll
    for (int nb = 0; nb < 4; ++nb)
#pragma unroll
        for (int gq = 0; gq < 4; ++gq) { u32x2 o; o.x = pk2(acc[nb][4 * gq], acc[nb][4 * gq + 1]); o.y = pk2(acc[nb][4 * gq + 2], acc[nb][4 * gq + 3]);
            *(u32x2*)(st + nb * 32 + 8 * gq + 4 * hh) = o; }
    __syncthreads();
}

constexpr int BC2_PITCH = 272;
__device__ __forceinline__ void ssd_c_item_mfma(const Ctx& c, int ck, int g) {
    LAS float* sdt = (LAS float*)(c.lds + L_SDT); LAS float* sacs = (LAS float*)(c.lds + L_SACS); LAS float* part = (LAS float*)(c.lds + L_SW);
    ssd_tables(c, ck, g, sdt, sacs);
    stage_conv_tile<256>(c, c.lds + L_XS, XS_PITCH, g * 256, ck * 128, nullptr);
    stage_conv_tile<128>(c, c.lds + L_B, BC2_PITCH, DSSM + g * 128, ck * 128, nullptr);
    stage_conv_tile<128>(c, c.lds + L_C, BC2_PITCH, DSSM + NGRP * NST + g * 128, ck * 128, nullptr);
    __syncthreads();
    const int lane = c.lane, h = c.wave >> 1, hh = lane >> 5, r = lane & 31;
    const float Dh = c.in[13][g * 4 + h];
    const bf16_t* hin = (const bf16_t*)(c.ws + WS_ST) + (size_t)(ck * 32 + g * 4 + h) * 64 * 128;
    LAS const unsigned char* xs = c.lds + L_XS; LAS const unsigned char* bt = c.lds + L_B; LAS const unsigned char* ct = c.lds + L_C;
    f32x16 acc[2][2];
#pragma unroll
    for (int lbi = 0; lbi < 2; ++lbi) {
        const int lb = (c.wave & 1) ? (lbi ? 2 : 1) : (lbi ? 3 : 0);
        const int l = lb * 32 + r;
        bf16x8 cf[8];
#pragma unroll
        for (int ks = 0; ks < 8; ++ks) cf[ks] = frag_row(ct, BC2_PITCH, lb * 32, 16 * ks, lane);
        f32x16 a0, a1; for (int i = 0; i < 16; ++i) { a0[i] = 0.f; a1[i] = 0.f; }
#pragma unroll
        for (int ks = 0; ks < 8; ++ks) {
            const bf16x8 h0 = *(const bf16x8*)(hin + (size_t)r * 128 + 16 * ks + 8 * hh), h1 = *(const bf16x8*)(hin + (size_t)(32 + r) * 128 + 16 * ks + 8 * hh);
            a0 = MFMA32(h0, cf[ks], a0); a1 = MFMA32(h1, cf[ks], a1);
        }
        const float al = sacs[l * 4 + h]; const float ea = __expf(al);
        a0 = a0 * ea; a1 = a1 * ea;
        for (int sb = 0; sb <= lb; ++sb) {
            f32x16 X; for (int i = 0; i < 16; ++i) X[i] = 0.f;
#pragma unroll
            for (int ks = 0; ks < 8; ++ks) X = MFMA32(frag_row(bt, BC2_PITCH, sb * 32, 16 * ks, lane), cf[ks], X);
            bf16x8 mf[2];
#pragma unroll
            for (int kk = 0; kk < 2; ++kk) {
                float mv[8];
#pragma unroll
                for (int j = 0; j < 8; ++j) {
                    const int sidx = sb * 32 + 16 * kk + 8 * (j >> 2) + 4 * hh + (j & 3);
                    float v = X[8 * kk + j] * __expf(al - sacs[sidx * 4 + h]) * sdt[sidx * 4 + h];
                    v = (sidx <= l) ? v : 0.f;
                    mv[j] = (sidx == l) ? v + Dh : v;
                }
                mf[kk] = pack_frag(mv);
            }
#pragma unroll
            for (int kk = 0; kk < 2; ++kk) {
                const bf16x8 x0 = frag_tr_perm(xs, XS_PITCH, sb * 32 + 16 * kk, h * 64, lane), x1 = frag_tr_perm(xs, XS_PITCH, sb * 32 + 16 * kk, h * 64 + 32, lane);
                a0 = MFMA32(x0, mf[kk], a0); a1 = MFMA32(x1, mf[kk], a1);
            }
        }
        acc[lbi][0] = a0; acc[lbi][1] = a1;
    }
    const bf16_t* zs = (const bf16_t*)(c.ws + WS_ZS); bf16_t* cat = (bf16_t*)(c.ws + WS_UV); const float* ng = c.in[14] + g * 256 + h * 64;
#pragma unroll
    for (int lbi = 0; lbi < 2; ++lbi) {
        const int lb = (c.wave & 1) ? (lbi ? 2 : 1) : (lbi ? 3 : 0);
        const int l = lb * 32 + r; const size_t row = (size_t)ck * 128 + l;
        float ss = 0.f;
#pragma unroll
        for (int pb = 0; pb < 2; ++pb)
#pragma unroll
            for (int gq = 0; gq < 4; ++gq) { const int p0 = pb * 32 + 8 * gq + 4 * hh;
                const u32x2 zw = *(const u32x2*)(zs + row * DSSM + g * 256 + h * 64 + p0);
                const float y0 = acc[lbi][pb][4 * gq] * bflo(zw.x), y1 = acc[lbi][pb][4 * gq + 1] * bfhi(zw.x), y2 = acc[lbi][pb][4 * gq + 2] * bflo(zw.y), y3 = acc[lbi][pb][4 * gq + 3] * bfhi(zw.y);
                acc[lbi][pb][4 * gq] = y0; acc[lbi][pb][4 * gq + 1] = y1; acc[lbi][pb][4 * gq + 2] = y2; acc[lbi][pb][4 * gq + 3] = y3;
                ss += (y0 * y0 + y1 * y1) + (y2 * y2 + y3 * y3); }
        ss += __shfl_xor(ss, 32);
        if (hh == 0) part[l * 4 + h] = ss;
    }
    __syncthreads();
#pragma unroll
    for (int lbi = 0; lbi < 2; ++lbi) {
        const int lb = (c.wave & 1) ? (lbi ? 2 : 1) : (lbi ? 3 : 0);
        const int l = lb * 32 + r; const size_t row = (size_t)ck * 128 + l;
        const float rinv = 1.0f / sqrtf(((part[l * 4] + part[l * 4 + 1]) + (part[l * 4 + 2] + part[l * 4 + 3])) * (1.0f / 256.0f) + EPS);
#pragma unroll
        for (int pb = 0; pb < 2; ++pb)
#pragma unroll
            for (int gq = 0; gq < 4; ++gq) { const int p0 = pb * 32 + 8 * gq + 4 * hh;
                const f32x4 gg = *(const f32x4*)(ng + p0);
                u32x2 o; o.x = pk2(acc[lbi][pb][4 * gq] * rinv * gg[0], acc[lbi][pb][4 * gq + 1] * rinv * gg[1]); o.y = pk2(acc[lbi][pb][4 * gq + 2] * rinv * gg[2], acc[lbi][pb][4 * gq + 3] * rinv * gg[3]);
                *(u32x2*)(cat + row * DMIX + DA + g * 256 + h * 64 + p0) = o; }
    }
    __syncthreads();
}

#ifndef MIX_GMLP_MFMA
#define MIX_GMLP_MFMA 1
#endif
#ifndef MIX_SSDA_MFMA
#define MIX_SSDA_MFMA 1
#endif
#ifndef MIX_SSDC_MFMA
#define MIX_SSDC_MFMA 1
#endif

__device__ __forceinline__ void phase_mix_a(const Ctx& c) {
    for (int it = c.bid; it < NCH * NGA + NCH * NGRP; it += c.nb) {
        if (it < NCH * NGA) { if (MIX_GMLP_MFMA) gmlp_item_mfma(c, it >> 4, it & 15); else gmlp_item(c, it >> 4, it & 15); }
        else { const int r = it - NCH * NGA; if (MIX_SSDA_MFMA) ssd_a_item_mfma(c, r >> 3, r & 7); else ssd_a_item(c, r >> 3, r & 7); }
    }
}

__device__ __forceinline__ void phase_scan(const Ctx& c) {
    unsigned* st = (unsigned*)(c.ws + WS_ST); const float* cdec = (const float*)(c.ws + WS_CDEC);
    for (int e = c.bid * 512 + c.tid; e < 32 * 64 * 64; e += c.nb * 512) {
        const int head = e >> 12; float h0 = 0.f, h1 = 0.f;
#pragma unroll 8
        for (int ck = 0; ck < NCH; ++ck) { const size_t idx = (size_t)ck * (32 * 64 * 64) + e; const unsigned w = st[idx]; const float dc = cdec[ck * 32 + head];
            st[idx] = pk2(h0, h1); h0 = dc * h0 + bflo(w); h1 = dc * h1 + bfhi(w); }
    }
    bf16_t* uv = (bf16_t*)(c.ws + WS_UV); const float* sq = (const float*)(c.ws + WS_SSQA);
    for (int i = c.bid * 512 + c.tid; i < S * (DA / 8); i += c.nb * 512) { const int row = i >> 8, ch = i & 255;
        const f32x4 q0 = *(const f32x4*)(sq + row * 16), q1 = *(const f32x4*)(sq + row * 16 + 4), q2 = *(const f32x4*)(sq + row * 16 + 8), q3 = *(const f32x4*)(sq + row * 16 + 12);
        float s = 0.f;
#pragma unroll
        for (int e = 0; e < 4; ++e) s += q0[e] + q1[e] + q2[e] + q3[e];
        const float rinv = 1.0f / sqrtf(s * (1.0f / DA) + EPS);
        u32x4* pp = (u32x4*)(uv + (size_t)row * DMIX + ch * 8); const u32x4 w = *pp; u32x4 o;
        o.x = pk2(bflo(w.x) * rinv, bfhi(w.x) * rinv); o.y = pk2(bflo(w.y) * rinv, bfhi(w.y) * rinv); o.z = pk2(bflo(w.z) * rinv, bfhi(w.z) * rinv); o.w = pk2(bflo(w.w) * rinv, bfhi(w.w) * rinv);
        *pp = o; }
}

__device__ __forceinline__ void ssd_c_item(const Ctx& c, int ck, int g) {
    LAS float* sdt = (LAS float*)(c.lds + L_SDT); LAS float* sacs = (LAS float*)(c.lds + L_SACS); LAS float* part = (LAS float*)(c.lds + L_SW);
    ssd_tables(c, ck, g, sdt, sacs);
    stage_conv_tile<256>(c, c.lds + L_XS, XS_PITCH, g * 256, ck * 128, nullptr);
    stage_conv_tile<128>(c, c.lds + L_B, BC_PITCH, DSSM + g * 128, ck * 128, nullptr);
    stage_conv_tile<128>(c, c.lds + L_C, BC_PITCH, DSSM + NGRP * NST + g * 128, ck * 128, nullptr);
    __syncthreads();
    float* G = (float*)(c.ws + WS_GSCR) + (size_t)c.bid * 16384;
    for (int o = c.tid; o < 16384; o += 512) { const int s = o & 127, l = o >> 7; float a = 0.f;
        if (s <= l) for (int n = 0; n < 128; ++n) a += bf2f(*(LAS bf16_t*)(c.lds + L_C + l * BC_PITCH + n * 2)) * bf2f(*(LAS bf16_t*)(c.lds + L_B + s * BC_PITCH + n * 2));
        __hip_atomic_store(G + o, a, __ATOMIC_RELAXED, __HIP_MEMORY_SCOPE_AGENT); }
    asm volatile("s_waitcnt vmcnt(0)" ::: "memory");
    __syncthreads();
    const bf16_t* hin = (const bf16_t*)(c.ws + WS_ST) + (size_t)(ck * 32 + g * 4) * 64 * 128;
    const bf16_t* zs = (const bf16_t*)(c.ws + WS_ZS); bf16_t* cat = (bf16_t*)(c.ws + WS_UV); const float* dsk = c.in[13]; const float* ng = c.in[14];
    const int hp = c.tid & 255, h = hp >> 6; const float Dh = dsk[g * 4 + h];
    for (int j = 0; j < 64; ++j) { const int l = (c.tid >> 8) + 2 * j; const float al = sacs[l * 4 + h];
        float y = 0.f;
        for (int s = 0; s <= l; ++s) y += __hip_atomic_load(G + l * 128 + s, __ATOMIC_RELAXED, __HIP_MEMORY_SCOPE_AGENT) * __expf(al - sacs[s * 4 + h]) * sdt[s * 4 + h] * bf2f(*(LAS bf16_t*)(c.lds + L_XS + s * XS_PITCH + hp * 2));
        float yo = 0.f;
        for (int n = 0; n < 128; ++n) yo += bf2f(*(LAS bf16_t*)(c.lds + L_C + l * BC_PITCH + n * 2)) * bf2f(hin[hp * 128 + n]);
        y += __expf(al) * yo + Dh * bf2f(*(LAS bf16_t*)(c.lds + L_XS + l * XS_PITCH + hp * 2));
        const size_t row = (size_t)ck * 128 + l;
        y *= bf2f(zs[row * DSSM + g * 256 + hp]);
        const float q = wave_sum(y * y);
        if (c.lane == 0) part[l * 4 + (c.wave & 3)] = q;
        cat[row * DMIX + DA + g * 256 + hp] = (bf16_t)f2bf(y);
    }
    __syncthreads();
    for (int j = 0; j < 64; ++j) { const int l = (c.tid >> 8) + 2 * j; const size_t row = (size_t)ck * 128 + l;
        const float rinv = 1.0f / sqrtf(((part[l * 4] + part[l * 4 + 1]) + (part[l * 4 + 2] + part[l * 4 + 3])) * (1.0f / 256.0f) + EPS);
        bf16_t* pp = cat + row * DMIX + DA + g * 256 + hp;
        *pp = (bf16_t)f2bf(bf2f(*pp) * rinv * ng[g * 256 + hp]); }
    __syncthreads();
}

__device__ __forceinline__ void phase_mix_c(const Ctx& c) {
    for (int it = c.bid; it < NCH * NGRP; it += c.nb) { if (MIX_SSDC_MFMA) ssd_c_item_mfma(c, it >> 3, it & 7); else ssd_c_item(c, it >> 3, it & 7); }
}

__device__ __forceinline__ void phase_final(const Ctx& c) {
    const int gw = c.bid * 8 + c.wave, NGW = c.nb * 8; const float* g = c.in[24]; const float* sq = (const float*)(c.ws + WS_SSQ3);
    for (int m = gw; m < S; m += NGW) {
        const f32x4 q0 = *(const f32x4*)(sq + (size_t)m * 8), q1 = *(const f32x4*)(sq + (size_t)m * 8 + 4);
        const float rinv = 1.0f / sqrtf(((q0[0] + q0[1]) + (q0[2] + q0[3]) + (q1[0] + q1[1]) + (q1[2] + q1[3])) * (1.0f / D) + EPS);
        float* orow = c.out + (size_t)m * D + 4 * c.lane;
#pragma unroll
        for (int j = 0; j < 8; ++j) { const f32x4 v = *(const f32x4*)(orow + 256 * j), gg = *(const f32x4*)(g + 4 * c.lane + 256 * j); *(f32x4*)(orow + 256 * j) = v * rinv * gg; }
    }
}

__global__ void __launch_bounds__(512, 2) mega_fwd(Params P, int ph_lo, int ph_hi) {
    extern __shared__ __attribute__((aligned(16))) unsigned char lds_raw[];
    Ctx c;
    c.lds = (LAS unsigned char*)lds_raw; c.tid = threadIdx.x; c.lane = c.tid & 63; c.wave = __builtin_amdgcn_readfirstlane(c.tid >> 6);
    c.nb = gridDim.x; c.bid = blockIdx.x; c.in = P.in; c.out = P.out; c.ws = P.ws;
    unsigned char* ws = P.ws;
#ifndef PH_MASK
#define PH_MASK 0x3ff
#endif
#define IN(k) (((PH_MASK >> (k)) & 1) && ph_lo <= (k) && (k) < ph_hi)
#define SEAM(k) do { if (IN(k) && IN((k) + 1)) cg::this_grid().sync(); } while (0)
    if (IN(0)) phase_prep(c);
    SEAM(0);
    if (IN(1)) {
        pg8::Gemm g{(const bf16_t*)(ws + WS_A), (const bf16_t*)(ws + WS_WIN), D}; pg8::StaticOrder So; So.init(32, 40, c.nb, c.bid);
        EpiProj E{(bf16_t*)(ws + WS_UV), (bf16_t*)(ws + WS_ZS), (bf16_t*)(ws + WS_XBC)};
        pg8::gemm_phase<EpiProj, true, true>(c.lds, g, So, E);
        phase_dt(c);
    }
    SEAM(1);
    if (IN(2)) phase_mix_a(c);
    SEAM(2);
    if (IN(3)) phase_scan(c);
    SEAM(3);
    if (IN(4)) phase_mix_c(c);
    SEAM(4);
    if (IN(5)) {
        { pg8::Gemm g{(const bf16_t*)(ws + WS_UV), (const bf16_t*)(ws + WS_WOUT), DMIX}; pg8::StaticOrder So; So.init(32, 8, c.nb, c.bid);
          EpiResid E{P.in[0], P.out, (bf16_t*)(ws + WS_HG), (bf16_t*)(ws + WS_HG) + (size_t)S * D, P.in[16], (float*)(ws + WS_SSQ1)};
          pg8::gemm_phase<EpiResid, false, true>(c.lds, g, So, E); }
        { pg8::Gemm g{(const bf16_t*)(ws + WS_P16), (const bf16_t*)(ws + WS_WPLE), DPLE}; pg8::StaticOrder So; So.init(32, 8, c.nb, c.bid);
          EpiPlain E{(bf16_t*)(ws + WS_E), D};
          pg8::gemm_phase<EpiPlain, true, true>(c.lds, g, So, E); }
    }
    SEAM(5);
    if (IN(6)) {
        pg8::Gemm g{(const bf16_t*)(ws + WS_HG), (const bf16_t*)(ws + WS_WUP), D}; pg8::StaticOrder So; So.init(34, 44, c.nb, c.bid);
        EpiFfn E{(bf16_t*)(ws + WS_ACT), (const float*)(ws + WS_SSQ1), P.in[18], P.in[19]};
        pg8::gemm_phase<EpiFfn, true, true>(c.lds, g, So, E);
    }
    SEAM(6);
    if (IN(7)) {
        pg8::Gemm g{(const bf16_t*)(ws + WS_ACT), (const bf16_t*)(ws + WS_WDN), DFF}; pg8::StaticOrder So; So.init(32, 8, c.nb, c.bid);
        EpiResid E{P.out, P.out, (bf16_t*)(ws + WS_H2G), nullptr, P.in[21], (float*)(ws + WS_SSQ2)};
        pg8::gemm_phase<EpiResid, false, true>(c.lds, g, So, E);
    }
    SEAM(7);
    if (IN(8)) {
        pg8::Gemm g{(const bf16_t*)(ws + WS_H2G), (const bf16_t*)(ws + WS_WPG), D}; pg8::StaticOrder So; So.init(32, 8, c.nb, c.bid);
        EpiPle E{P.out, (const bf16_t*)(ws + WS_E), (const float*)(ws + WS_SSQ2), (float*)(ws + WS_SSQ3)};
        pg8::gemm_phase<EpiPle, false, true>(c.lds, g, So, E);
    }
    SEAM(8);
    if (IN(9)) phase_final(c);
#undef IN
#undef SEAM
}

extern "C" void kernel_launch(void* const* d_in, const int* in_sizes, int n_in, void* d_out, int out_size, void* d_ws, size_t ws_size, hipStream_t stream) {
    static int grid = 0;
    if (grid == 0) {
        if (n_in != 25 || out_size != S * D || ws_size < WS_END) { fprintf(stderr, "kernel_launch: unexpected shapes (n_in %d out %d ws %zu)\n", n_in, out_size, ws_size); grid = -1; return; }
        int dev = 0, cus = 0, per_cu = 0;
        (void)hipGetDevice(&dev); (void)hipDeviceGetAttribute(&cus, hipDeviceAttributeMultiprocessorCount, dev);
        if (hipFuncSetAttribute((const void*)mega_fwd, hipFuncAttributeMaxDynamicSharedMemorySize, LDS_BYTES) != hipSuccess) { fprintf(stderr, "kernel_launch: hipFuncSetAttribute failed\n"); grid = -1; return; }
        (void)hipOccupancyMaxActiveBlocksPerMultiprocessor(&per_cu, (const void*)mega_fwd, 512, LDS_BYTES);
        if (per_cu < 1) { fprintf(stderr, "kernel_launch: occupancy query says %d blocks/CU\n", per_cu); per_cu = 1; }
        (void)hipGetLastError();
        grid = cus;
        fprintf(stderr, "kernel_launch: grid %d (cus %d, per_cu %d)\n", grid, cus, per_cu);
    }
    if (grid < 0) return;
    Params P{};
    for (int i = 0; i < 25; ++i) P.in[i] = (const float*)d_in[i];
    P.out = (float*)d_out; P.ws = (unsigned char*)d_ws;
#if MK_LAUNCHES == 1
    int lo = 0, hi = NPH;
    void* args[] = {&P, &lo, &hi};
    hipError_t e = hipLaunchCooperativeKernel((const void*)mega_fwd, dim3(grid), dim3(512), args, LDS_BYTES, stream);
    if (e != hipSuccess) fprintf(stderr, "kernel_launch: cooperative launch failed: %s\n", hipGetErrorString(e));
#else
    for (int k = 0; k < NPH; ++k) {
        int lo = k, hi = k + 1;
        void* args[] = {&P, &lo, &hi};
        hipError_t e = hipLaunchCooperativeKernel((const void*)mega_fwd, dim3(grid), dim3(512), args, LDS_BYTES, stream);
        if (e != hipSuccess) { fprintf(stderr, "kernel_launch: launch %d failed: %s\n", k, hipGetErrorString(e)); break; }
    }
#endif
}
```

```cpp
#include <hip/hip_runtime.h>
#include <hip/hip_cooperative_groups.h>
#include <cstdio>
#include <cstdint>
namespace cg = cooperative_groups;

#ifndef MK_LAUNCHES
#define MK_LAUNCHES 1
#endif

#define LAS __attribute__((address_space(3)))
typedef unsigned short bf16_t;
typedef short bf16x8 __attribute__((ext_vector_type(8)));
typedef float f32x4 __attribute__((ext_vector_type(4)));
typedef float f32x2 __attribute__((ext_vector_type(2)));
typedef float f32x16 __attribute__((ext_vector_type(16)));
typedef unsigned u32x4 __attribute__((ext_vector_type(4)));
typedef unsigned u32x2 __attribute__((ext_vector_type(2)));

constexpr int S = 8192, D = 2048, DIN = 10272, DA = 2048, DSSM = 2048, DXBC = 4096, NH = 32, NGRP = 8, NST = 128;
constexpr int DFF = 5632, DPLE = 256, DMIX = 4096, NCH = 64, CH = 128, NGA = 16;
constexpr float EPS = 1e-6f;
constexpr int NPH = 10;

constexpr size_t MiB = 1u << 20;
constexpr size_t WS_WUP = 1 * MiB;
constexpr size_t WS_WDN = 45 * MiB;
constexpr size_t WS_WPG = 67 * MiB;
constexpr size_t WS_WPLE = 75 * MiB;
constexpr size_t WS_WIN = 76 * MiB;
constexpr size_t WS_WOUT = 117 * MiB;
constexpr size_t WS_UV = 133 * MiB;
constexpr size_t WS_ACT = 133 * MiB;
constexpr size_t WS_ZS = 197 * MiB;
constexpr size_t WS_XBC = 229 * MiB;
constexpr size_t WS_HG = 229 * MiB;
constexpr size_t WS_H2G = 229 * MiB;
constexpr size_t WS_A = 293 * MiB;
constexpr size_t WS_ST = 293 * MiB;
constexpr size_t WS_E = 293 * MiB;
constexpr size_t WS_P16 = 325 * MiB;
constexpr size_t WS_DT = 329 * MiB;
constexpr size_t WS_SSQA = 330 * MiB;
constexpr size_t WS_SSQ1 = 331 * MiB;
constexpr size_t WS_SSQ2 = WS_SSQ1 + 256 * 1024;
constexpr size_t WS_SSQ3 = WS_SSQ2 + 256 * 1024;
constexpr size_t WS_CDEC = WS_SSQ3 + 256 * 1024;
constexpr size_t WS_GSCR = 332 * MiB;
constexpr size_t WS_END = 348 * MiB;

constexpr int LDS_BYTES = 163840;

struct Params {
    const float* in[25];
    float* out;
    unsigned char* ws;
};

__device__ __forceinline__ unsigned f2bf(float f) { unsigned u = __builtin_bit_cast(unsigned, f); return (u + 0x7fffu + ((u >> 16) & 1u)) >> 16; }
__device__ __forceinline__ unsigned pk2(float lo, float hi) { return f2bf(lo) | (f2bf(hi) << 16); }
__device__ __forceinline__ float bf2f(unsigned short b) { return __builtin_bit_cast(float, ((unsigned)b) << 16); }
__device__ __forceinline__ float bflo(unsigned w) { return __builtin_bit_cast(float, w << 16); }
__device__ __forceinline__ float bfhi(unsigned w) { return __builtin_bit_cast(float, w & 0xffff0000u); }
__device__ __forceinline__ float fast_sigmoid(float x) { return __builtin_amdgcn_rcpf(1.0f + __builtin_amdgcn_exp2f(-1.4426950408889634f * x)); }
__device__ __forceinline__ float silu_f(float x) { return x * fast_sigmoid(x); }
__device__ __forceinline__ float gelu_tanh_f(float x) { const float t = x + 0.044715f * x * x * x; return x * __builtin_amdgcn_rcpf(1.0f + __builtin_amdgcn_exp2f(-2.3022081986f * t)); }
__device__ __forceinline__ float wave_sum(float v) {
#pragma unroll
    for (int o = 1; o < 64; o <<= 1) v += __shfl_xor(v, o);
    return v;
}

namespace pg8 {
constexpr int BM = 256, BK = 64, HALF = 128, HTB = HALF * BK * 2, STAGE_BYTES = 8 * HTB, NXCD = 8, WGM = 8;
__host__ __device__ __forceinline__ int lds_byte(int r, int c) { const int st = (r >> 4) * 2 + (c >> 5), rr = r & 15, cc = c & 31, ob = rr * 64 + cc * 2; return st * 1024 + (ob ^ (((ob >> 9) & 1) << 5)); }
__host__ __device__ __forceinline__ void stage_rc(int b, int& R, int& C) { const int st = b / 1024, sb = b % 1024, swz = sb ^ (((sb >> 9) & 1) << 5); R = (st >> 1) * 16 + swz / 64; C = (st & 1) * 32 + (swz % 64) / 2; }
__host__ __device__ __forceinline__ int perm32(int rho) { const int n = rho >> 4, i = rho & 15; return 8 * (i >> 2) + 4 * n + (i & 3); }

struct Unit { int pm, pn; };
struct Gemm { const bf16_t* A; const bf16_t* Bt; int K; };

struct StaticOrder {
    int nM, nN, nwg, G, c;
    __device__ void init(int nM_, int nN_, int G_, int c_) { nM = nM_; nN = nN_; nwg = nM * nN; G = G_; c = c_; }
    __device__ bool next(int i, Unit& u) const {
        const long L = (long)i * G + c; if (L >= nwg) return false;
        int wgid = (int)L; { const int q = nwg / NXCD, r = nwg % NXCD, xcd = wgid % NXCD, off = wgid / NXCD; wgid = (xcd < r ? xcd * (q + 1) : r * (q + 1) + (xcd - r) * q) + off; }
        const int nig = WGM * nN, gid = wgid / nig, fm = gid * WGM, gsz = (nM - fm) < WGM ? (nM - fm) : WGM;
        u.pm = fm + ((wgid % nig) % gsz); u.pn = (wgid % nig) / gsz; return true;
    }
};

__device__ __forceinline__ unsigned cvt_pk_bf16(float lo, float hi) { unsigned r; asm volatile("v_cvt_pk_bf16_f32 %0, %1, %2" : "=v"(r) : "v"(lo), "v"(hi)); return r; }

template <class Epi, bool ALIGN_EPI, bool SP2>
__device__ __forceinline__ void gemm_phase(LAS unsigned char* lds, const Gemm g, const StaticOrder& S, const Epi& E) {
    const int tid = threadIdx.x, wid = __builtin_amdgcn_readfirstlane(tid >> 6), lane = tid & 63, wr = wid >> 2, wc = wid & 3, fr = lane & 15, fq = lane >> 4;
    const int K = g.K, nt = K / BK;
    unsigned voffA[2], voffB[2];
#pragma unroll
    for (int i = 0; i < 2; ++i) { int R, C; stage_rc(tid * 16 + i * 8192, R, C); const int Rb = (R & ~31) + perm32(R & 31);
        voffA[i] = (unsigned)(R * K + C) * 2u; voffB[i] = (unsigned)(Rb * K + C) * 2u; }
    const size_t kstep = (size_t)(BK * 2);
    const size_t hstep = (size_t)HALF * K * 2;
    const size_t tstep = 2 * hstep;
    const unsigned ldsw = (unsigned)wid * 1024u;
    const int aoff = lds_byte(wr * 64 + fr, fq * 8), boff = lds_byte(wc * 32 + fr, fq * 8);
#define PG8_SA(b, h) (((b) * 2 + (h)) * HTB)
#define PG8_SB(b, h) ((4 + (b) * 2 + (h)) * HTB)
#define PG8_STAGE(bufoff, gbase, voff) do { _Pragma("unroll") for (int _i = 0; _i < 2; ++_i) \
        __builtin_amdgcn_global_load_lds((const unsigned*)((const char*)(gbase) + (voff)[_i]), (LAS unsigned*)(lds + (bufoff) + ldsw + _i * 8192), 16, 0, 0); } while (0)
#define PG8_LDA(dst, b, h) do { _Pragma("unroll") for (int m = 0; m < 4; ++m) _Pragma("unroll") for (int k = 0; k < 2; ++k) dst[m][k] = *(const LAS bf16x8*)(lds + PG8_SA(b, h) + aoff + m * 2048 + k * 1024); } while (0)
#define PG8_LDB(dst, b, h) do { _Pragma("unroll") for (int n = 0; n < 2; ++n) _Pragma("unroll") for (int k = 0; k < 2; ++k) dst[n][k] = *(const LAS bf16x8*)(lds + PG8_SB(b, h) + boff + n * 2048 + k * 1024); } while (0)
#define PG8_MMA(ai, bj, At, Bt) do { __builtin_amdgcn_s_setprio(1); _Pragma("unroll") for (int m = 0; m < 4; ++m) _Pragma("unroll") for (int n = 0; n < 2; ++n) _Pragma("unroll") for (int k = 0; k < 2; ++k) \
        acc[ai][bj][m][n] = __builtin_amdgcn_mfma_f32_16x16x32_bf16(Bt[n][k], At[m][k], acc[ai][bj][m][n], 0, 0, 0); __builtin_amdgcn_s_setprio(0); } while (0)
#define PG8_WAIT_V(n) asm volatile("s_waitcnt vmcnt(" #n ")" ::: "memory")
#define PG8_WAIT_L(n) asm volatile("s_waitcnt lgkmcnt(" #n ")" ::: "memory")
#define PG8_BAR __builtin_amdgcn_s_barrier()
#define PG8_SCHED __builtin_amdgcn_sched_barrier(0)
    Unit cur, nxt; int ui = 0;
    if (!S.next(0, cur)) return;
    f32x4 acc[2][2][4][2];
#pragma unroll
    for (int a = 0; a < 2; ++a)
#pragma unroll
        for (int b = 0; b < 2; ++b)
#pragma unroll
            for (int m = 0; m < 4; ++m)
#pragma unroll
                for (int n = 0; n < 2; ++n) acc[a][b][m][n] = (f32x4){0.f, 0.f, 0.f, 0.f};
    bf16x8 At[4][2], B0[2][2], B1[2][2];
    const char* cA = (const char*)g.A + (size_t)cur.pm * tstep; const char* cB = (const char*)g.Bt + (size_t)cur.pn * tstep;
    if constexpr (SP2) {
        PG8_STAGE(PG8_SB(0, 0), cB, voffB); PG8_STAGE(PG8_SB(0, 1), cB + hstep, voffB); PG8_STAGE(PG8_SA(0, 0), cA, voffA); PG8_STAGE(PG8_SA(0, 1), cA + hstep, voffA);
        if (wr == 1) PG8_BAR;
        PG8_WAIT_V(2); PG8_BAR;
        PG8_STAGE(PG8_SB(1, 0), cB + kstep, voffB); PG8_STAGE(PG8_SA(1, 0), cA + kstep, voffA); PG8_STAGE(PG8_SB(1, 1), cB + hstep + kstep, voffB);
        PG8_WAIT_V(6); PG8_BAR;
    } else {
        PG8_STAGE(PG8_SB(0, 0), cB, voffB); PG8_STAGE(PG8_SA(0, 0), cA, voffA); PG8_STAGE(PG8_SB(0, 1), cB + hstep, voffB); PG8_STAGE(PG8_SA(0, 1), cA + hstep, voffA);
        if (wr == 1) PG8_BAR;
        PG8_WAIT_V(4); PG8_BAR;
        PG8_STAGE(PG8_SB(1, 0), cB + kstep, voffB); PG8_STAGE(PG8_SA(1, 0), cA + kstep, voffA); PG8_STAGE(PG8_SB(1, 1), cB + hstep + kstep, voffB);
        PG8_WAIT_V(6); PG8_BAR;
    }
    for (;;) {
        const bool has_next = S.next(ui + 1, nxt);
        const char* nA = has_next ? (const char*)g.A + (size_t)nxt.pm * tstep : cA; const char* nB = has_next ? (const char*)g.Bt + (size_t)nxt.pn * tstep : cB;
#pragma nounroll
        for (int t = 0; t < nt; t += 2) {
            const bool last = (t == nt - 2);
            const char* a1 = cA + (size_t)(t + 1) * kstep;
            const char* a2 = last ? nA : cA + (size_t)(t + 2) * kstep; const char* b2 = last ? nB : cB + (size_t)(t + 2) * kstep;
            const char* a3 = a2 + kstep; const char* b3 = b2 + kstep;
            if constexpr (SP2) {
            PG8_LDB(B0, 0, 0); PG8_LDB(B1, 0, 1); PG8_SCHED; PG8_LDA(At, 0, 0); PG8_STAGE(PG8_SA(1, 1), a1 + hstep, voffA);
            PG8_WAIT_V(8); PG8_WAIT_L(0); PG8_BAR; PG8_MMA(0, 0, At, B0); PG8_MMA(0, 1, At, B1); PG8_BAR; PG8_SCHED;
            PG8_LDA(At, 0, 1); PG8_STAGE(PG8_SB(0, 0), b2, voffB); PG8_STAGE(PG8_SB(0, 1), b2 + hstep, voffB); PG8_STAGE(PG8_SA(0, 0), a2, voffA);
            PG8_WAIT_V(8); PG8_WAIT_L(0); PG8_BAR; PG8_MMA(1, 0, At, B0); PG8_MMA(1, 1, At, B1); PG8_BAR; PG8_SCHED;
            PG8_LDB(B0, 1, 0); PG8_LDB(B1, 1, 1); PG8_SCHED; PG8_LDA(At, 1, 0); PG8_STAGE(PG8_SA(0, 1), a2 + hstep, voffA);
            PG8_WAIT_V(8); PG8_WAIT_L(0); PG8_BAR; PG8_MMA(0, 0, At, B0); PG8_MMA(0, 1, At, B1); PG8_BAR; PG8_SCHED;
            PG8_LDA(At, 1, 1); PG8_STAGE(PG8_SB(1, 0), b3, voffB); PG8_STAGE(PG8_SB(1, 1), b3 + hstep, voffB); PG8_STAGE(PG8_SA(1, 0), a3, voffA);
            PG8_WAIT_V(8); PG8_WAIT_L(0); PG8_BAR; PG8_MMA(1, 0, At, B0); PG8_MMA(1, 1, At, B1); PG8_BAR; PG8_SCHED;
            } else {
            PG8_LDB(B0, 0, 0); PG8_SCHED; PG8_LDA(At, 0, 0); PG8_STAGE(PG8_SA(1, 1), a1 + hstep, voffA);
            PG8_WAIT_L(8); PG8_BAR; PG8_WAIT_L(0); PG8_MMA(0, 0, At, B0); PG8_BAR; PG8_SCHED;
            PG8_LDB(B1, 0, 1); PG8_STAGE(PG8_SB(0, 0), b2, voffB);
            PG8_BAR; PG8_WAIT_L(0); PG8_MMA(0, 1, At, B1); PG8_BAR;
            PG8_LDA(At, 0, 1); PG8_STAGE(PG8_SA(0, 0), a2, voffA);
            PG8_BAR; PG8_WAIT_L(0); PG8_MMA(1, 0, At, B0); PG8_BAR; PG8_SCHED;
            PG8_STAGE(PG8_SB(0, 1), b2 + hstep, voffB);
            PG8_WAIT_V(6); PG8_BAR; PG8_MMA(1, 1, At, B1); PG8_BAR;
            PG8_LDB(B0, 1, 0); PG8_SCHED; PG8_LDA(At, 1, 0); PG8_STAGE(PG8_SA(0, 1), a2 + hstep, voffA);
            PG8_WAIT_L(8); PG8_BAR; PG8_WAIT_L(0); PG8_MMA(0, 0, At, B0); PG8_BAR; PG8_SCHED;
            PG8_LDB(B1, 1, 1); PG8_STAGE(PG8_SB(1, 0), b3, voffB);
            PG8_BAR; PG8_WAIT_L(0); PG8_MMA(0, 1, At, B1); PG8_BAR;
            PG8_LDA(At, 1, 1); PG8_STAGE(PG8_SA(1, 0), a3, voffA);
            PG8_BAR; PG8_WAIT_L(0); PG8_MMA(1, 0, At, B0); PG8_BAR; PG8_SCHED;
            PG8_STAGE(PG8_SB(1, 1), b3 + hstep, voffB);
            PG8_WAIT_V(6); PG8_BAR; PG8_MMA(1, 1, At, B1); PG8_BAR;
            }
        }
        if constexpr (ALIGN_EPI) { if (wr == 0) PG8_BAR; }
        if constexpr (!Epi::AFTER_DRAIN) { E(acc, cur, wr, wc, fr, fq); }
        if (!has_next) break;
#pragma unroll
        for (int a = 0; a < 2; ++a)
#pragma unroll
            for (int b = 0; b < 2; ++b)
#pragma unroll
                for (int m = 0; m < 4; ++m)
#pragma unroll
                    for (int n = 0; n < 2; ++n) acc[a][b][m][n] = (f32x4){0.f, 0.f, 0.f, 0.f};
        cur = nxt; cA = nA; cB = nB; ++ui;
        if constexpr (ALIGN_EPI) { if (wr == 1) PG8_BAR; }
    }
    PG8_WAIT_V(0);
    if constexpr (!ALIGN_EPI) { if (wr == 0) PG8_BAR; }
    PG8_BAR;
    if constexpr (Epi::AFTER_DRAIN) { E.fused(acc, cur, wr, wc, fr, fq, lds, wid, lane); }
#undef PG8_SA
#undef PG8_SB
#undef PG8_STAGE
#undef PG8_LDA
#undef PG8_LDB
#undef PG8_MMA
#undef PG8_WAIT_V
#undef PG8_WAIT_L
#undef PG8_BAR
#undef PG8_SCHED
}
}
using pg8::Unit; using pg8::cvt_pk_bf16;
typedef f32x4 AccT[2][2][4][2];

__device__ __forceinline__ u32x4 pack8(const f32x4 v0, const f32x4 v1) { u32x4 w; w.x = cvt_pk_bf16(v0[0], v0[1]); w.y = cvt_pk_bf16(v0[2], v0[3]); w.z = cvt_pk_bf16(v1[0], v1[1]); w.w = cvt_pk_bf16(v1[2], v1[3]); return w; }

struct EpiProj {
    static constexpr bool AFTER_DRAIN = false;
    bf16_t *uv, *zs, *xbc;
    __device__ __forceinline__ void operator()(const AccT& acc, const Unit& u, int wr, int wc, int fr, int fq) const {
        const int row0 = u.pm * 256 + wr * 64 + fr; const int ct = wc * 32 + 8 * fq;
        bf16_t* base; int ld, mode;
        if (u.pn < 16) { base = uv + u.pn * 256; ld = DMIX; mode = 0; }
        else if (u.pn < 24) { base = zs + (u.pn - 16) * 256; ld = DSSM; mode = 1; }
        else { base = xbc + (u.pn - 24) * 256; ld = DXBC; mode = 2; }
#pragma unroll
        for (int ai = 0; ai < 2; ++ai)
#pragma unroll
            for (int m = 0; m < 4; ++m) { bf16_t* rowp = base + (size_t)(row0 + ai * 128 + m * 16) * ld + ct;
#pragma unroll
                for (int bj = 0; bj < 2; ++bj) { f32x4 v0 = acc[ai][bj][m][0], v1 = acc[ai][bj][m][1];
                    if (mode == 0) {
#pragma unroll
                        for (int j = 0; j < 4; ++j) { v0[j] = gelu_tanh_f(v0[j]); v1[j] = gelu_tanh_f(v1[j]); } }
                    else if (mode == 1) {
#pragma unroll
                        for (int j = 0; j < 4; ++j) { v0[j] = silu_f(v0[j]); v1[j] = silu_f(v1[j]); } }
                    *(u32x4*)(rowp + bj * 128) = pack8(v0, v1); } }
    }
};
struct EpiPlain {
    static constexpr bool AFTER_DRAIN = false;
    bf16_t* O; int ld;
    __device__ __forceinline__ void operator()(const AccT& acc, const Unit& u, int wr, int wc, int fr, int fq) const {
        const int row0 = u.pm * 256 + wr * 64 + fr; const int col0 = u.pn * 256 + wc * 32 + 8 * fq;
#pragma unroll
        for (int ai = 0; ai < 2; ++ai)
#pragma unroll
            for (int m = 0; m < 4; ++m) { bf16_t* rowp = O + (size_t)(row0 + ai * 128 + m * 16) * ld + col0;
#pragma unroll
                for (int bj = 0; bj < 2; ++bj) *(u32x4*)(rowp + bj * 128) = pack8(acc[ai][bj][m][0], acc[ai][bj][m][1]); }
    }
};
struct EpiResid {
    static constexpr bool AFTER_DRAIN = true;
    const float* base; float* out; bf16_t* hn; bf16_t* halo; const float* gain; float* ssq;
    __device__ __forceinline__ void fused(AccT& acc, const Unit& u, int wr, int wc, int fr, int fq, LAS unsigned char* lds, int wid, int lane) const {
        asm volatile("" : "+v"(fr), "+v"(fq));
        LAS float* P = (LAS float*)lds;
        const int col0 = u.pn * 256 + wc * 32 + 8 * fq;
#pragma unroll
        for (int ai = 0; ai < 2; ++ai)
#pragma unroll
            for (int m = 0; m < 4; ++m) { const int rl = ai * 128 + wr * 64 + m * 16 + fr; const int row = u.pm * 256 + rl; const size_t off = (size_t)row * D + col0;
                float ss = 0.f;
                bf16_t* hrow = nullptr;
                if (halo) { const int r6 = row & 63; if (r6 >= 62) { if ((row >> 6) <= 126) hrow = halo + (size_t)(4 * (row >> 6) + (row & 1)) * D; } else if (r6 < 2 && row >= 64) hrow = halo + (size_t)(4 * ((row >> 6) - 1) + 2 + (row & 1)) * D; }
#pragma unroll
                for (int bj = 0; bj < 2; ++bj) { const f32x4 b0 = *(const f32x4*)(base + off + bj * 128), b1 = *(const f32x4*)(base + off + bj * 128 + 4);
                    const f32x4 v0 = acc[ai][bj][m][0] + b0, v1 = acc[ai][bj][m][1] + b1;
                    *(f32x4*)(out + off + bj * 128) = v0; *(f32x4*)(out + off + bj * 128 + 4) = v1;
                    ss += (v0[0] * v0[0] + v0[1] * v0[1]) + (v0[2] * v0[2] + v0[3] * v0[3]) + (v1[0] * v1[0] + v1[1] * v1[1]) + (v1[2] * v1[2] + v1[3] * v1[3]);
                    const f32x4 g0 = *(const f32x4*)(gain + col0 + bj * 128), g1 = *(const f32x4*)(gain + col0 + bj * 128 + 4);
                    const u32x4 w = pack8(v0 * g0, v1 * g1);
                    *(u32x4*)(hn + off + bj * 128) = w;
                    if (hrow) *(u32x4*)(hrow + col0 + bj * 128) = w; }
                ss += __shfl_xor(ss, 16); ss += __shfl_xor(ss, 32);
                if (fq == 0) P[rl * 4 + wc] = ss;
                asm volatile("" ::: "memory"); }
        __syncthreads();
        if (threadIdx.x < 256) { const int t = threadIdx.x; ssq[(size_t)(u.pm * 256 + t) * 8 + u.pn] = (P[t * 4 + 0] + P[t * 4 + 1]) + (P[t * 4 + 2] + P[t * 4 + 3]); }
        __syncthreads();
    }
};
struct EpiPle {
    static constexpr bool AFTER_DRAIN = true;
    float* out; const bf16_t* Eb; const float* ssq_in; float* ssq;
    __device__ __forceinline__ void fused(AccT& acc, const Unit& u, int wr, int wc, int fr, int fq, LAS unsigned char* lds, int wid, int lane) const {
        asm volatile("" : "+v"(fr), "+v"(fq));
        LAS float* P = (LAS float*)lds;
        const int col0 = u.pn * 256 + wc * 32 + 8 * fq;
#pragma unroll
        for (int ai = 0; ai < 2; ++ai)
#pragma unroll
            for (int m = 0; m < 4; ++m) { const int rl = ai * 128 + wr * 64 + m * 16 + fr; const int row = u.pm * 256 + rl; const size_t off = (size_t)row * D + col0;
                const f32x4 q0 = *(const f32x4*)(ssq_in + (size_t)row * 8), q1 = *(const f32x4*)(ssq_in + (size_t)row * 8 + 4);
                const float rinv = 1.0f / sqrtf(((q0[0] + q0[1]) + (q0[2] + q0[3]) + (q1[0] + q1[1]) + (q1[2] + q1[3])) * (1.0f / D) + EPS);
                float ss = 0.f;
#pragma unroll
                for (int bj = 0; bj < 2; ++bj) { const f32x4 b0 = *(const f32x4*)(out + off + bj * 128), b1 = *(const f32x4*)(out + off + bj * 128 + 4);
                    const u32x4 ew = *(const u32x4*)(Eb + off + bj * 128);
                    f32x4 e0 = {bflo(ew.x), bfhi(ew.x), bflo(ew.y), bfhi(ew.y)}, e1 = {bflo(ew.z), bfhi(ew.z), bflo(ew.w), bfhi(ew.w)};
                    f32x4 v0, v1;
#pragma unroll
                    for (int j = 0; j < 4; ++j) { v0[j] = b0[j] + fast_sigmoid(acc[ai][bj][m][0][j] * rinv) * e0[j]; v1[j] = b1[j] + fast_sigmoid(acc[ai][bj][m][1][j] * rinv) * e1[j]; }
                    *(f32x4*)(out + off + bj * 128) = v0; *(f32x4*)(out + off + bj * 128 + 4) = v1;
                    ss += (v0[0] * v0[0] + v0[1] * v0[1]) + (v0[2] * v0[2] + v0[3] * v0[3]) + (v1[0] * v1[0] + v1[1] * v1[1]) + (v1[2] * v1[2] + v1[3] * v1[3]); }
                ss += __shfl_xor(ss, 16); ss += __shfl_xor(ss, 32);
                if (fq == 0) P[rl * 4 + wc] = ss;
                asm volatile("" ::: "memory"); }
        __syncthreads();
        if (threadIdx.x < 256) { const int t = threadIdx.x; ssq[(size_t)(u.pm * 256 + t) * 8 + u.pn] = (P[t * 4 + 0] + P[t * 4 + 1]) + (P[t * 4 + 2] + P[t * 4 + 3]); }
        __syncthreads();
    }
};
struct EpiFfn {
    static constexpr bool AFTER_DRAIN = false;
    bf16_t* act; const float* ssq1; const float* cw; const float* cb;
    __device__ __forceinline__ int grow_of(const Unit& u, int rl) const {
        if (u.pm < 32) return u.pm * 256 + rl;
        const int R = (u.pm - 32) * 256 + rl; int q = (R >> 2) + 1; if (q > 127) q = 127; return 64 * q - 2 + (R & 3);
    }
    __device__ __forceinline__ void operator()(AccT& acc, const Unit& u, int wr, int wc, int fr, int fq) const {
        asm volatile("" : "+v"(fr), "+v"(fq));
        const bool halo = u.pm >= 32;
        const int lane = fq * 16 + fr;
        const int s1 = (lane & 48) | ((fr + 15) & 15), s2 = (lane & 48) | ((fr + 14) & 15);
#pragma unroll
        for (int ai = 0; ai < 2; ++ai)
#pragma unroll
            for (int m = 0; m < 4; ++m) {
                const int gr = grow_of(u, ai * 128 + wr * 64 + m * 16 + fr);
                const f32x4 q0 = *(const f32x4*)(ssq1 + (size_t)gr * 8), q1 = *(const f32x4*)(ssq1 + (size_t)gr * 8 + 4);
                const float rinv = 1.0f / sqrtf(((q0[0] + q0[1]) + (q0[2] + q0[3]) + (q1[0] + q1[1]) + (q1[2] + q1[3])) * (1.0f / D) + EPS);
#pragma unroll
                for (int bj = 0; bj < 2; ++bj)
#pragma unroll
                    for (int n = 0; n < 2; ++n) acc[ai][bj][m][n] = acc[ai][bj][m][n] * rinv;
                asm volatile("" ::: "memory");
            }
#pragma unroll
        for (int n = 0; n < 2; ++n) {
            const int gc = u.pn * 128 + wc * 32 + 8 * fq + 4 * n;
#pragma unroll
            for (int bj = 0; bj < 2; ++bj) {
                const int cc = bj * DFF + gc;
                asm volatile("" ::: "memory");
                const f32x4 w0 = *(const f32x4*)(cw + cc), w1 = *(const f32x4*)(cw + 2 * DFF + cc), w2 = *(const f32x4*)(cw + 4 * DFF + cc), bb = *(const f32x4*)(cb + cc);
#pragma unroll
                for (int ai = 0; ai < 2; ++ai) {
                    f32x4 p1 = {0.f, 0.f, 0.f, 0.f}, p2 = p1;
#pragma unroll
                    for (int m = 0; m < 4; ++m) {
                        f32x4 v = acc[ai][bj][m][n];
                        asm volatile("" : "+v"(v));
                        f32x4 r1, r2, hh;
#pragma unroll
                        for (int j = 0; j < 4; ++j) { r1[j] = __shfl(v[j], s1); r2[j] = __shfl(v[j], s2); }
#pragma unroll
                        for (int j = 0; j < 4; ++j) { const float x1 = fr >= 1 ? r1[j] : p1[j], x2 = fr >= 2 ? r2[j] : p2[j]; hh[j] = bb[j] + w2[j] * v[j] + w1[j] * x1 + w0[j] * x2; }
                        asm volatile("" : "+v"(hh));
                        acc[ai][bj][m][n] = hh; p1 = r1; p2 = r2;
                    }
                }
            }
            asm volatile("" ::: "memory");
#pragma unroll
            for (int ai = 0; ai < 2; ++ai)
#pragma unroll
                for (int m = 0; m < 4; ++m) {
                    const int rl = ai * 128 + wr * 64 + m * 16 + fr;
                    bool st;
                    if (!halo) st = !(m == 0 && fr < 2) || (u.pm == 0 && ai == 0 && wr == 0);
                    else st = ((fr & 3) >= 2) && ((((u.pm - 32) * 256 + rl) >> 2) + 1 <= 127);
                    if (st) { const f32x4 hg_ = acc[ai][0][m][n], hu_ = acc[ai][1][m][n];
                        u32x2 w; w.x = cvt_pk_bf16(silu_f(hg_[0]) * hu_[0], silu_f(hg_[1]) * hu_[1]); w.y = cvt_pk_bf16(silu_f(hg_[2]) * hu_[2], silu_f(hg_[3]) * hu_[3]);
                        *(u32x2*)(act + (size_t)grow_of(u, rl) * DFF + gc) = w; }
                }
        }
    }
};

struct Ctx {
    LAS unsigned char* lds;
    int tid, lane, wave, nb, bid;
    const float* const* in;
    float* out;
    unsigned char* ws;
};

template <int MODE>
__device__ __forceinline__ void prep_w_item(const float* __restrict__ W, int K, int N, bf16_t* __restrict__ Wt, int item, int lane) {
    const int nkb = K / 64, nb = item / nkb, kb = item % nkb;
    const int n4 = nb * 256 + lane * 4; if (n4 >= N) return;
    int orow = n4;
    if (MODE == 1) orow = (n4 < DFF) ? 256 * (n4 >> 7) + (n4 & 127) : 256 * ((n4 - DFF) >> 7) + 128 + ((n4 - DFF) & 127);
    const float* src = W + (size_t)(kb * 64) * N + n4;
    bf16_t* dst = Wt + (size_t)orow * K + kb * 64;
#pragma unroll 2
    for (int it = 0; it < 8; ++it) {
        f32x4 v[8];
#pragma unroll
        for (int j = 0; j < 8; ++j) v[j] = *(const f32x4*)(src + (size_t)(it * 8 + j) * N);
#pragma unroll
        for (int q = 0; q < 4; ++q) { u32x4 o; o.x = pk2(v[0][q], v[1][q]); o.y = pk2(v[2][q], v[3][q]); o.z = pk2(v[4][q], v[5][q]); o.w = pk2(v[6][q], v[7][q]);
            *(u32x4*)(dst + (size_t)q * K + it * 8) = o; }
    }
}
__device__ __forceinline__ void phase_prep(const Ctx& c) {
    const int gw = c.bid * 8 + c.wave, NGW = c.nb * 8;
    const float* w_in = c.in[3]; const float* w_out = c.in[15]; const float* w_up = c.in[17]; const float* w_dn = c.in[20]; const float* w_pg = c.in[22]; const float* w_ple = c.in[23];
    constexpr int I_IN = 41 * (D / 64), I_OUT = 8 * (DMIX / 64), I_UP = 44 * (D / 64), I_DN = 8 * (DFF / 64), I_PG = 8 * (D / 64), I_PLE = 8 * (DPLE / 64);
    constexpr int NIT = I_IN + I_OUT + I_UP + I_DN + I_PG + I_PLE;
    for (int it = gw; it < NIT; it += NGW) {
        int r = it;
        if (r < I_IN) { prep_w_item<0>(w_in, D, DIN, (bf16_t*)(c.ws + WS_WIN), r, c.lane); continue; } r -= I_IN;
        if (r < I_UP) { prep_w_item<1>(w_up, D, 2 * DFF, (bf16_t*)(c.ws + WS_WUP), r, c.lane); continue; } r -= I_UP;
        if (r < I_OUT) { prep_w_item<0>(w_out, DMIX, D, (bf16_t*)(c.ws + WS_WOUT), r, c.lane); continue; } r -= I_OUT;
        if (r < I_DN) { prep_w_item<0>(w_dn, DFF, D, (bf16_t*)(c.ws + WS_WDN), r, c.lane); continue; } r -= I_DN;
        if (r < I_PG) { prep_w_item<0>(w_pg, D, D, (bf16_t*)(c.ws + WS_WPG), r, c.lane); continue; } r -= I_PG;
        prep_w_item<0>(w_ple, DPLE, D, (bf16_t*)(c.ws + WS_WPLE), r, c.lane);
    }
    const float* x = c.in[0]; const float* g = c.in[2]; bf16_t* A = (bf16_t*)(c.ws + WS_A);
    for (int m = gw; m < S; m += NGW) {
        const float* xr = x + (size_t)m * D + 8 * c.lane; f32x4 v[4][2]; float s = 0.f;
#pragma unroll
        for (int j = 0; j < 4; ++j) { v[j][0] = *(const f32x4*)(xr + 512 * j); v[j][1] = *(const f32x4*)(xr + 512 * j + 4);
#pragma unroll
            for (int e = 0; e < 4; ++e) s += v[j][0][e] * v[j][0][e] + v[j][1][e] * v[j][1][e]; }
        const float rinv = 1.0f / sqrtf(wave_sum(s) * (1.0f / D) + EPS);
#pragma unroll
        for (int j = 0; j < 4; ++j) { const f32x4 g0 = *(const f32x4*)(g + 8 * c.lane + 512 * j), g1 = *(const f32x4*)(g + 8 * c.lane + 512 * j + 4);
            const f32x4 a0 = v[j][0] * rinv * g0, a1 = v[j][1] * rinv * g1;
            u32x4 o; o.x = pk2(a0[0], a0[1]); o.y = pk2(a0[2], a0[3]); o.z = pk2(a1[0], a1[1]); o.w = pk2(a1[2], a1[3]);
            *(u32x4*)(A + (size_t)m * D + 8 * c.lane + 512 * j) = o; }
    }
    const float* p = c.in[1]; bf16_t* P16 = (bf16_t*)(c.ws + WS_P16);
    for (size_t i = ((size_t)c.bid * 512 + c.tid) * 8; i < (size_t)S * DPLE; i += (size_t)c.nb * 512 * 8) {
        const f32x4 a0 = *(const f32x4*)(p + i), a1 = *(const f32x4*)(p + i + 4);
        u32x4 o; o.x = pk2(a0[0], a0[1]); o.y = pk2(a0[2], a0[3]); o.z = pk2(a1[0], a1[1]); o.w = pk2(a1[2], a1[3]);
        *(u32x4*)(P16 + i) = o;
    }
}

__device__ __forceinline__ void phase_dt(const Ctx& c) {
    const bf16_t* A = (const bf16_t*)(c.ws + WS_A); const bf16_t* Wdt = (const bf16_t*)(c.ws + WS_WIN) + (size_t)10240 * D;
    float* dt = (float*)(c.ws + WS_DT); const float* dtb = c.in[11];
    LAS float* red = (LAS float*)c.lds;
    const int r = c.lane & 31, h = c.lane >> 5;
    for (int item = c.bid; item < S / 32; item += c.nb) {
        const int row0 = item * 32;
        f32x16 acc; for (int i = 0; i < 16; ++i) acc[i] = 0.f;
        const bf16_t* ap = A + (size_t)(row0 + r) * D + c.wave * 256 + 8 * h;
        const bf16_t* bp = Wdt + (size_t)r * D + c.wave * 256 + 8 * h;
#pragma unroll 4
        for (int s = 0; s < 16; ++s) { const bf16x8 af = *(const bf16x8*)(ap + 16 * s), bfr = *(const bf16x8*)(bp + 16 * s);
            acc = __builtin_amdgcn_mfma_f32_32x32x16_bf16(af, bfr, acc, 0, 0, 0); }
#pragma unroll
        for (int i = 0; i < 16; ++i) red[(c.wave * 32 + ((i & 3) + 8 * (i >> 2) + 4 * h)) * 32 + r] = acc[i];
        __syncthreads();
        for (int o = c.tid; o < 1024; o += 512) { float s = 0.f;
#pragma unroll
            for (int w = 0; w < 8; ++w) s += red[w * 1024 + o];
            const int hd = o & 31; const float xv = s + dtb[hd];
            const float sp = xv > 20.f ? xv : log1pf(__expf(xv));
            dt[(size_t)(row0 + (o >> 5)) * 32 + hd] = sp; }
        __syncthreads();
    }
}

template <int W>
__device__ __forceinline__ void stage_conv_tile(const Ctx& c, LAS unsigned char* dst, int pitchB, int col0, int t0, const LAS float* scale) {
    const bf16_t* xbc = (const bf16_t*)(c.ws + WS_XBC); const float* cw = c.in[9]; const float* cb = c.in[10];
    constexpr int NCHK = W / 8, NGRPS = 512 / NCHK, RPT = 128 / NGRPS;
    const int ch = c.tid % NCHK, grp = c.tid / NCHK; const int cc = col0 + ch * 8;
    float w[4][8], b[8];
#pragma unroll
    for (int k = 0; k < 4; ++k) { const f32x4 a0 = *(const f32x4*)(cw + (size_t)k * DXBC + cc), a1 = *(const f32x4*)(cw + (size_t)k * DXBC + cc + 4);
#pragma unroll
        for (int e = 0; e < 4; ++e) { w[k][e] = a0[e]; w[k][4 + e] = a1[e]; } }
    { const f32x4 a0 = *(const f32x4*)(cb + cc), a1 = *(const f32x4*)(cb + cc + 4);
#pragma unroll
      for (int e = 0; e < 4; ++e) { b[e] = a0[e]; b[4 + e] = a1[e]; } }
    const int r0 = grp * RPT;
    float x0[8], x1[8], x2[8];
#pragma unroll
    for (int e = 0; e < 8; ++e) { x0[e] = 0.f; x1[e] = 0.f; x2[e] = 0.f; }
    {
        const int t = t0 + r0;
        if (t - 3 >= 0) { const u32x4 q = *(const u32x4*)(xbc + (size_t)(t - 3) * DXBC + cc); x0[0] = bflo(q.x); x0[1] = bfhi(q.x); x0[2] = bflo(q.y); x0[3] = bfhi(q.y); x0[4] = bflo(q.z); x0[5] = bfhi(q.z); x0[6] = bflo(q.w); x0[7] = bfhi(q.w); }
        if (t - 2 >= 0) { const u32x4 q = *(const u32x4*)(xbc + (size_t)(t - 2) * DXBC + cc); x1[0] = bflo(q.x); x1[1] = bfhi(q.x); x1[2] = bflo(q.y); x1[3] = bfhi(q.y); x1[4] = bflo(q.z); x1[5] = bfhi(q.z); x1[6] = bflo(q.w); x1[7] = bfhi(q.w); }
        if (t - 1 >= 0) { const u32x4 q = *(const u32x4*)(xbc + (size_t)(t - 1) * DXBC + cc); x2[0] = bflo(q.x); x2[1] = bfhi(q.x); x2[2] = bflo(q.y); x2[3] = bfhi(q.y); x2[4] = bflo(q.z); x2[5] = bfhi(q.z); x2[6] = bflo(q.w); x2[7] = bfhi(q.w); }
    }
#pragma unroll
    for (int i = 0; i < RPT; ++i) {
        const int rl = r0 + i, t = t0 + rl;
        const u32x4 q = *(const u32x4*)(xbc + (size_t)t * DXBC + cc);
        float x3[8]; x3[0] = bflo(q.x); x3[1] = bfhi(q.x); x3[2] = bflo(q.y); x3[3] = bfhi(q.y); x3[4] = bflo(q.z); x3[5] = bfhi(q.z); x3[6] = bflo(q.w); x3[7] = bfhi(q.w);
        float sc = 1.f; if (scale) sc = scale[rl * 4 + (ch * 8) / 64];
        float o[8];
#pragma unroll
        for (int e = 0; e < 8; ++e) { const float hsum = b[e] + w[0][e] * x0[e] + w[1][e] * x1[e] + w[2][e] * x2[e] + w[3][e] * x3[e]; o[e] = silu_f(hsum) * sc; x0[e] = x1[e]; x1[e] = x2[e]; x2[e] = x3[e]; }
        u32x4 ov; ov.x = pk2(o[0], o[1]); ov.y = pk2(o[2], o[3]); ov.z = pk2(o[4], o[5]); ov.w = pk2(o[6], o[7]);
        *(LAS u32x4*)(dst + rl * pitchB + ch * 16) = ov;
    }
}

__device__ __forceinline__ void ssd_tables(const Ctx& c, int ck, int g, LAS float* sdt, LAS float* sacs) {
    const float* dt = (const float*)(c.ws + WS_DT); const float* alog = c.in[12];
    { const int l = c.tid >> 2, h = c.tid & 3; const float dv = dt[(size_t)(ck * 128 + l) * 32 + g * 4 + h]; sdt[l * 4 + h] = dv; sacs[l * 4 + h] = dv * (-__expf(alog[g * 4 + h])); }
    __syncthreads();
    if (c.wave < 4) { const int h = c.wave; const float v0 = sacs[(2 * c.lane) * 4 + h], v1 = sacs[(2 * c.lane + 1) * 4 + h]; float s = v0 + v1;
#pragma unroll
        for (int d = 1; d < 64; d <<= 1) { const float t = __shfl_up(s, d); if (c.lane >= d) s += t; }
        const float ex = s - (v0 + v1);
        sacs[(2 * c.lane) * 4 + h] = ex + v0; sacs[(2 * c.lane + 1) * 4 + h] = s; }
    __syncthreads();
}

constexpr int XS_PITCH = 576, BC_PITCH = 320;
constexpr int L_XS = 0, L_B = 128 * XS_PITCH, L_C = L_B + 128 * BC_PITCH, L_TAB = L_C + 128 * BC_PITCH;
constexpr int L_SDT = L_TAB, L_SACS = L_TAB + 2048, L_SW = L_TAB + 4096, L_MISC = L_TAB + 6144;
static_assert(L_MISC + 2048 <= LDS_BYTES, "mixer LDS map");

__device__ __forceinline__ void ssd_a_item(const Ctx& c, int ck, int g) {
    LAS float* sdt = (LAS float*)(c.lds + L_SDT); LAS float* sacs = (LAS float*)(c.lds + L_SACS); LAS float* sw = (LAS float*)(c.lds + L_SW);
    ssd_tables(c, ck, g, sdt, sacs);
    { const int l = c.tid >> 2, h = c.tid & 3; sw[l * 4 + h] = sdt[l * 4 + h] * __expf(sacs[127 * 4 + h] - sacs[l * 4 + h]); }
    if (c.tid < 4) ((float*)(c.ws + WS_CDEC))[ck * 32 + g * 4 + c.tid] = __expf(sacs[127 * 4 + c.tid]);
    __syncthreads();
    stage_conv_tile<256>(c, c.lds + L_XS, XS_PITCH, g * 256, ck * 128, sw);
    stage_conv_tile<128>(c, c.lds + L_B, BC_PITCH, DSSM + g * 128, ck * 128, nullptr);
    __syncthreads();
    bf16_t* st = (bf16_t*)(c.ws + WS_ST) + (size_t)(ck * 32 + g * 4) * 64 * 128;
    for (int o = c.tid; o < 4 * 64 * 128; o += 512) { const int n = o & 127, hp = o >> 7; float s = 0.f;
        for (int l = 0; l < 128; ++l) s += bf2f(*(LAS bf16_t*)(c.lds + L_B + l * BC_PITCH + n * 2)) * bf2f(*(LAS bf16_t*)(c.lds + L_XS + l * XS_PITCH + hp * 2));
        st[o] = (bf16_t)f2bf(s); }
    __syncthreads();
}

__device__ __forceinline__ void gmlp_item(const Ctx& c, int ck, int g) {
    bf16_t* uv = (bf16_t*)(c.ws + WS_UV);
    LAS float* vn = (LAS float*)c.lds;
    LAS float* ssq = (LAS float*)(c.lds + 65536);
    const float* lng = c.in[4] + g * 128; const float* lnb = c.in[5] + g * 128; const float* Ws = c.in[6] + (size_t)g * 128 * 128; const float* bs = c.in[7] + g * 128; const float* nag = c.in[8] + g * 128;
    for (int s = c.wave; s < 128; s += 8) {
        const bf16_t* vr = uv + (size_t)(ck * 128 + s) * DMIX + DA + g * 128;
        const float a0 = bf2f(vr[c.lane]), a1 = bf2f(vr[c.lane + 64]);
        const float mu = wave_sum(a0 + a1) * (1.0f / 128.0f); const float d0 = a0 - mu, d1 = a1 - mu;
        const float var = wave_sum(d0 * d0 + d1 * d1) * (1.0f / 128.0f); const float rs = 1.0f / sqrtf(var + EPS);
        vn[s * 128 + c.lane] = d0 * rs * lng[c.lane] + lnb[c.lane]; vn[s * 128 + c.lane + 64] = d1 * rs * lng[c.lane + 64] + lnb[c.lane + 64];
    }
    __syncthreads();
    const int d = c.tid & 127;
    for (int j = 0; j < 32; ++j) {
        const int t = (c.tid >> 7) + 4 * j; float sg = bs[t]; const float* wr_ = Ws + t * 128;
        for (int s = 0; s <= t; ++s) sg += wr_[s] * vn[s * 128 + d];
        bf16_t* up = uv + (size_t)(ck * 128 + t) * DMIX + g * 128 + d;
        const float y = bf2f(*up) * sg;
        *up = (bf16_t)f2bf(y * nag[d]);
        const float q = wave_sum(y * y);
        if (c.lane == 0) ssq[t * 2 + (c.wave & 1)] = q;
    }
    __syncthreads();
    if (c.tid < 128) ((float*)(c.ws + WS_SSQA))[(size_t)(ck * 128 + c.tid) * 16 + g] = ssq[c.tid * 2] + ssq[c.tid * 2 + 1];
    __syncthreads();
}

typedef short s16x4 __attribute__((ext_vector_type(4)));
typedef short v4i16_t __attribute__((ext_vector_type(4)));
__device__ __forceinline__ s16x4 ds_tr(LAS const unsigned char* p) { return __builtin_bit_cast(s16x4, __builtin_amdgcn_ds_read_tr16_b64_v4i16((LAS v4i16_t*)p)); }
__device__ __forceinline__ bf16x8 frag_tr(LAS const unsigned char* tile, int pitch, int k0, int c0, int lane) {
    const int hh = lane >> 5, blk = (lane >> 4) & 1, q = (lane & 15) >> 2, p = lane & 3;
    LAS const unsigned char* a = tile + (k0 + 8 * hh + q) * pitch + (c0 + 16 * blk + 4 * p) * 2;
    const s16x4 lo = ds_tr(a), hi = ds_tr(a + 4 * pitch);
    return __builtin_shufflevector(lo, hi, 0, 1, 2, 3, 4, 5, 6, 7);
}
__device__ __forceinline__ bf16x8 frag_tr_perm(LAS const unsigned char* tile, int pitch, int k0, int c0, int lane) {
    const int hh = lane >> 5, blk = (lane >> 4) & 1, q = (lane & 15) >> 2, p = lane & 3;
    LAS const unsigned char* a = tile + (k0 + 4 * hh + q) * pitch + (c0 + 16 * blk + 4 * p) * 2;
    const s16x4 lo = ds_tr(a), hi = ds_tr(a + 8 * pitch);
    return __builtin_shufflevector(lo, hi, 0, 1, 2, 3, 4, 5, 6, 7);
}
__device__ __forceinline__ bf16x8 frag_row(LAS const unsigned char* tile, int pitch, int r0, int k0, int lane) {
    return *(LAS const bf16x8*)(tile + (r0 + (lane & 31)) * pitch + (k0 + 8 * (lane >> 5)) * 2);
}
__device__ __forceinline__ bf16x8 pack_frag(const float* v) {
    u32x4 w; w.x = cvt_pk_bf16(v[0], v[1]); w.y = cvt_pk_bf16(v[2], v[3]); w.z = cvt_pk_bf16(v[4], v[5]); w.w = cvt_pk_bf16(v[6], v[7]);
    return __builtin_bit_cast(bf16x8, w);
}
#define MFMA32(a, b, c) __builtin_amdgcn_mfma_f32_32x32x16_bf16((a), (b), (c), 0, 0, 0)

__device__ __forceinline__ void gmlp_item_mfma(const Ctx& c, int ck, int g) {
    constexpr int VP = 320;
    bf16_t* uv = (bf16_t*)(c.ws + WS_UV);
    LAS unsigned char* vt = c.lds;
    LAS float* part = (LAS float*)(c.lds + 128 * VP);
    const float* lng = c.in[4] + g * 128; const float* lnb = c.in[5] + g * 128; const float* Ws = c.in[6] + (size_t)g * 128 * 128; const float* bs = c.in[7] + g * 128; const float* nag = c.in[8] + g * 128;
    const int lane = c.lane;
    { const f32x2 gg = *(const f32x2*)(lng + 2 * lane), bb = *(const f32x2*)(lnb + 2 * lane);
      for (int s = c.wave; s < 128; s += 8) {
        const unsigned w = *(const unsigned*)(uv + (size_t)(ck * 128 + s) * DMIX + DA + g * 128 + 2 * lane);
        const float a0 = bflo(w), a1 = bfhi(w);
        const float mu = wave_sum(a0 + a1) * (1.0f / 128.0f); const float d0 = a0 - mu, d1 = a1 - mu;
        const float var = wave_sum(d0 * d0 + d1 * d1) * (1.0f / 128.0f); const float rs = 1.0f / sqrtf(var + EPS);
        *(LAS unsigned*)(vt + s * VP + 4 * lane) = pk2(d0 * rs * gg[0] + bb[0], d1 * rs * gg[1] + bb[1]);
      } }
    __syncthreads();
    const int db = c.wave & 3, hh = lane >> 5, r = lane & 31;
#pragma unroll
    for (int tt = 0; tt < 2; ++tt) {
        const int tb = (c.wave < 4) ? (tt ? 3 : 0) : (tt ? 2 : 1);
        f32x16 acc; for (int i = 0; i < 16; ++i) acc[i] = 0.f;
        const int t = tb * 32 + r;
        const float* wrow = Ws + t * 128;
        for (int ks = 0; ks < 2 * (tb + 1); ++ks) {
            const int s0 = 16 * ks + 8 * hh;
            const f32x4 w0 = *(const f32x4*)(wrow + s0), w1 = *(const f32x4*)(wrow + s0 + 4);
            float wv[8];
#pragma unroll
            for (int j = 0; j < 4; ++j) { wv[j] = (s0 + j <= t) ? w0[j] : 0.f; wv[4 + j] = (s0 + 4 + j <= t) ? w1[j] : 0.f; }
            const bf16x8 bfrag = pack_frag(wv);
            const bf16x8 afrag = frag_tr(vt, VP, 16 * ks, db * 32, lane);
            acc = MFMA32(afrag, bfrag, acc);
        }
        const float bst = bs[t];
        bf16_t* urow = uv + (size_t)(ck * 128 + t) * DMIX + g * 128 + db * 32;
        float ss = 0.f;
#pragma unroll
        for (int gq = 0; gq < 4; ++gq) {
            const int dl = 8 * gq + 4 * hh;
            const u32x2 uw = *(const u32x2*)(urow + dl);
            const f32x4 na = *(const f32x4*)(nag + db * 32 + dl);
            const float y0 = bflo(uw.x) * (acc[4 * gq] + bst), y1 = bfhi(uw.x) * (acc[4 * gq + 1] + bst), y2 = bflo(uw.y) * (acc[4 * gq + 2] + bst), y3 = bfhi(uw.y) * (acc[4 * gq + 3] + bst);
            ss += (y0 * y0 + y1 * y1) + (y2 * y2 + y3 * y3);
            u32x2 o; o.x = pk2(y0 * na[0], y1 * na[1]); o.y = pk2(y2 * na[2], y3 * na[3]);
            *(u32x2*)(urow + dl) = o;
        }
        ss += __shfl_xor(ss, 32);
        if (hh == 0) part[t * 4 + db] = ss;
    }
    __syncthreads();
    if (c.tid < 128) ((float*)(c.ws + WS_SSQA))[(size_t)(ck * 128 + c.tid) * 16 + g] = (part[c.tid * 4] + part[c.tid * 4 + 1]) + (part[c.tid * 4 + 2] + part[c.tid * 4 + 3]);
    __syncthreads();
}

__device__ __forceinline__ void ssd_a_item_mfma(const Ctx& c, int ck, int g) {
    LAS float* sdt = (LAS float*)(c.lds + L_SDT); LAS float* sacs = (LAS float*)(c.lds + L_SACS); LAS float* sw = (LAS float*)(c.lds + L_SW);
    ssd_tables(c, ck, g, sdt, sacs);
    { const int l = c.tid >> 2, h = c.tid & 3; sw[l * 4 + h] = sdt[l * 4 + h] * __expf(sacs[127 * 4 + h] - sacs[l * 4 + h]); }
    if (c.tid < 4) ((float*)(c.ws + WS_CDEC))[ck * 32 + g * 4 + c.tid] = __expf(sacs[127 * 4 + c.tid]);
    __syncthreads();
    stage_conv_tile<256>(c, c.lds + L_XS, XS_PITCH, g * 256, ck * 128, sw);
    stage_conv_tile<128>(c, c.lds + L_B, BC_PITCH, DSSM + g * 128, ck * 128, nullptr);
    __syncthreads();
    const int lane = c.lane, h = c.wave >> 1, pb = c.wave & 1, hh = lane >> 5, r = lane & 31;
    f32x16 acc[4];
#pragma unroll
    for (int nb = 0; nb < 4; ++nb) for (int i = 0; i < 16; ++i) acc[nb][i] = 0.f;
#pragma unroll 2
    for (int ks = 0; ks < 8; ++ks) {
        const bf16x8 xf = frag_tr(c.lds + L_XS, XS_PITCH, 16 * ks, h * 64 + pb * 32, lane);
#pragma unroll
        for (int nb = 0; nb < 4; ++nb) { const bf16x8 bfg = frag_tr(c.lds + L_B, BC_PITCH, 16 * ks, nb * 32, lane); acc[nb] = MFMA32(bfg, xf, acc[nb]); }
    }
    bf16_t* st = (bf16_t*)(c.ws + WS_ST) + ((size_t)(ck * 32 + g * 4 + h) * 64 + pb * 32 + r) * 128;
#pragma unroll
    for (int nb = 0; nb < 4; ++nb)
#pragma unroll
        for (int gq = 0; gq < 4; ++gq) { u32x2 o; o.x = pk2(acc[nb][4 * gq], acc[nb][4 * gq + 1]); o.y = pk2(acc[nb][4 * gq + 2], acc[nb][4 * gq + 3]);
            *(u32x2*)(st + nb * 32 + 8 * gq + 4 * hh) = o; }
    __syncthreads();
}

constexpr int BC2_PITCH = 272;
__device__ __forceinline__ void ssd_c_item_mfma(const Ctx& c, int ck, int g) {
    LAS float* sdt = (LAS float*)(c.lds + L_SDT); LAS float* sacs = (LAS float*)(c.lds + L_SACS); LAS float* part = (LAS float*)(c.lds + L_SW);
    ssd_tables(c, ck, g, sdt, sacs);
    stage_conv_tile<256>(c, c.lds + L_XS, XS_PITCH, g * 256, ck * 128, nullptr);
    stage_conv_tile<128>(c, c.lds + L_B, BC2_PITCH, DSSM + g * 128, ck * 128, nullptr);
    stage_conv_tile<128>(c, c.lds + L_C, BC2_PITCH, DSSM + NGRP * NST + g * 128, ck * 128, nullptr);
    __syncthreads();
    const int lane = c.lane, h = c.wave >> 1, hh = lane >> 5, r = lane & 31;
    const float Dh = c.in[13][g * 4 + h];
    const bf16_t* hin = (const bf16_t*)(c.ws + WS_ST) + (size_t)(ck * 32 + g * 4 + h) * 64 * 128;
    LAS const unsigned char* xs = c.lds + L_XS; LAS const unsigned char* bt = c.lds + L_B; LAS const unsigned char* ct = c.lds + L_C;
    f32x16 acc[2][2];
#pragma unroll
    for (int lbi = 0; lbi < 2; ++lbi) {
        const int lb = (c.wave & 1) ? (lbi ? 2 : 1) : (lbi ? 3 : 0);
        const int l = lb * 32 + r;
        bf16x8 cf[8];
#pragma unroll
        for (int ks = 0; ks < 8; ++ks) cf[ks] = frag_row(ct, BC2_PITCH, lb * 32, 16 * ks, lane);
        f32x16 a0, a1; for (int i = 0; i < 16; ++i) { a0[i] = 0.f; a1[i] = 0.f; }
#pragma unroll
        for (int ks = 0; ks < 8; ++ks) {
            const bf16x8 h0 = *(const bf16x8*)(hin + (size_t)r * 128 + 16 * ks + 8 * hh), h1 = *(const bf16x8*)(hin + (size_t)(32 + r) * 128 + 16 * ks + 8 * hh);
            a0 = MFMA32(h0, cf[ks], a0); a1 = MFMA32(h1, cf[ks], a1);
        }
        const float al = sacs[l * 4 + h]; const float ea = __expf(al);
        a0 = a0 * ea; a1 = a1 * ea;
        for (int sb = 0; sb <= lb; ++sb) {
            f32x16 X; for (int i = 0; i < 16; ++i) X[i] = 0.f;
#pragma unroll
            for (int ks = 0; ks < 8; ++ks) X = MFMA32(frag_row(bt, BC2_PITCH, sb * 32, 16 * ks, lane), cf[ks], X);
            bf16x8 mf[2];
#pragma unroll
            for (int kk = 0; kk < 2; ++kk) {
                float mv[8];
#pragma unroll
                for (int j = 0; j < 8; ++j) {
                    const int sidx = sb * 32 + 16 * kk + 8 * (j >> 2) + 4 * hh + (j & 3);
                    float v = X[8 * kk + j] * __expf(al - sacs[sidx * 4 + h]) * sdt[sidx * 4 + h];
                    v = (sidx <= l) ? v : 0.f;
                    mv[j] = (sidx == l) ? v + Dh : v;
                }
                mf[kk] = pack_frag(mv);
            }
#pragma unroll
            for (int kk = 0; kk < 2; ++kk) {
                const bf16x8 x0 = frag_tr_perm(xs, XS_PITCH, sb * 32 + 16 * kk, h * 64, lane), x1 = frag_tr_perm(xs, XS_PITCH, sb * 32 + 16 * kk, h * 64 + 32, lane);
                a0 = MFMA32(x0, mf[kk], a0); a1 = MFMA32(x1, mf[kk], a1);
            }
        }
        acc[lbi][0] = a0; acc[lbi][1] = a1;
    }
    const bf16_t* zs = (const bf16_t*)(c.ws + WS_ZS); bf16_t* cat = (bf16_t*)(c.ws + WS_UV); const float* ng = c.in[14] + g * 256 + h * 64;
#pragma unroll
    for (int lbi = 0; lbi < 2; ++lbi) {
        const int lb = (c.wave & 1) ? (lbi ? 2 : 1) : (lbi ? 3 : 0);
        const int l = lb * 32 + r; const size_t row = (size_t)ck * 128 + l;
        float ss = 0.f;
#pragma unroll
        for (int pb = 0; pb < 2; ++pb)
#pragma unroll
            for (int gq = 0; gq < 4; ++gq) { const int p0 = pb * 32 + 8 * gq + 4 * hh;
                const u32x2 zw = *(const u32x2*)(zs + row * DSSM + g * 256 + h * 64 + p0);
                const float y0 = acc[lbi][pb][4 * gq] * bflo(zw.x), y1 = acc[lbi][pb][4 * gq + 1] * bfhi(zw.x), y2 = acc[lbi][pb][4 * gq + 2] * bflo(zw.y), y3 = acc[lbi][pb][4 * gq + 3] * bfhi(zw.y);
                acc[lbi][pb][4 * gq] = y0; acc[lbi][pb][4 * gq + 1] = y1; acc[lbi][pb][4 * gq + 2] = y2; acc[lbi][pb][4 * gq + 3] = y3;
                ss += (y0 * y0 + y1 * y1) + (y2 * y2 + y3 * y3); }
        ss += __shfl_xor(ss, 32);
        if (hh == 0) part[l * 4 + h] = ss;
    }
    __syncthreads();
#pragma unroll
    for (int lbi = 0; lbi < 2; ++lbi) {
        const int lb = (c.wave & 1) ? (lbi ? 2 : 1) : (lbi ? 3 : 0);
        const int l = lb * 32 + r; const size_t row = (size_t)ck * 128 + l;
        const float rinv = 1.0f / sqrtf(((part[l * 4] + part[l * 4 + 1]) + (part[l * 4 + 2] + part[l * 4 + 3])) * (1.0f / 256.0f) + EPS);
#pragma unroll
        for (int pb = 0; pb < 2; ++pb)
#pragma unroll
            for (int gq = 0; gq < 4; ++gq) { const int p0 = pb * 32 + 8 * gq + 4 * hh;
                const f32x4 gg = *(const f32x4*)(ng + p0);
                u32x2 o; o.x = pk2(acc[lbi][pb][4 * gq] * rinv * gg[0], acc[lbi][pb][4 * gq + 1] * rinv * gg[1]); o.y = pk2(acc[lbi][pb][4 * gq + 2] * rinv * gg[2], acc[lbi][pb][4 * gq + 3] * rinv * gg[3]);
                *(u32x2*)(cat + row * DMIX + DA + g * 256 + h * 64 + p0) = o; }
    }
    __syncthreads();
}

#ifndef MIX_GMLP_MFMA
#define MIX_GMLP_MFMA 1
#endif
#ifndef MIX_SSDA_MFMA
#define MIX_SSDA_MFMA 1
#endif
#ifndef MIX_SSDC_MFMA
#define MIX_SSDC_MFMA 1
#endif

__device__ __forceinline__ void phase_mix_a(const Ctx& c) {
    for (int it = c.bid; it < NCH * NGA + NCH * NGRP; it += c.nb) {
        if (it < NCH * NGA) { if (MIX_GMLP_MFMA) gmlp_item_mfma(c, it >> 4, it & 15); else gmlp_item(c, it >> 4, it & 15); }
        else { const int r = it - NCH * NGA; if (MIX_SSDA_MFMA) ssd_a_item_mfma(c, r >> 3, r & 7); else ssd_a_item(c, r >> 3, r & 7); }
    }
}

__device__ __forceinline__ void phase_scan(const Ctx& c) {
    unsigned* st = (unsigned*)(c.ws + WS_ST); const float* cdec = (const float*)(c.ws + WS_CDEC);
    for (int e = c.bid * 512 + c.tid; e < 32 * 64 * 64; e += c.nb * 512) {
        const int head = e >> 12; float h0 = 0.f, h1 = 0.f;
#pragma unroll 8
        for (int ck = 0; ck < NCH; ++ck) { const size_t idx = (size_t)ck * (32 * 64 * 64) + e; const unsigned w = st[idx]; const float dc = cdec[ck * 32 + head];
            st[idx] = pk2(h0, h1); h0 = dc * h0 + bflo(w); h1 = dc * h1 + bfhi(w); }
    }
    bf16_t* uv = (bf16_t*)(c.ws + WS_UV); const float* sq = (const float*)(c.ws + WS_SSQA);
    for (int i = c.bid * 512 + c.tid; i < S * (DA / 8); i += c.nb * 512) { const int row = i >> 8, ch = i & 255;
        const f32x4 q0 = *(const f32x4*)(sq + row * 16), q1 = *(const f32x4*)(sq + row * 16 + 4), q2 = *(const f32x4*)(sq + row * 16 + 8), q3 = *(const f32x4*)(sq + row * 16 + 12);
        float s = 0.f;
#pragma unroll
        for (int e = 0; e < 4; ++e) s += q0[e] + q1[e] + q2[e] + q3[e];
        const float rinv = 1.0f / sqrtf(s * (1.0f / DA) + EPS);
        u32x4* pp = (u32x4*)(uv + (size_t)row * DMIX + ch * 8); const u32x4 w = *pp; u32x4 o;
        o.x = pk2(bflo(w.x) * rinv, bfhi(w.x) * rinv); o.y = pk2(bflo(w.y) * rinv, bfhi(w.y) * rinv); o.z = pk2(bflo(w.z) * rinv, bfhi(w.z) * rinv); o.w = pk2(bflo(w.w) * rinv, bfhi(w.w) * rinv);
        *pp = o; }
}

__device__ __forceinline__ void ssd_c_item(const Ctx& c, int ck, int g) {
    LAS float* sdt = (LAS float*)(c.lds + L_SDT); LAS float* sacs = (LAS float*)(c.lds + L_SACS); LAS float* part = (LAS float*)(c.lds + L_SW);
    ssd_tables(c, ck, g, sdt, sacs);
    stage_conv_tile<256>(c, c.lds + L_XS, XS_PITCH, g * 256, ck * 128, nullptr);
    stage_conv_tile<128>(c, c.lds + L_B, BC_PITCH, DSSM + g * 128, ck * 128, nullptr);
    stage_conv_tile<128>(c, c.lds + L_C, BC_PITCH, DSSM + NGRP * NST + g * 128, ck * 128, nullptr);
    __syncthreads();
    float* G = (float*)(c.ws + WS_GSCR) + (size_t)c.bid * 16384;
    for (int o = c.tid; o < 16384; o += 512) { const int s = o & 127, l = o >> 7; float a = 0.f;
        if (s <= l) for (int n = 0; n < 128; ++n) a += bf2f(*(LAS bf16_t*)(c.lds + L_C + l * BC_PITCH + n * 2)) * bf2f(*(LAS bf16_t*)(c.lds + L_B + s * BC_PITCH + n * 2));
        __hip_atomic_store(G + o, a, __ATOMIC_RELAXED, __HIP_MEMORY_SCOPE_AGENT); }
    asm volatile("s_waitcnt vmcnt(0)" ::: "memory");
    __syncthreads();
    const bf16_t* hin = (const bf16_t*)(c.ws + WS_ST) + (size_t)(ck * 32 + g * 4) * 64 * 128;
    const bf16_t* zs = (const bf16_t*)(c.ws + WS_ZS); bf16_t* cat = (bf16_t*)(c.ws + WS_UV); const float* dsk = c.in[13]; const float* ng = c.in[14];
    const int hp = c.tid & 255, h = hp >> 6; const float Dh = dsk[g * 4 + h];
    for (int j = 0; j < 64; ++j) { const int l = (c.tid >> 8) + 2 * j; const float al = sacs[l * 4 + h];
        float y = 0.f;
        for (int s = 0; s <= l; ++s) y += __hip_atomic_load(G + l * 128 + s, __ATOMIC_RELAXED, __HIP_MEMORY_SCOPE_AGENT) * __expf(al - sacs[s * 4 + h]) * sdt[s * 4 + h] * bf2f(*(LAS bf16_t*)(c.lds + L_XS + s * XS_PITCH + hp * 2));
        float yo = 0.f;
        for (int n = 0; n < 128; ++n) yo += bf2f(*(LAS bf16_t*)(c.lds + L_C + l * BC_PITCH + n * 2)) * bf2f(hin[hp * 128 + n]);
        y += __expf(al) * yo + Dh * bf2f(*(LAS bf16_t*)(c.lds + L_XS + l * XS_PITCH + hp * 2));
        const size_t row = (size_t)ck * 128 + l;
        y *= bf2f(zs[row * DSSM + g * 256 + hp]);
        const float q = wave_sum(y * y);
        if (c.lane == 0) part[l * 4 + (c.wave & 3)] = q;
        cat[row * DMIX + DA + g * 256 + hp] = (bf16_t)f2bf(y);
    }
    __syncthreads();
    for (int j = 0; j < 64; ++j) { const int l = (c.tid >> 8) + 2 * j; const size_t row = (size_t)ck * 128 + l;
        const float rinv = 1.0f / sqrtf(((part[l * 4] + part[l * 4 + 1]) + (part[l * 4 + 2] + part[l * 4 + 3])) * (1.0f / 256.0f) + EPS);
        bf16_t* pp = cat + row * DMIX + DA + g * 256 + hp;
        *pp = (bf16_t)f2bf(bf2f(*pp) * rinv * ng[g * 256 + hp]); }
    __syncthreads();
}

__device__ __forceinline__ void phase_mix_c(const Ctx& c) {
    for (int it = c.bid; it < NCH * NGRP; it += c.nb) { if (MIX_SSDC_MFMA) ssd_c_item_mfma(c, it >> 3, it & 7); else ssd_c_item(c, it >> 3, it & 7); }
}

__device__ __forceinline__ void phase_final(const Ctx& c) {
    const int gw = c.bid * 8 + c.wave, NGW = c.nb * 8; const float* g = c.in[24]; const float* sq = (const float*)(c.ws + WS_SSQ3);
    for (int m = gw; m < S; m += NGW) {
        const f32x4 q0 = *(const f32x4*)(sq + (size_t)m * 8), q1 = *(const f32x4*)(sq + (size_t)m * 8 + 4);
        const float rinv = 1.0f / sqrtf(((q0[0] + q0[1]) + (q0[2] + q0[3]) + (q1[0] + q1[1]) + (q1[2] + q1[3])) * (1.0f / D) + EPS);
        float* orow = c.out + (size_t)m * D + 4 * c.lane;
#pragma unroll
        for (int j = 0; j < 8; ++j) { const f32x4 v = *(const f32x4*)(orow + 256 * j), gg = *(const f32x4*)(g + 4 * c.lane + 256 * j); *(f32x4*)(orow + 256 * j) = v * rinv * gg; }
    }
}

#define XB_TMO      128
#define XB_XCNT(j)  (256  + 64 * (j))
#define XB_XSUB(j)  (1280 + 64 * (j))
#define XB_XGEN(j)  (2304 + 64 * (j))
#define XB_TOP      3328
#define XB_TOPGEN   3392
#define XCD_BAR_WORDS 3456
#define XB_SPIN_CAP (1u << 20)
__device__ __forceinline__ unsigned xb_ld(unsigned* p)              { return __hip_atomic_load(p, __ATOMIC_RELAXED, __HIP_MEMORY_SCOPE_AGENT); }
__device__ __forceinline__ unsigned xb_add(unsigned* p, unsigned v) { return __hip_atomic_fetch_add(p, v, __ATOMIC_RELAXED, __HIP_MEMORY_SCOPE_AGENT); }
__device__ __forceinline__ unsigned xb_xcc_id() { return (unsigned)__builtin_amdgcn_s_getreg((3 << 11) | 20) & 0xFu; }
#define XB_SPIN(cond, bar) do { unsigned _sp = 0; while (cond) { __builtin_amdgcn_s_sleep(1); \
    if ((++_sp & 255u) == 0u) { if (xb_ld(&(bar)[XB_TMO])) break; if (_sp > XB_SPIN_CAP) { atomicAdd(&(bar)[XB_TMO], 1u); break; } } } } while (0)
struct XcdBarrier { unsigned* bar; unsigned x; volatile LAS unsigned* st; };
__device__ __forceinline__ XcdBarrier xcd_barrier_post(unsigned* bar, volatile LAS unsigned* st) {
    XcdBarrier b; b.bar = bar; b.x = xb_xcc_id(); b.st = st;
    if (threadIdx.x == 0) (void)xb_add(&bar[XB_XCNT(b.x)], 1u);
    return b;
}
__device__ __forceinline__ void xcd_barrier_complete(unsigned* bar, unsigned x, unsigned& nloc, unsigned& nx) {
    const unsigned G = gridDim.x * gridDim.y * gridDim.z;
    unsigned sum, cnt, mine, sp = 0u;
    for (;;) {
        sum = 0u; cnt = 0u; mine = 0u;
#pragma unroll
        for (unsigned j = 0; j < 16; ++j) { const unsigned c = xb_ld(&bar[XB_XCNT(j)]); sum += c; cnt += (c > 0u) ? 1u : 0u; mine = (j == x) ? c : mine; }
        if (sum == G) break;
        __builtin_amdgcn_s_sleep(1);
        if ((++sp & 255u) == 0u) { if (xb_ld(&bar[XB_TMO])) break; if (sp > XB_SPIN_CAP) { atomicAdd(&bar[XB_TMO], 1u); break; } }
    }
    nloc = mine > 0u ? mine : 1u; nx = cnt > 0u ? cnt : 1u;
}
__device__ __forceinline__ void xcd_barrier(const XcdBarrier& b) {
    asm volatile("s_waitcnt vmcnt(0)" ::: "memory");
    __syncthreads();
    if (threadIdx.x == 0) {
        unsigned* bar = b.bar;
        __builtin_amdgcn_s_waitcnt(0);
        unsigned nloc = b.st[0], nx = b.st[1];
        if (nloc == 0u) { xcd_barrier_complete(bar, b.x, nloc, nx); b.st[0] = nloc; b.st[1] = nx; }
        const unsigned old = xb_add(&bar[XB_XSUB(b.x)], 1u);
        const unsigned gen = old / nloc;
        if (old + 1u == (gen + 1u) * nloc) {
            __builtin_amdgcn_fence(__ATOMIC_RELEASE, "agent");
            asm volatile("s_waitcnt vmcnt(0)" ::: "memory");
            const unsigned og = xb_add(&bar[XB_TOP], 1u);
            const unsigned tg = og / nx;
            if (og + 1u == (tg + 1u) * nx) xb_add(&bar[XB_TOPGEN], 1u);
            else XB_SPIN(xb_ld(&bar[XB_TOPGEN]) == tg, bar);
            __builtin_amdgcn_fence(__ATOMIC_ACQUIRE, "agent");
            xb_add(&bar[XB_XGEN(b.x)], 1u);
            asm volatile("s_waitcnt vmcnt(0)" ::: "memory");
        } else {
            XB_SPIN(xb_ld(&bar[XB_XGEN(b.x)]) == gen, bar);
            __builtin_amdgcn_fence(__ATOMIC_ACQUIRE, "agent");
            asm volatile("s_waitcnt vmcnt(0)" ::: "memory");
        }
    }
    __syncthreads();
}

__global__ void __launch_bounds__(512, 2) mega_fwd(Params P, int ph_lo, int ph_hi) {
    extern __shared__ __attribute__((aligned(16))) unsigned char lds_raw[];
    Ctx c;
    c.lds = (LAS unsigned char*)lds_raw; c.tid = threadIdx.x; c.lane = c.tid & 63; c.wave = __builtin_amdgcn_readfirstlane(c.tid >> 6);
    c.nb = gridDim.x; c.bid = blockIdx.x; c.in = P.in; c.out = P.out; c.ws = P.ws;
    unsigned char* ws = P.ws;
    volatile LAS unsigned* bst = (volatile LAS unsigned*)(c.lds + L_MISC);
    if (c.tid < 2) bst[c.tid] = 0u;
    __syncthreads();
    const XcdBarrier xbar = xcd_barrier_post((unsigned*)ws, bst);
#ifndef PH_MASK
#define PH_MASK 0x3ff
#endif
#define IN(k) (((PH_MASK >> (k)) & 1) && ph_lo <= (k) && (k) < ph_hi)
#ifndef CG_SEAM
#define CG_SEAM 0
#endif
#define SEAM(k) do { if (IN(k) && IN((k) + 1)) { if ((k) == CG_SEAM) cg::this_grid().sync(); else xcd_barrier(xbar); } } while (0)
    if (IN(0)) phase_prep(c);
    SEAM(0);
    if (IN(1)) {
        pg8::Gemm g{(const bf16_t*)(ws + WS_A), (const bf16_t*)(ws + WS_WIN), D}; pg8::StaticOrder So; So.init(32, 40, c.nb, c.bid);
        EpiProj E{(bf16_t*)(ws + WS_UV), (bf16_t*)(ws + WS_ZS), (bf16_t*)(ws + WS_XBC)};
        pg8::gemm_phase<EpiProj, true, true>(c.lds, g, So, E);
        phase_dt(c);
    }
    SEAM(1);
    if (IN(2)) phase_mix_a(c);
    SEAM(2);
    if (IN(3)) phase_scan(c);
    SEAM(3);
    if (IN(4)) phase_mix_c(c);
    SEAM(4);
    if (IN(5)) {
        { pg8::Gemm g{(const bf16_t*)(ws + WS_UV), (const bf16_t*)(ws + WS_WOUT), DMIX}; pg8::StaticOrder So; So.init(32, 8, c.nb, c.bid);
          EpiResid E{P.in[0], P.out, (bf16_t*)(ws + WS_HG), (bf16_t*)(ws + WS_HG) + (size_t)S * D, P.in[16], (float*)(ws + WS_SSQ1)};
          pg8::gemm_phase<EpiResid, false, true>(c.lds, g, So, E); }
        { pg8::Gemm g{(const bf16_t*)(ws + WS_P16), (const bf16_t*)(ws + WS_WPLE), DPLE}; pg8::StaticOrder So; So.init(32, 8, c.nb, c.bid);
          EpiPlain E{(bf16_t*)(ws + WS_E), D};
          pg8::gemm_phase<EpiPlain, true, true>(c.lds, g, So, E); }
    }
    SEAM(5);
    if (IN(6)) {
        pg8::Gemm g{(const bf16_t*)(ws + WS_HG), (const bf16_t*)(ws + WS_WUP), D}; pg8::StaticOrder So; So.init(34, 44, c.nb, c.bid);
        EpiFfn E{(bf16_t*)(ws + WS_ACT), (const float*)(ws + WS_SSQ1), P.in[18], P.in[19]};
        pg8::gemm_phase<EpiFfn, true, true>(c.lds, g, So, E);
    }
    SEAM(6);
    if (IN(7)) {
        pg8::Gemm g{(const bf16_t*)(ws + WS_ACT), (const bf16_t*)(ws + WS_WDN), DFF}; pg8::StaticOrder So; So.init(32, 8, c.nb, c.bid);
        EpiResid E{P.out, P.out, (bf16_t*)(ws + WS_H2G), nullptr, P.in[21], (float*)(ws + WS_SSQ2)};
        pg8::gemm_phase<EpiResid, false, true>(c.lds, g, So, E);
    }
    SEAM(7);
    if (IN(8)) {
        pg8::Gemm g{(const bf16_t*)(ws + WS_H2G), (const bf16_t*)(ws + WS_WPG), D}; pg8::StaticOrder So; So.init(32, 8, c.nb, c.bid);
        EpiPle E{P.out, (const bf16_t*)(ws + WS_E), (const float*)(ws + WS_SSQ2), (float*)(ws + WS_SSQ3)};
        pg8::gemm_phase<EpiPle, false, true>(c.lds, g, So, E);
    }
    SEAM(8);
    if (IN(9)) phase_final(c);
#undef IN
#undef SEAM
}

extern "C" void kernel_launch(void* const* d_in, const int* in_sizes, int n_in, void* d_out, int out_size, void* d_ws, size_t ws_size, hipStream_t stream) {
    static int grid = 0;
    if (grid == 0) {
        if (n_in != 25 || out_size != S * D || ws_size < WS_END) { fprintf(stderr, "kernel_launch: unexpected shapes (n_in %d out %d ws %zu)\n", n_in, out_size, ws_size); grid = -1; return; }
        int dev = 0, cus = 0, per_cu = 0;
        (void)hipGetDevice(&dev); (void)hipDeviceGetAttribute(&cus, hipDeviceAttributeMultiprocessorCount, dev);
        if (hipFuncSetAttribute((const void*)mega_fwd, hipFuncAttributeMaxDynamicSharedMemorySize, LDS_BYTES) != hipSuccess) { fprintf(stderr, "kernel_launch: hipFuncSetAttribute failed\n"); grid = -1; return; }
        (void)hipOccupancyMaxActiveBlocksPerMultiprocessor(&per_cu, (const void*)mega_fwd, 512, LDS_BYTES);
        if (per_cu < 1) { fprintf(stderr, "kernel_launch: occupancy query says %d blocks/CU\n", per_cu); per_cu = 1; }
        (void)hipGetLastError();
        grid = cus;
        fprintf(stderr, "kernel_launch: grid %d (cus %d, per_cu %d)\n", grid, cus, per_cu);
    }
    if (grid < 0) return;
    if (hipMemsetAsync(d_ws, 0, 16384, stream) != hipSuccess) { fprintf(stderr, "kernel_launch: memset failed\n"); return; }
    Params P{};
    for (int i = 0; i < 25; ++i) P.in[i] = (const float*)d_in[i];
    P.out = (float*)d_out; P.ws = (unsigned char*)d_ws;
#if MK_LAUNCHES == 1
    int lo = 0, hi = NPH;
    void* args[] = {&P, &lo, &hi};
    hipError_t e = hipLaunchCooperativeKernel((const void*)mega_fwd, dim3(grid), dim3(512), args, LDS_BYTES, stream);
    if (e != hipSuccess) fprintf(stderr, "kernel_launch: cooperative launch failed: %s\n", hipGetErrorString(e));
#else
    for (int k = 0; k < NPH; ++k) {
        int lo = k, hi = k + 1;
        void* args[] = {&P, &lo, &hi};
        hipError_t e = hipLaunchCooperativeKernel((const void*)mega_fwd, dim3(grid), dim3(512), args, LDS_BYTES, stream);
        if (e != hipSuccess) { fprintf(stderr, "kernel_launch: launch %d failed: %s\n", k, hipGetErrorString(e)); break; }
    }
#endif
}
```

```cpp
#include <hip/hip_runtime.h>
#include <hip/hip_cooperative_groups.h>
#include <cstdio>
#include <cstdint>
namespace cg = cooperative_groups;

#ifndef MK_LAUNCHES
#define MK_LAUNCHES 1
#endif

#define LAS __attribute__((address_space(3)))
typedef unsigned short bf16_t;
typedef short bf16x8 __attribute__((ext_vector_type(8)));
typedef float f32x4 __attribute__((ext_vector_type(4)));
typedef float f32x2 __attribute__((ext_vector_type(2)));
typedef float f32x16 __attribute__((ext_vector_type(16)));
typedef unsigned u32x4 __attribute__((ext_vector_type(4)));
typedef unsigned u32x2 __attribute__((ext_vector_type(2)));

constexpr int S = 8192, D = 2048, DIN = 10272, DA = 2048, DSSM = 2048, DXBC = 4096, NH = 32, NGRP = 8, NST = 128;
constexpr int DFF = 5632, DPLE = 256, DMIX = 4096, NCH = 64, CH = 128, NGA = 16;
constexpr float EPS = 1e-6f;
constexpr int NPH = 10;

constexpr size_t MiB = 1u << 20;
constexpr size_t WS_WUP = 1 * MiB;
constexpr size_t WS_WDN = 45 * MiB;
constexpr size_t WS_WPG = 67 * MiB;
constexpr size_t WS_WPLE = 75 * MiB;
constexpr size_t WS_WIN = 76 * MiB;
constexpr size_t WS_WOUT = 117 * MiB;
constexpr size_t WS_UV = 133 * MiB;
constexpr size_t WS_ACT = 133 * MiB;
constexpr size_t WS_ZS = 197 * MiB;
constexpr size_t WS_XBC = 229 * MiB;
constexpr size_t WS_HG = 229 * MiB;
constexpr size_t WS_H2G = 229 * MiB;
constexpr size_t WS_A = 293 * MiB;
constexpr size_t WS_ST = 293 * MiB;
constexpr size_t WS_E = 293 * MiB;
constexpr size_t WS_P16 = 325 * MiB;
constexpr size_t WS_DT = 329 * MiB;
constexpr size_t WS_SSQA = 330 * MiB;
constexpr size_t WS_SSQ1 = 331 * MiB;
constexpr size_t WS_SSQ2 = WS_SSQ1 + 256 * 1024;
constexpr size_t WS_SSQ3 = WS_SSQ2 + 256 * 1024;
constexpr size_t WS_CDEC = WS_SSQ3 + 256 * 1024;
constexpr size_t WS_GSCR = 332 * MiB;
constexpr size_t WS_END = 348 * MiB;

constexpr int LDS_BYTES = 163840;

struct Params {
    const float* in[25];
    float* out;
    unsigned char* ws;
};

__device__ __forceinline__ unsigned f2bf(float f) { unsigned u = __builtin_bit_cast(unsigned, f); return (u + 0x7fffu + ((u >> 16) & 1u)) >> 16; }
__device__ __forceinline__ unsigned pk2(float lo, float hi) { return f2bf(lo) | (f2bf(hi) << 16); }
__device__ __forceinline__ float bf2f(unsigned short b) { return __builtin_bit_cast(float, ((unsigned)b) << 16); }
__device__ __forceinline__ float bflo(unsigned w) { return __builtin_bit_cast(float, w << 16); }
__device__ __forceinline__ float bfhi(unsigned w) { return __builtin_bit_cast(float, w & 0xffff0000u); }
__device__ __forceinline__ float fast_sigmoid(float x) { return __builtin_amdgcn_rcpf(1.0f + __builtin_amdgcn_exp2f(-1.4426950408889634f * x)); }
__device__ __forceinline__ float silu_f(float x) { return x * fast_sigmoid(x); }
__device__ __forceinline__ float gelu_tanh_f(float x) { const float t = x + 0.044715f * x * x * x; return x * __builtin_amdgcn_rcpf(1.0f + __builtin_amdgcn_exp2f(-2.3022081986f * t)); }
__device__ __forceinline__ float wave_sum(float v) {
#pragma unroll
    for (int o = 1; o < 64; o <<= 1) v += __shfl_xor(v, o);
    return v;
}

namespace pg8 {
constexpr int BM = 256, BK = 64, HALF = 128, HTB = HALF * BK * 2, STAGE_BYTES = 8 * HTB, NXCD = 8, WGM = 8;
__host__ __device__ __forceinline__ int lds_byte(int r, int c) { const int st = (r >> 4) * 2 + (c >> 5), rr = r & 15, cc = c & 31, ob = rr * 64 + cc * 2; return st * 1024 + (ob ^ (((ob >> 9) & 1) << 5)); }
__host__ __device__ __forceinline__ void stage_rc(int b, int& R, int& C) { const int st = b / 1024, sb = b % 1024, swz = sb ^ (((sb >> 9) & 1) << 5); R = (st >> 1) * 16 + swz / 64; C = (st & 1) * 32 + (swz % 64) / 2; }
__host__ __device__ __forceinline__ int perm32(int rho) { const int n = rho >> 4, i = rho & 15; return 8 * (i >> 2) + 4 * n + (i & 3); }

struct Unit { int pm, pn; };
struct Gemm { const bf16_t* A; const bf16_t* Bt; int K; };

struct StaticOrder {
    int nM, nN, nwg, G, c;
    __device__ void init(int nM_, int nN_, int G_, int c_) { nM = nM_; nN = nN_; nwg = nM * nN; G = G_; c = c_; }
    __device__ bool next(int i, Unit& u) const {
        const long L = (long)i * G + c; if (L >= nwg) return false;
        int wgid = (int)L; { const int q = nwg / NXCD, r = nwg % NXCD, xcd = wgid % NXCD, off = wgid / NXCD; wgid = (xcd < r ? xcd * (q + 1) : r * (q + 1) + (xcd - r) * q) + off; }
        const int nig = WGM * nN, gid = wgid / nig, fm = gid * WGM, gsz = (nM - fm) < WGM ? (nM - fm) : WGM;
        u.pm = fm + ((wgid % nig) % gsz); u.pn = (wgid % nig) / gsz; return true;
    }
};

__device__ __forceinline__ unsigned cvt_pk_bf16(float lo, float hi) { unsigned r; asm volatile("v_cvt_pk_bf16_f32 %0, %1, %2" : "=v"(r) : "v"(lo), "v"(hi)); return r; }

template <class Epi, bool ALIGN_EPI, bool SP2>
__device__ __forceinline__ void gemm_phase(LAS unsigned char* lds, const Gemm g, const StaticOrder& S, const Epi& E) {
    const int tid = threadIdx.x, wid = __builtin_amdgcn_readfirstlane(tid >> 6), lane = tid & 63, wr = wid >> 2, wc = wid & 3, fr = lane & 15, fq = lane >> 4;
    const int K = g.K, nt = K / BK;
    unsigned voffA[2], voffB[2];
#pragma unroll
    for (int i = 0; i < 2; ++i) { int R, C; stage_rc(tid * 16 + i * 8192, R, C); const int Rb = (R & ~31) + perm32(R & 31);
        voffA[i] = (unsigned)(R * K + C) * 2u; voffB[i] = (unsigned)(Rb * K + C) * 2u; }
    const size_t kstep = (size_t)(BK * 2);
    const size_t hstep = (size_t)HALF * K * 2;
    const size_t tstep = 2 * hstep;
    const unsigned ldsw = (unsigned)wid * 1024u;
    const int aoff = lds_byte(wr * 64 + fr, fq * 8), boff = lds_byte(wc * 32 + fr, fq * 8);
#define PG8_SA(b, h) (((b) * 2 + (h)) * HTB)
#define PG8_SB(b, h) ((4 + (b) * 2 + (h)) * HTB)
#define PG8_STAGE(bufoff, gbase, voff) do { _Pragma("unroll") for (int _i = 0; _i < 2; ++_i) \
        __builtin_amdgcn_global_load_lds((const unsigned*)((const char*)(gbase) + (voff)[_i]), (LAS unsigned*)(lds + (bufoff) + ldsw + _i * 8192), 16, 0, 0); } while (0)
#define PG8_LDA(dst, b, h) do { _Pragma("unroll") for (int m = 0; m < 4; ++m) _Pragma("unroll") for (int k = 0; k < 2; ++k) dst[m][k] = *(const LAS bf16x8*)(lds + PG8_SA(b, h) + aoff + m * 2048 + k * 1024); } while (0)
#define PG8_LDB(dst, b, h) do { _Pragma("unroll") for (int n = 0; n < 2; ++n) _Pragma("unroll") for (int k = 0; k < 2; ++k) dst[n][k] = *(const LAS bf16x8*)(lds + PG8_SB(b, h) + boff + n * 2048 + k * 1024); } while (0)
#define PG8_MMA(ai, bj, At, Bt) do { __builtin_amdgcn_s_setprio(1); _Pragma("unroll") for (int m = 0; m < 4; ++m) _Pragma("unroll") for (int n = 0; n < 2; ++n) _Pragma("unroll") for (int k = 0; k < 2; ++k) \
        acc[ai][bj][m][n] = __builtin_amdgcn_mfma_f32_16x16x32_bf16(Bt[n][k], At[m][k], acc[ai][bj][m][n], 0, 0, 0); __builtin_amdgcn_s_setprio(0); } while (0)
#define PG8_WAIT_V(n) asm volatile("s_waitcnt vmcnt(" #n ")" ::: "memory")
#define PG8_WAIT_L(n) asm volatile("s_waitcnt lgkmcnt(" #n ")" ::: "memory")
#define PG8_BAR __builtin_amdgcn_s_barrier()
#define PG8_SCHED __builtin_amdgcn_sched_barrier(0)
    Unit cur, nxt; int ui = 0;
    if (!S.next(0, cur)) return;
    f32x4 acc[2][2][4][2];
#pragma unroll
    for (int a = 0; a < 2; ++a)
#pragma unroll
        for (int b = 0; b < 2; ++b)
#pragma unroll
            for (int m = 0; m < 4; ++m)
#pragma unroll
                for (int n = 0; n < 2; ++n) acc[a][b][m][n] = (f32x4){0.f, 0.f, 0.f, 0.f};
    bf16x8 At[4][2], B0[2][2], B1[2][2];
    const char* cA = (const char*)g.A + (size_t)cur.pm * tstep; const char* cB = (const char*)g.Bt + (size_t)cur.pn * tstep;
    if constexpr (SP2) {
        PG8_STAGE(PG8_SB(0, 0), cB, voffB); PG8_STAGE(PG8_SB(0, 1), cB + hstep, voffB); PG8_STAGE(PG8_SA(0, 0), cA, voffA); PG8_STAGE(PG8_SA(0, 1), cA + hstep, voffA);
        if (wr == 1) PG8_BAR;
        PG8_WAIT_V(2); PG8_BAR;
        PG8_STAGE(PG8_SB(1, 0), cB + kstep, voffB); PG8_STAGE(PG8_SA(1, 0), cA + kstep, voffA); PG8_STAGE(PG8_SB(1, 1), cB + hstep + kstep, voffB);
        PG8_WAIT_V(6); PG8_BAR;
    } else {
        PG8_STAGE(PG8_SB(0, 0), cB, voffB); PG8_STAGE(PG8_SA(0, 0), cA, voffA); PG8_STAGE(PG8_SB(0, 1), cB + hstep, voffB); PG8_STAGE(PG8_SA(0, 1), cA + hstep, voffA);
        if (wr == 1) PG8_BAR;
        PG8_WAIT_V(4); PG8_BAR;
        PG8_STAGE(PG8_SB(1, 0), cB + kstep, voffB); PG8_STAGE(PG8_SA(1, 0), cA + kstep, voffA); PG8_STAGE(PG8_SB(1, 1), cB + hstep + kstep, voffB);
        PG8_WAIT_V(6); PG8_BAR;
    }
    for (;;) {
        const bool has_next = S.next(ui + 1, nxt);
        const char* nA = has_next ? (const char*)g.A + (size_t)nxt.pm * tstep : cA; const char* nB = has_next ? (const char*)g.Bt + (size_t)nxt.pn * tstep : cB;
#pragma nounroll
        for (int t = 0; t < nt; t += 2) {
            const bool last = (t == nt - 2);
            const char* a1 = cA + (size_t)(t + 1) * kstep;
            const char* a2 = last ? nA : cA + (size_t)(t + 2) * kstep; const char* b2 = last ? nB : cB + (size_t)(t + 2) * kstep;
            const char* a3 = a2 + kstep; const char* b3 = b2 + kstep;
            if constexpr (SP2) {
            PG8_LDB(B0, 0, 0); PG8_LDB(B1, 0, 1); PG8_SCHED; PG8_LDA(At, 0, 0); PG8_STAGE(PG8_SA(1, 1), a1 + hstep, voffA);
            PG8_WAIT_V(8); PG8_WAIT_L(0); PG8_BAR; PG8_MMA(0, 0, At, B0); PG8_MMA(0, 1, At, B1); PG8_BAR; PG8_SCHED;
            PG8_LDA(At, 0, 1); PG8_STAGE(PG8_SB(0, 0), b2, voffB); PG8_STAGE(PG8_SB(0, 1), b2 + hstep, voffB); PG8_STAGE(PG8_SA(0, 0), a2, voffA);
            PG8_WAIT_V(8); PG8_WAIT_L(0); PG8_BAR; PG8_MMA(1, 0, At, B0); PG8_MMA(1, 1, At, B1); PG8_BAR; PG8_SCHED;
            PG8_LDB(B0, 1, 0); PG8_LDB(B1, 1, 1); PG8_SCHED; PG8_LDA(At, 1, 0); PG8_STAGE(PG8_SA(0, 1), a2 + hstep, voffA);
            PG8_WAIT_V(8); PG8_WAIT_L(0); PG8_BAR; PG8_MMA(0, 0, At, B0); PG8_MMA(0, 1, At, B1); PG8_BAR; PG8_SCHED;
            PG8_LDA(At, 1, 1); PG8_STAGE(PG8_SB(1, 0), b3, voffB); PG8_STAGE(PG8_SB(1, 1), b3 + hstep, voffB); PG8_STAGE(PG8_SA(1, 0), a3, voffA);
            PG8_WAIT_V(8); PG8_WAIT_L(0); PG8_BAR; PG8_MMA(1, 0, At, B0); PG8_MMA(1, 1, At, B1); PG8_BAR; PG8_SCHED;
            } else {
            PG8_LDB(B0, 0, 0); PG8_SCHED; PG8_LDA(At, 0, 0); PG8_STAGE(PG8_SA(1, 1), a1 + hstep, voffA);
            PG8_WAIT_L(8); PG8_BAR; PG8_WAIT_L(0); PG8_MMA(0, 0, At, B0); PG8_BAR; PG8_SCHED;
            PG8_LDB(B1, 0, 1); PG8_STAGE(PG8_SB(0, 0), b2, voffB);
            PG8_BAR; PG8_WAIT_L(0); PG8_MMA(0, 1, At, B1); PG8_BAR;
            PG8_LDA(At, 0, 1); PG8_STAGE(PG8_SA(0, 0), a2, voffA);
            PG8_BAR; PG8_WAIT_L(0); PG8_MMA(1, 0, At, B0); PG8_BAR; PG8_SCHED;
            PG8_STAGE(PG8_SB(0, 1), b2 + hstep, voffB);
            PG8_WAIT_V(6); PG8_BAR; PG8_MMA(1, 1, At, B1); PG8_BAR;
            PG8_LDB(B0, 1, 0); PG8_SCHED; PG8_LDA(At, 1, 0); PG8_STAGE(PG8_SA(0, 1), a2 + hstep, voffA);
            PG8_WAIT_L(8); PG8_BAR; PG8_WAIT_L(0); PG8_MMA(0, 0, At, B0); PG8_BAR; PG8_SCHED;
            PG8_LDB(B1, 1, 1); PG8_STAGE(PG8_SB(1, 0), b3, voffB);
            PG8_BAR; PG8_WAIT_L(0); PG8_MMA(0, 1, At, B1); PG8_BAR;
            PG8_LDA(At, 1, 1); PG8_STAGE(PG8_SA(1, 0), a3, voffA);
            PG8_BAR; PG8_WAIT_L(0); PG8_MMA(1, 0, At, B0); PG8_BAR; PG8_SCHED;
            PG8_STAGE(PG8_SB(1, 1), b3 + hstep, voffB);
            PG8_WAIT_V(6); PG8_BAR; PG8_MMA(1, 1, At, B1); PG8_BAR;
            }
        }
        if constexpr (ALIGN_EPI) { if (wr == 0) PG8_BAR; }
        if constexpr (!Epi::AFTER_DRAIN) { E(acc, cur, wr, wc, fr, fq); }
        if (!has_next) break;
#pragma unroll
        for (int a = 0; a < 2; ++a)
#pragma unroll
            for (int b = 0; b < 2; ++b)
#pragma unroll
                for (int m = 0; m < 4; ++m)
#pragma unroll
                    for (int n = 0; n < 2; ++n) acc[a][b][m][n] = (f32x4){0.f, 0.f, 0.f, 0.f};
        cur = nxt; cA = nA; cB = nB; ++ui;
        if constexpr (ALIGN_EPI) { if (wr == 1) PG8_BAR; }
    }
    PG8_WAIT_V(0);
    if constexpr (!ALIGN_EPI) { if (wr == 0) PG8_BAR; }
    PG8_BAR;
    if constexpr (Epi::AFTER_DRAIN) { E.fused(acc, cur, wr, wc, fr, fq, lds, wid, lane); }
#undef PG8_SA
#undef PG8_SB
#undef PG8_STAGE
#undef PG8_LDA
#undef PG8_LDB
#undef PG8_MMA
#undef PG8_WAIT_V
#undef PG8_WAIT_L
#undef PG8_BAR
#undef PG8_SCHED
}
}
using pg8::Unit; using pg8::cvt_pk_bf16;
typedef f32x4 AccT[2][2][4][2];

__device__ __forceinline__ u32x4 pack8(const f32x4 v0, const f32x4 v1) { u32x4 w; w.x = cvt_pk_bf16(v0[0], v0[1]); w.y = cvt_pk_bf16(v0[2], v0[3]); w.z = cvt_pk_bf16(v1[0], v1[1]); w.w = cvt_pk_bf16(v1[2], v1[3]); return w; }

struct EpiProj {
    static constexpr bool AFTER_DRAIN = false;
    bf16_t *uv, *zs, *xbc;
    __device__ __forceinline__ void operator()(const AccT& acc, const Unit& u, int wr, int wc, int fr, int fq) const {
        const int row0 = u.pm * 256 + wr * 64 + fr; const int ct = wc * 32 + 8 * fq;
        bf16_t* base; int ld, mode;
        if (u.pn < 16) { base = uv + u.pn * 256; ld = DMIX; mode = 0; }
        else if (u.pn < 24) { base = zs + (u.pn - 16) * 256; ld = DSSM; mode = 1; }
        else { base = xbc + (u.pn - 24) * 256; ld = DXBC; mode = 2; }
#pragma unroll
        for (int ai = 0; ai < 2; ++ai)
#pragma unroll
            for (int m = 0; m < 4; ++m) { bf16_t* rowp = base + (size_t)(row0 + ai * 128 + m * 16) * ld + ct;
#pragma unroll
                for (int bj = 0; bj < 2; ++bj) { f32x4 v0 = acc[ai][bj][m][0], v1 = acc[ai][bj][m][1];
                    if (mode == 0) {
#pragma unroll
                        for (int j = 0; j < 4; ++j) { v0[j] = gelu_tanh_f(v0[j]); v1[j] = gelu_tanh_f(v1[j]); } }
                    else if (mode == 1) {
#pragma unroll
                        for (int j = 0; j < 4; ++j) { v0[j] = silu_f(v0[j]); v1[j] = silu_f(v1[j]); } }
                    *(u32x4*)(rowp + bj * 128) = pack8(v0, v1); } }
    }
};
struct EpiPlain {
    static constexpr bool AFTER_DRAIN = false;
    bf16_t* O; int ld;
    __device__ __forceinline__ void operator()(const AccT& acc, const Unit& u, int wr, int wc, int fr, int fq) const {
        const int row0 = u.pm * 256 + wr * 64 + fr; const int col0 = u.pn * 256 + wc * 32 + 8 * fq;
#pragma unroll
        for (int ai = 0; ai < 2; ++ai)
#pragma unroll
            for (int m = 0; m < 4; ++m) { bf16_t* rowp = O + (size_t)(row0 + ai * 128 + m * 16) * ld + col0;
#pragma unroll
                for (int bj = 0; bj < 2; ++bj) *(u32x4*)(rowp + bj * 128) = pack8(acc[ai][bj][m][0], acc[ai][bj][m][1]); }
    }
};
struct EpiResid {
    static constexpr bool AFTER_DRAIN = true;
    const float* base; float* out; bf16_t* hn; bf16_t* halo; const float* gain; float* ssq;
    __device__ __forceinline__ void fused(AccT& acc, const Unit& u, int wr, int wc, int fr, int fq, LAS unsigned char* lds, int wid, int lane) const {
        asm volatile("" : "+v"(fr), "+v"(fq));
        LAS float* P = (LAS float*)lds;
        const int col0 = u.pn * 256 + wc * 32 + 8 * fq;
#pragma unroll
        for (int ai = 0; ai < 2; ++ai)
#pragma unroll
            for (int m = 0; m < 4; ++m) { const int rl = ai * 128 + wr * 64 + m * 16 + fr; const int row = u.pm * 256 + rl; const size_t off = (size_t)row * D + col0;
                float ss = 0.f;
                bf16_t* hrow = nullptr;
                if (halo) { const int r6 = row & 63; if (r6 >= 62) { if ((row >> 6) <= 126) hrow = halo + (size_t)(4 * (row >> 6) + (row & 1)) * D; } else if (r6 < 2 && row >= 64) hrow = halo + (size_t)(4 * ((row >> 6) - 1) + 2 + (row & 1)) * D; }
#pragma unroll
                for (int bj = 0; bj < 2; ++bj) { const f32x4 b0 = *(const f32x4*)(base + off + bj * 128), b1 = *(const f32x4*)(base + off + bj * 128 + 4);
                    const f32x4 v0 = acc[ai][bj][m][0] + b0, v1 = acc[ai][bj][m][1] + b1;
                    *(f32x4*)(out + off + bj * 128) = v0; *(f32x4*)(out + off + bj * 128 + 4) = v1;
                    ss += (v0[0] * v0[0] + v0[1] * v0[1]) + (v0[2] * v0[2] + v0[3] * v0[3]) + (v1[0] * v1[0] + v1[1] * v1[1]) + (v1[2] * v1[2] + v1[3] * v1[3]);
                    const f32x4 g0 = *(const f32x4*)(gain + col0 + bj * 128), g1 = *(const f32x4*)(gain + col0 + bj * 128 + 4);
                    const u32x4 w = pack8(v0 * g0, v1 * g1);
                    *(u32x4*)(hn + off + bj * 128) = w;
                    if (hrow) *(u32x4*)(hrow + col0 + bj * 128) = w; }
                ss += __shfl_xor(ss, 16); ss += __shfl_xor(ss, 32);
                if (fq == 0) P[rl * 4 + wc] = ss;
                asm volatile("" ::: "memory"); }
        __syncthreads();
        if (threadIdx.x < 256) { const int t = threadIdx.x; ssq[(size_t)(u.pm * 256 + t) * 8 + u.pn] = (P[t * 4 + 0] + P[t * 4 + 1]) + (P[t * 4 + 2] + P[t * 4 + 3]); }
        __syncthreads();
    }
};
struct EpiPle {
    static constexpr bool AFTER_DRAIN = true;
    float* out; const bf16_t* Eb; const float* ssq_in; float* ssq;
    __device__ __forceinline__ void fused(AccT& acc, const Unit& u, int wr, int wc, int fr, int fq, LAS unsigned char* lds, int wid, int lane) const {
        asm volatile("" : "+v"(fr), "+v"(fq));
        LAS float* P = (LAS float*)lds;
        const int col0 = u.pn * 256 + wc * 32 + 8 * fq;
#pragma unroll
        for (int ai = 0; ai < 2; ++ai)
#pragma unroll
            for (int m = 0; m < 4; ++m) { const int rl = ai * 128 + wr * 64 + m * 16 + fr; const int row = u.pm * 256 + rl; const size_t off = (size_t)row * D + col0;
                const f32x4 q0 = *(const f32x4*)(ssq_in + (size_t)row * 8), q1 = *(const f32x4*)(ssq_in + (size_t)row * 8 + 4);
                const float rinv = 1.0f / sqrtf(((q0[0] + q0[1]) + (q0[2] + q0[3]) + (q1[0] + q1[1]) + (q1[2] + q1[3])) * (1.0f / D) + EPS);
                float ss = 0.f;
#pragma unroll
                for (int bj = 0; bj < 2; ++bj) { const f32x4 b0 = *(const f32x4*)(out + off + bj * 128), b1 = *(const f32x4*)(out + off + bj * 128 + 4);
                    const u32x4 ew = *(const u32x4*)(Eb + off + bj * 128);
                    f32x4 e0 = {bflo(ew.x), bfhi(ew.x), bflo(ew.y), bfhi(ew.y)}, e1 = {bflo(ew.z), bfhi(ew.z), bflo(ew.w), bfhi(ew.w)};
                    f32x4 v0, v1;
#pragma unroll
                    for (int j = 0; j < 4; ++j) { v0[j] = b0[j] + fast_sigmoid(acc[ai][bj][m][0][j] * rinv) * e0[j]; v1[j] = b1[j] + fast_sigmoid(acc[ai][bj][m][1][j] * rinv) * e1[j]; }
                    *(f32x4*)(out + off + bj * 128) = v0; *(f32x4*)(out + off + bj * 128 + 4) = v1;
                    ss += (v0[0] * v0[0] + v0[1] * v0[1]) + (v0[2] * v0[2] + v0[3] * v0[3]) + (v1[0] * v1[0] + v1[1] * v1[1]) + (v1[2] * v1[2] + v1[3] * v1[3]); }
                ss += __shfl_xor(ss, 16); ss += __shfl_xor(ss, 32);
                if (fq == 0) P[rl * 4 + wc] = ss;
                asm volatile("" ::: "memory"); }
        __syncthreads();
        if (threadIdx.x < 256) { const int t = threadIdx.x; ssq[(size_t)(u.pm * 256 + t) * 8 + u.pn] = (P[t * 4 + 0] + P[t * 4 + 1]) + (P[t * 4 + 2] + P[t * 4 + 3]); }
        __syncthreads();
    }
};
struct EpiFfn {
    static constexpr bool AFTER_DRAIN = false;
    bf16_t* act; const float* ssq1; const float* cw; const float* cb;
    __device__ __forceinline__ int grow_of(const Unit& u, int rl) const {
        if (u.pm < 32) return u.pm * 256 + rl;
        const int R = (u.pm - 32) * 256 + rl; int q = (R >> 2) + 1; if (q > 127) q = 127; return 64 * q - 2 + (R & 3);
    }
    __device__ __forceinline__ void operator()(AccT& acc, const Unit& u, int wr, int wc, int fr, int fq) const {
        asm volatile("" : "+v"(fr), "+v"(fq));
        const bool halo = u.pm >= 32;
        const int lane = fq * 16 + fr;
        const int s1 = (lane & 48) | ((fr + 15) & 15), s2 = (lane & 48) | ((fr + 14) & 15);
#pragma unroll
        for (int ai = 0; ai < 2; ++ai)
#pragma unroll
            for (int m = 0; m < 4; ++m) {
                const int gr = grow_of(u, ai * 128 + wr * 64 + m * 16 + fr);
                const f32x4 q0 = *(const f32x4*)(ssq1 + (size_t)gr * 8), q1 = *(const f32x4*)(ssq1 + (size_t)gr * 8 + 4);
                const float rinv = 1.0f / sqrtf(((q0[0] + q0[1]) + (q0[2] + q0[3]) + (q1[0] + q1[1]) + (q1[2] + q1[3])) * (1.0f / D) + EPS);
#pragma unroll
                for (int bj = 0; bj < 2; ++bj)
#pragma unroll
                    for (int n = 0; n < 2; ++n) acc[ai][bj][m][n] = acc[ai][bj][m][n] * rinv;
                asm volatile("" ::: "memory");
            }
#pragma unroll
        for (int n = 0; n < 2; ++n) {
            const int gc = u.pn * 128 + wc * 32 + 8 * fq + 4 * n;
#pragma unroll
            for (int bj = 0; bj < 2; ++bj) {
                const int cc = bj * DFF + gc;
                asm volatile("" ::: "memory");
                const f32x4 w0 = *(const f32x4*)(cw + cc), w1 = *(const f32x4*)(cw + 2 * DFF + cc), w2 = *(const f32x4*)(cw + 4 * DFF + cc), bb = *(const f32x4*)(cb + cc);
#pragma unroll
                for (int ai = 0; ai < 2; ++ai) {
                    f32x4 p1 = {0.f, 0.f, 0.f, 0.f}, p2 = p1;
#pragma unroll
                    for (int m = 0; m < 4; ++m) {
                        f32x4 v = acc[ai][bj][m][n];
                        asm volatile("" : "+v"(v));
                        f32x4 r1, r2, hh;
#pragma unroll
                        for (int j = 0; j < 4; ++j) { r1[j] = __shfl(v[j], s1); r2[j] = __shfl(v[j], s2); }
#pragma unroll
                        for (int j = 0; j < 4; ++j) { const float x1 = fr >= 1 ? r1[j] : p1[j], x2 = fr >= 2 ? r2[j] : p2[j]; hh[j] = bb[j] + w2[j] * v[j] + w1[j] * x1 + w0[j] * x2; }
                        asm volatile("" : "+v"(hh));
                        acc[ai][bj][m][n] = hh; p1 = r1; p2 = r2;
                    }
                }
            }
            asm volatile("" ::: "memory");
#pragma unroll
            for (int ai = 0; ai < 2; ++ai)
#pragma unroll
                for (int m = 0; m < 4; ++m) {
                    const int rl = ai * 128 + wr * 64 + m * 16 + fr;
                    bool st;
                    if (!halo) st = !(m == 0 && fr < 2) || (u.pm == 0 && ai == 0 && wr == 0);
                    else st = ((fr & 3) >= 2) && ((((u.pm - 32) * 256 + rl) >> 2) + 1 <= 127);
                    if (st) { const f32x4 hg_ = acc[ai][0][m][n], hu_ = acc[ai][1][m][n];
                        u32x2 w; w.x = cvt_pk_bf16(silu_f(hg_[0]) * hu_[0], silu_f(hg_[1]) * hu_[1]); w.y = cvt_pk_bf16(silu_f(hg_[2]) * hu_[2], silu_f(hg_[3]) * hu_[3]);
                        *(u32x2*)(act + (size_t)grow_of(u, rl) * DFF + gc) = w; }
                }
        }
    }
};

struct Ctx {
    LAS unsigned char* lds;
    int tid, lane, wave, nb, bid;
    const float* const* in;
    float* out;
    unsigned char* ws;
};

template <int MODE>
__device__ __forceinline__ void prep_w_item(const float* __restrict__ W, int K, int N, bf16_t* __restrict__ Wt, int item, int lane) {
    const int nkb = K / 64, nb = item / nkb, kb = item % nkb;
    const int n4 = nb * 256 + lane * 4; if (n4 >= N) return;
    int orow = n4;
    if (MODE == 1) orow = (n4 < DFF) ? 256 * (n4 >> 7) + (n4 & 127) : 256 * ((n4 - DFF) >> 7) + 128 + ((n4 - DFF) & 127);
    const float* src = W + (size_t)(kb * 64) * N + n4;
    bf16_t* dst = Wt + (size_t)orow * K + kb * 64;
#pragma unroll 1
    for (int half = 0; half < 2; ++half) {
        f32x4 v[32];
#pragma unroll
        for (int j = 0; j < 32; ++j) v[j] = __builtin_nontemporal_load((const f32x4*)(src + (size_t)(half * 32 + j) * N));
#pragma unroll
        for (int q = 0; q < 4; ++q)
#pragma unroll
            for (int e = 0; e < 4; ++e) { u32x4 o; o.x = pk2(v[8 * e][q], v[8 * e + 1][q]); o.y = pk2(v[8 * e + 2][q], v[8 * e + 3][q]); o.z = pk2(v[8 * e + 4][q], v[8 * e + 5][q]); o.w = pk2(v[8 * e + 6][q], v[8 * e + 7][q]);
                *(u32x4*)(dst + (size_t)q * K + half * 32 + e * 8) = o; }
    }
}
__device__ __forceinline__ void phase_prep(const Ctx& c) {
    const int gw = c.bid * 8 + c.wave, NGW = c.nb * 8;
    const float* w_in = c.in[3]; const float* w_out = c.in[15]; const float* w_up = c.in[17]; const float* w_dn = c.in[20]; const float* w_pg = c.in[22]; const float* w_ple = c.in[23];
    constexpr int I_IN = 41 * (D / 64), I_OUT = 8 * (DMIX / 64), I_UP = 44 * (D / 64), I_DN = 8 * (DFF / 64), I_PG = 8 * (D / 64), I_PLE = 8 * (DPLE / 64);
    constexpr int NIT = I_IN + I_OUT + I_UP + I_DN + I_PG + I_PLE;
    for (int it = gw; it < NIT; it += NGW) {
        int r = it;
        if (r < I_IN) { prep_w_item<0>(w_in, D, DIN, (bf16_t*)(c.ws + WS_WIN), r, c.lane); continue; } r -= I_IN;
        if (r < I_UP) { prep_w_item<1>(w_up, D, 2 * DFF, (bf16_t*)(c.ws + WS_WUP), r, c.lane); continue; } r -= I_UP;
        if (r < I_OUT) { prep_w_item<0>(w_out, DMIX, D, (bf16_t*)(c.ws + WS_WOUT), r, c.lane); continue; } r -= I_OUT;
        if (r < I_DN) { prep_w_item<0>(w_dn, DFF, D, (bf16_t*)(c.ws + WS_WDN), r, c.lane); continue; } r -= I_DN;
        if (r < I_PG) { prep_w_item<0>(w_pg, D, D, (bf16_t*)(c.ws + WS_WPG), r, c.lane); continue; } r -= I_PG;
        prep_w_item<0>(w_ple, DPLE, D, (bf16_t*)(c.ws + WS_WPLE), r, c.lane);
    }
    const float* x = c.in[0]; const float* g = c.in[2]; bf16_t* A = (bf16_t*)(c.ws + WS_A);
    for (int m = gw * 2; m < S; m += NGW * 2) {
        const float* xr = x + (size_t)m * D + 8 * c.lane; f32x4 v[2][4][2]; float s0 = 0.f, s1 = 0.f;
#pragma unroll
        for (int rr = 0; rr < 2; ++rr)
#pragma unroll
            for (int j = 0; j < 4; ++j) { v[rr][j][0] = __builtin_nontemporal_load((const f32x4*)(xr + (size_t)rr * D + 512 * j)); v[rr][j][1] = __builtin_nontemporal_load((const f32x4*)(xr + (size_t)rr * D + 512 * j + 4)); }
#pragma unroll
        for (int j = 0; j < 4; ++j)
#pragma unroll
            for (int e = 0; e < 4; ++e) { s0 += v[0][j][0][e] * v[0][j][0][e] + v[0][j][1][e] * v[0][j][1][e]; s1 += v[1][j][0][e] * v[1][j][0][e] + v[1][j][1][e] * v[1][j][1][e]; }
#pragma unroll
        for (int o = 1; o < 64; o <<= 1) { s0 += __shfl_xor(s0, o); s1 += __shfl_xor(s1, o); }
        const float ri[2] = {1.0f / sqrtf(s0 * (1.0f / D) + EPS), 1.0f / sqrtf(s1 * (1.0f / D) + EPS)};
#pragma unroll
        for (int j = 0; j < 4; ++j) { const f32x4 g0 = *(const f32x4*)(g + 8 * c.lane + 512 * j), g1 = *(const f32x4*)(g + 8 * c.lane + 512 * j + 4);
#pragma unroll
            for (int rr = 0; rr < 2; ++rr) { const f32x4 a0 = v[rr][j][0] * ri[rr] * g0, a1 = v[rr][j][1] * ri[rr] * g1;
                u32x4 o; o.x = pk2(a0[0], a0[1]); o.y = pk2(a0[2], a0[3]); o.z = pk2(a1[0], a1[1]); o.w = pk2(a1[2], a1[3]);
                *(u32x4*)(A + (size_t)(m + rr) * D + 8 * c.lane + 512 * j) = o; } }
    }
    const float* p = c.in[1]; bf16_t* P16 = (bf16_t*)(c.ws + WS_P16);
    for (size_t i = ((size_t)c.bid * 512 + c.tid) * 8; i < (size_t)S * DPLE; i += (size_t)c.nb * 512 * 8) {
        const f32x4 a0 = *(const f32x4*)(p + i), a1 = *(const f32x4*)(p + i + 4);
        u32x4 o; o.x = pk2(a0[0], a0[1]); o.y = pk2(a0[2], a0[3]); o.z = pk2(a1[0], a1[1]); o.w = pk2(a1[2], a1[3]);
        *(u32x4*)(P16 + i) = o;
    }
}

__device__ __forceinline__ void phase_dt(const Ctx& c) {
    const bf16_t* A = (const bf16_t*)(c.ws + WS_A); const bf16_t* Wdt = (const bf16_t*)(c.ws + WS_WIN) + (size_t)10240 * D;
    float* dt = (float*)(c.ws + WS_DT); const float* dtb = c.in[11];
    LAS float* red = (LAS float*)c.lds;
    const int r = c.lane & 31, h = c.lane >> 5;
    for (int item = c.bid; item < S / 32; item += c.nb) {
        const int row0 = item * 32;
        f32x16 acc; for (int i = 0; i < 16; ++i) acc[i] = 0.f;
        const bf16_t* ap = A + (size_t)(row0 + r) * D + c.wave * 256 + 8 * h;
        const bf16_t* bp = Wdt + (size_t)r * D + c.wave * 256 + 8 * h;
#pragma unroll 4
        for (int s = 0; s < 16; ++s) { const bf16x8 af = *(const bf16x8*)(ap + 16 * s), bfr = *(const bf16x8*)(bp + 16 * s);
            acc = __builtin_amdgcn_mfma_f32_32x32x16_bf16(af, bfr, acc, 0, 0, 0); }
#pragma unroll
        for (int i = 0; i < 16; ++i) red[(c.wave * 32 + ((i & 3) + 8 * (i >> 2) + 4 * h)) * 32 + r] = acc[i];
        __syncthreads();
        for (int o = c.tid; o < 1024; o += 512) { float s = 0.f;
#pragma unroll
            for (int w = 0; w < 8; ++w) s += red[w * 1024 + o];
            const int hd = o & 31; const float xv = s + dtb[hd];
            const float sp = xv > 20.f ? xv : log1pf(__expf(xv));
            dt[(size_t)(row0 + (o >> 5)) * 32 + hd] = sp; }
        __syncthreads();
    }
}

template <int W>
__device__ __forceinline__ void stage_conv_tile(const Ctx& c, LAS unsigned char* dst, int pitchB, int col0, int t0, const LAS float* scale) {
    const bf16_t* xbc = (const bf16_t*)(c.ws + WS_XBC); const float* cw = c.in[9]; const float* cb = c.in[10];
    constexpr int NCHK = W / 8, NGRPS = 512 / NCHK, RPT = 128 / NGRPS;
    const int ch = c.tid % NCHK, grp = c.tid / NCHK; const int cc = col0 + ch * 8;
    float w[4][8], b[8];
#pragma unroll
    for (int k = 0; k < 4; ++k) { const f32x4 a0 = *(const f32x4*)(cw + (size_t)k * DXBC + cc), a1 = *(const f32x4*)(cw + (size_t)k * DXBC + cc + 4);
#pragma unroll
        for (int e = 0; e < 4; ++e) { w[k][e] = a0[e]; w[k][4 + e] = a1[e]; } }
    { const f32x4 a0 = *(const f32x4*)(cb + cc), a1 = *(const f32x4*)(cb + cc + 4);
#pragma unroll
      for (int e = 0; e < 4; ++e) { b[e] = a0[e]; b[4 + e] = a1[e]; } }
    const int r0 = grp * RPT;
    float x0[8], x1[8], x2[8];
#pragma unroll
    for (int e = 0; e < 8; ++e) { x0[e] = 0.f; x1[e] = 0.f; x2[e] = 0.f; }
    {
        const int t = t0 + r0;
        if (t - 3 >= 0) { const u32x4 q = *(const u32x4*)(xbc + (size_t)(t - 3) * DXBC + cc); x0[0] = bflo(q.x); x0[1] = bfhi(q.x); x0[2] = bflo(q.y); x0[3] = bfhi(q.y); x0[4] = bflo(q.z); x0[5] = bfhi(q.z); x0[6] = bflo(q.w); x0[7] = bfhi(q.w); }
        if (t - 2 >= 0) { const u32x4 q = *(const u32x4*)(xbc + (size_t)(t - 2) * DXBC + cc); x1[0] = bflo(q.x); x1[1] = bfhi(q.x); x1[2] = bflo(q.y); x1[3] = bfhi(q.y); x1[4] = bflo(q.z); x1[5] = bfhi(q.z); x1[6] = bflo(q.w); x1[7] = bfhi(q.w); }
        if (t - 1 >= 0) { const u32x4 q = *(const u32x4*)(xbc + (size_t)(t - 1) * DXBC + cc); x2[0] = bflo(q.x); x2[1] = bfhi(q.x); x2[2] = bflo(q.y); x2[3] = bfhi(q.y); x2[4] = bflo(q.z); x2[5] = bfhi(q.z); x2[6] = bflo(q.w); x2[7] = bfhi(q.w); }
    }
#pragma unroll
    for (int i = 0; i < RPT; ++i) {
        const int rl = r0 + i, t = t0 + rl;
        const u32x4 q = *(const u32x4*)(xbc + (size_t)t * DXBC + cc);
        float x3[8]; x3[0] = bflo(q.x); x3[1] = bfhi(q.x); x3[2] = bflo(q.y); x3[3] = bfhi(q.y); x3[4] = bflo(q.z); x3[5] = bfhi(q.z); x3[6] = bflo(q.w); x3[7] = bfhi(q.w);
        float sc = 1.f; if (scale) sc = scale[rl * 4 + (ch * 8) / 64];
        float o[8];
#pragma unroll
        for (int e = 0; e < 8; ++e) { const float hsum = b[e] + w[0][e] * x0[e] + w[1][e] * x1[e] + w[2][e] * x2[e] + w[3][e] * x3[e]; o[e] = silu_f(hsum) * sc; x0[e] = x1[e]; x1[e] = x2[e]; x2[e] = x3[e]; }
        u32x4 ov; ov.x = pk2(o[0], o[1]); ov.y = pk2(o[2], o[3]); ov.z = pk2(o[4], o[5]); ov.w = pk2(o[6], o[7]);
        *(LAS u32x4*)(dst + rl * pitchB + ch * 16) = ov;
    }
}

__device__ __forceinline__ void ssd_tables(const Ctx& c, int ck, int g, LAS float* sdt, LAS float* sacs) {
    const float* dt = (const float*)(c.ws + WS_DT); const float* alog = c.in[12];
    { const int l = c.tid >> 2, h = c.tid & 3; const float dv = dt[(size_t)(ck * 128 + l) * 32 + g * 4 + h]; sdt[l * 4 + h] = dv; sacs[l * 4 + h] = dv * (-__expf(alog[g * 4 + h])); }
    __syncthreads();
    if (c.wave < 4) { const int h = c.wave; const float v0 = sacs[(2 * c.lane) * 4 + h], v1 = sacs[(2 * c.lane + 1) * 4 + h]; float s = v0 + v1;
#pragma unroll
        for (int d = 1; d < 64; d <<= 1) { const float t = __shfl_up(s, d); if (c.lane >= d) s += t; }
        const float ex = s - (v0 + v1);
        sacs[(2 * c.lane) * 4 + h] = ex + v0; sacs[(2 * c.lane + 1) * 4 + h] = s; }
    __syncthreads();
}

constexpr int XS_PITCH = 576, BC_PITCH = 320;
constexpr int L_XS = 0, L_B = 128 * XS_PITCH, L_C = L_B + 128 * BC_PITCH, L_TAB = L_C + 128 * BC_PITCH;
constexpr int L_SDT = L_TAB, L_SACS = L_TAB + 2048, L_SW = L_TAB + 4096, L_MISC = L_TAB + 6144;
static_assert(L_MISC + 2048 <= LDS_BYTES, "mixer LDS map");

__device__ __forceinline__ void ssd_a_item(const Ctx& c, int ck, int g) {
    LAS float* sdt = (LAS float*)(c.lds + L_SDT); LAS float* sacs = (LAS float*)(c.lds + L_SACS); LAS float* sw = (LAS float*)(c.lds + L_SW);
    ssd_tables(c, ck, g, sdt, sacs);
    { const int l = c.tid >> 2, h = c.tid & 3; sw[l * 4 + h] = sdt[l * 4 + h] * __expf(sacs[127 * 4 + h] - sacs[l * 4 + h]); }
    if (c.tid < 4) ((float*)(c.ws + WS_CDEC))[ck * 32 + g * 4 + c.tid] = __expf(sacs[127 * 4 + c.tid]);
    __syncthreads();
    stage_conv_tile<256>(c, c.lds + L_XS, XS_PITCH, g * 256, ck * 128, sw);
    stage_conv_tile<128>(c, c.lds + L_B, BC_PITCH, DSSM + g * 128, ck * 128, nullptr);
    __syncthreads();
    bf16_t* st = (bf16_t*)(c.ws + WS_ST) + (size_t)(ck * 32 + g * 4) * 64 * 128;
    for (int o = c.tid; o < 4 * 64 * 128; o += 512) { const int n = o & 127, hp = o >> 7; float s = 0.f;
        for (int l = 0; l < 128; ++l) s += bf2f(*(LAS bf16_t*)(c.lds + L_B + l * BC_PITCH + n * 2)) * bf2f(*(LAS bf16_t*)(c.lds + L_XS + l * XS_PITCH + hp * 2));
        st[o] = (bf16_t)f2bf(s); }
    __syncthreads();
}

__device__ __forceinline__ void gmlp_item(const Ctx& c, int ck, int g) {
    bf16_t* uv = (bf16_t*)(c.ws + WS_UV);
    LAS float* vn = (LAS float*)c.lds;
    LAS float* ssq = (LAS float*)(c.lds + 65536);
    const float* lng = c.in[4] + g * 128; const float* lnb = c.in[5] + g * 128; const float* Ws = c.in[6] + (size_t)g * 128 * 128; const float* bs = c.in[7] + g * 128; const float* nag = c.in[8] + g * 128;
    for (int s = c.wave; s < 128; s += 8) {
        const bf16_t* vr = uv + (size_t)(ck * 128 + s) * DMIX + DA + g * 128;
        const float a0 = bf2f(vr[c.lane]), a1 = bf2f(vr[c.lane + 64]);
        const float mu = wave_sum(a0 + a1) * (1.0f / 128.0f); const float d0 = a0 - mu, d1 = a1 - mu;
        const float var = wave_sum(d0 * d0 + d1 * d1) * (1.0f / 128.0f); const float rs = 1.0f / sqrtf(var + EPS);
        vn[s * 128 + c.lane] = d0 * rs * lng[c.lane] + lnb[c.lane]; vn[s * 128 + c.lane + 64] = d1 * rs * lng[c.lane + 64] + lnb[c.lane + 64];
    }
    __syncthreads();
    const int d = c.tid & 127;
    for (int j = 0; j < 32; ++j) {
        const int t = (c.tid >> 7) + 4 * j; float sg = bs[t]; const float* wr_ = Ws + t * 128;
        for (int s = 0; s <= t; ++s) sg += wr_[s] * vn[s * 128 + d];
        bf16_t* up = uv + (size_t)(ck * 128 + t) * DMIX + g * 128 + d;
        const float y = bf2f(*up) * sg;
        *up = (bf16_t)f2bf(y * nag[d]);
        const float q = wave_sum(y * y);
        if (c.lane == 0) ssq[t * 2 + (c.wave & 1)] = q;
    }
    __syncthreads();
    if (c.tid < 128) ((float*)(c.ws + WS_SSQA))[(size_t)(ck * 128 + c.tid) * 16 + g] = ssq[c.tid * 2] + ssq[c.tid * 2 + 1];
    __syncthreads();
}

typedef short s16x4 __attribute__((ext_vector_type(4)));
typedef short v4i16_t __attribute__((ext_vector_type(4)));
__device__ __forceinline__ s16x4 ds_tr(LAS const unsigned char* p) { return __builtin_bit_cast(s16x4, __builtin_amdgcn_ds_read_tr16_b64_v4i16((LAS v4i16_t*)p)); }
__device__ __forceinline__ bf16x8 frag_tr(LAS const unsigned char* tile, int pitch, int k0, int c0, int lane) {
    const int hh = lane >> 5, blk = (lane >> 4) & 1, q = (lane & 15) >> 2, p = lane & 3;
    LAS const unsigned char* a = tile + (k0 + 8 * hh + q) * pitch + (c0 + 16 * blk + 4 * p) * 2;
    const s16x4 lo = ds_tr(a), hi = ds_tr(a + 4 * pitch);
    return __builtin_shufflevector(lo, hi, 0, 1, 2, 3, 4, 5, 6, 7);
}
__device__ __forceinline__ bf16x8 frag_tr_perm(LAS const unsigned char* tile, int pitch, int k0, int c0, int lane) {
    const int hh = lane >> 5, blk = (lane >> 4) & 1, q = (lane & 15) >> 2, p = lane & 3;
    LAS const unsigned char* a = tile + (k0 + 4 * hh + q) * pitch + (c0 + 16 * blk + 4 * p) * 2;
    const s16x4 lo = ds_tr(a), hi = ds_tr(a + 8 * pitch);
    return __builtin_shufflevector(lo, hi, 0, 1, 2, 3, 4, 5, 6, 7);
}
__device__ __forceinline__ bf16x8 frag_row(LAS const unsigned char* tile, int pitch, int r0, int k0, int lane) {
    return *(LAS const bf16x8*)(tile + (r0 + (lane & 31)) * pitch + (k0 + 8 * (lane >> 5)) * 2);
}
__device__ __forceinline__ bf16x8 pack_frag(const float* v) {
    u32x4 w; w.x = cvt_pk_bf16(v[0], v[1]); w.y = cvt_pk_bf16(v[2], v[3]); w.z = cvt_pk_bf16(v[4], v[5]); w.w = cvt_pk_bf16(v[6], v[7]);
    return __builtin_bit_cast(bf16x8, w);
}
#define MFMA32(a, b, c) __builtin_amdgcn_mfma_f32_32x32x16_bf16((a), (b), (c), 0, 0, 0)

__device__ __forceinline__ void gmlp_item_mfma(const Ctx& c, int ck, int g) {
    constexpr int VP = 320;
    bf16_t* uv = (bf16_t*)(c.ws + WS_UV);
    LAS unsigned char* vt = c.lds;
    LAS float* part = (LAS float*)(c.lds + 128 * VP);
    const float* lng = c.in[4] + g * 128; const float* lnb = c.in[5] + g * 128; const float* Ws = c.in[6] + (size_t)g * 128 * 128; const float* bs = c.in[7] + g * 128; const float* nag = c.in[8] + g * 128;
    const int lane = c.lane;
    { const f32x2 gg = *(const f32x2*)(lng + 2 * lane), bb = *(const f32x2*)(lnb + 2 * lane);
      for (int s = c.wave; s < 128; s += 8) {
        const unsigned w = *(const unsigned*)(uv + (size_t)(ck * 128 + s) * DMIX + DA + g * 128 + 2 * lane);
        const float a0 = bflo(w), a1 = bfhi(w);
        const float mu = wave_sum(a0 + a1) * (1.0f / 128.0f); const float d0 = a0 - mu, d1 = a1 - mu;
        const float var = wave_sum(d0 * d0 + d1 * d1) * (1.0f / 128.0f); const float rs = 1.0f / sqrtf(var + EPS);
        *(LAS unsigned*)(vt + s * VP + 4 * lane) = pk2(d0 * rs * gg[0] + bb[0], d1 * rs * gg[1] + bb[1]);
      } }
    __syncthreads();
    const int db = c.wave & 3, hh = lane >> 5, r = lane & 31;
#pragma unroll
    for (int tt = 0; tt < 2; ++tt) {
        const int tb = (c.wave < 4) ? (tt ? 3 : 0) : (tt ? 2 : 1);
        f32x16 acc; for (int i = 0; i < 16; ++i) acc[i] = 0.f;
        const int t = tb * 32 + r;
        const float* wrow = Ws + t * 128;
        for (int ks = 0; ks < 2 * (tb + 1); ++ks) {
            const int s0 = 16 * ks + 8 * hh;
            const f32x4 w0 = *(const f32x4*)(wrow + s0), w1 = *(const f32x4*)(wrow + s0 + 4);
            float wv[8];
#pragma unroll
            for (int j = 0; j < 4; ++j) { wv[j] = (s0 + j <= t) ? w0[j] : 0.f; wv[4 + j] = (s0 + 4 + j <= t) ? w1[j] : 0.f; }
            const bf16x8 bfrag = pack_frag(wv);
            const bf16x8 afrag = frag_tr(vt, VP, 16 * ks, db * 32, lane);
            acc = MFMA32(afrag, bfrag, acc);
        }
        const float bst = bs[t];
        bf16_t* urow = uv + (size_t)(ck * 128 + t) * DMIX + g * 128 + db * 32;
        float ss = 0.f;
#pragma unroll
        for (int gq = 0; gq < 4; ++gq) {
            const int dl = 8 * gq + 4 * hh;
            const u32x2 uw = *(const u32x2*)(urow + dl);
            const f32x4 na = *(const f32x4*)(nag + db * 32 + dl);
            const float y0 = bflo(uw.x) * (acc[4 * gq] + bst), y1 = bfhi(uw.x) * (acc[4 * gq + 1] + bst), y2 = bflo(uw.y) * (acc[4 * gq + 2] + bst), y3 = bfhi(uw.y) * (acc[4 * gq + 3] + bst);
            ss += (y0 * y0 + y1 * y1) + (y2 * y2 + y3 * y3);
            u32x2 o; o.x = pk2(y0 * na[0], y1 * na[1]); o.y = pk2(y2 * na[2], y3 * na[3]);
            *(u32x2*)(urow + dl) = o;
        }
        ss += __shfl_xor(ss, 32);
        if (hh == 0) part[t * 4 + db] = ss;
    }
    __syncthreads();
    if (c.tid < 128) ((float*)(c.ws + WS_SSQA))[(size_t)(ck * 128 + c.tid) * 16 + g] = (part[c.tid * 4] + part[c.tid * 4 + 1]) + (part[c.tid * 4 + 2] + part[c.tid * 4 + 3]);
    __syncthreads();
}

__device__ __forceinline__ void ssd_a_item_mfma(const Ctx& c, int ck, int g) {
    LAS float* sdt = (LAS float*)(c.lds + L_SDT); LAS float* sacs = (LAS float*)(c.lds + L_SACS); LAS float* sw = (LAS float*)(c.lds + L_SW);
    ssd_tables(c, ck, g, sdt, sacs);
    { const int l = c.tid >> 2, h = c.tid & 3; sw[l * 4 + h] = sdt[l * 4 + h] * __expf(sacs[127 * 4 + h] - sacs[l * 4 + h]); }
    if (c.tid < 4) ((float*)(c.ws + WS_CDEC))[ck * 32 + g * 4 + c.tid] = __expf(sacs[127 * 4 + c.tid]);
    __syncthreads();
    stage_conv_tile<256>(c, c.lds + L_XS, XS_PITCH, g * 256, ck * 128, sw);
    stage_conv_tile<128>(c, c.lds + L_B, BC_PITCH, DSSM + g * 128, ck * 128, nullptr);
    __syncthreads();
    const int lane = c.lane, h = c.wave >> 1, pb = c.wave & 1, hh = lane >> 5, r = lane & 31;
    f32x16 acc[4];
#pragma unroll
    for (int nb = 0; nb < 4; ++nb) for (int i = 0; i < 16; ++i) acc[nb][i] = 0.f;
#pragma unroll 2
    for (int ks = 0; ks < 8; ++ks) {
        const bf16x8 xf = frag_tr(c.lds + L_XS, XS_PITCH, 16 * ks, h * 64 + pb * 32, lane);
#pragma unroll
        for (int nb = 0; nb < 4; ++nb) { const bf16x8 bfg = frag_tr(c.lds + L_B, BC_PITCH, 16 * ks, nb * 32, lane); acc[nb] = MFMA32(bfg, xf, acc[nb]); }
    }
    bf16_t* st = (bf16_t*)(c.ws + WS_ST) + ((size_t)(ck * 32 + g * 4 + h) * 64 + pb * 32 + r) * 128;
#pragma unroll
    for (int nb = 0; nb < 4; ++nb)
#pragma unroll
        for (int gq = 0; gq < 4; ++gq) { u32x2 o; o.x = pk2(acc[nb][4 * gq], acc[nb][4 * gq + 1]); o.y = pk2(acc[nb][4 * gq + 2], acc[nb][4 * gq + 3]);
            *(u32x2*)(st + nb * 32 + 8 * gq + 4 * hh) = o; }
    __syncthreads();
}

constexpr int BC2_PITCH = 272;
__device__ __forceinline__ void ssd_c_item_mfma(const Ctx& c, int ck, int g) {
    LAS float* sdt = (LAS float*)(c.lds + L_SDT); LAS float* sacs = (LAS float*)(c.lds + L_SACS); LAS float* part = (LAS float*)(c.lds + L_SW);
    ssd_tables(c, ck, g, sdt, sacs);
    stage_conv_tile<256>(c, c.lds + L_XS, XS_PITCH, g * 256, ck * 128, nullptr);
    stage_conv_tile<128>(c, c.lds + L_B, BC2_PITCH, DSSM + g * 128, ck * 128, nullptr);
    stage_conv_tile<128>(c, c.lds + L_C, BC2_PITCH, DSSM + NGRP * NST + g * 128, ck * 128, nullptr);
    __syncthreads();
    const int lane = c.lane, h = c.wave >> 1, hh = lane >> 5, r = lane & 31;
    const float Dh = c.in[13][g * 4 + h];
    const bf16_t* hin = (const bf16_t*)(c.ws + WS_ST) + (size_t)(ck * 32 + g * 4 + h) * 64 * 128;
    LAS const unsigned char* xs = c.lds + L_XS; LAS const unsigned char* bt = c.lds + L_B; LAS const unsigned char* ct = c.lds + L_C;
    f32x16 acc[2][2];
#pragma unroll
    for (int lbi = 0; lbi < 2; ++lbi) {
        const int lb = (c.wave & 1) ? (lbi ? 2 : 1) : (lbi ? 3 : 0);
        const int l = lb * 32 + r;
        bf16x8 cf[8];
#pragma unroll
        for (int ks = 0; ks < 8; ++ks) cf[ks] = frag_row(ct, BC2_PITCH, lb * 32, 16 * ks, lane);
        f32x16 a0, a1; for (int i = 0; i < 16; ++i) { a0[i] = 0.f; a1[i] = 0.f; }
#pragma unroll
        for (int ks = 0; ks < 8; ++ks) {
            const bf16x8 h0 = *(const bf16x8*)(hin + (size_t)r * 128 + 16 * ks + 8 * hh), h1 = *(const bf16x8*)(hin + (size_t)(32 + r) * 128 + 16 * ks + 8 * hh);
            a0 = MFMA32(h0, cf[ks], a0); a1 = MFMA32(h1, cf[ks], a1);
        }
        const float al = sacs[l * 4 + h]; const float ea = __expf(al);
        a0 = a0 * ea; a1 = a1 * ea;
        for (int sb = 0; sb <= lb; ++sb) {
            f32x16 X; for (int i = 0; i < 16; ++i) X[i] = 0.f;
#pragma unroll
            for (int ks = 0; ks < 8; ++ks) X = MFMA32(frag_row(bt, BC2_PITCH, sb * 32, 16 * ks, lane), cf[ks], X);
            bf16x8 mf[2];
#pragma unroll
            for (int kk = 0; kk < 2; ++kk) {
                float mv[8];
#pragma unroll
                for (int j = 0; j < 8; ++j) {
                    const int sidx = sb * 32 + 16 * kk + 8 * (j >> 2) + 4 * hh + (j & 3);
                    float v = X[8 * kk + j] * __expf(al - sacs[sidx * 4 + h]) * sdt[sidx * 4 + h];
                    v = (sidx <= l) ? v : 0.f;
                    mv[j] = (sidx == l) ? v + Dh : v;
                }
                mf[kk] = pack_frag(mv);
            }
#pragma unroll
            for (int kk = 0; kk < 2; ++kk) {
                const bf16x8 x0 = frag_tr_perm(xs, XS_PITCH, sb * 32 + 16 * kk, h * 64, lane), x1 = frag_tr_perm(xs, XS_PITCH, sb * 32 + 16 * kk, h * 64 + 32, lane);
                a0 = MFMA32(x0, mf[kk], a0); a1 = MFMA32(x1, mf[kk], a1);
            }
        }
        acc[lbi][0] = a0; acc[lbi][1] = a1;
    }
    const bf16_t* zs = (const bf16_t*)(c.ws + WS_ZS); bf16_t* cat = (bf16_t*)(c.ws + WS_UV); const float* ng = c.in[14] + g * 256 + h * 64;
#pragma unroll
    for (int lbi = 0; lbi < 2; ++lbi) {
        const int lb = (c.wave & 1) ? (lbi ? 2 : 1) : (lbi ? 3 : 0);
        const int l = lb * 32 + r; const size_t row = (size_t)ck * 128 + l;
        float ss = 0.f;
#pragma unroll
        for (int pb = 0; pb < 2; ++pb)
#pragma unroll
            for (int gq = 0; gq < 4; ++gq) { const int p0 = pb * 32 + 8 * gq + 4 * hh;
                const u32x2 zw = *(const u32x2*)(zs + row * DSSM + g * 256 + h * 64 + p0);
                const float y0 = acc[lbi][pb][4 * gq] * bflo(zw.x), y1 = acc[lbi][pb][4 * gq + 1] * bfhi(zw.x), y2 = acc[lbi][pb][4 * gq + 2] * bflo(zw.y), y3 = acc[lbi][pb][4 * gq + 3] * bfhi(zw.y);
                acc[lbi][pb][4 * gq] = y0; acc[lbi][pb][4 * gq + 1] = y1; acc[lbi][pb][4 * gq + 2] = y2; acc[lbi][pb][4 * gq + 3] = y3;
                ss += (y0 * y0 + y1 * y1) + (y2 * y2 + y3 * y3); }
        ss += __shfl_xor(ss, 32);
        if (hh == 0) part[l * 4 + h] = ss;
    }
    __syncthreads();
#pragma unroll
    for (int lbi = 0; lbi < 2; ++lbi) {
        const int lb = (c.wave & 1) ? (lbi ? 2 : 1) : (lbi ? 3 : 0);
        const int l = lb * 32 + r; const size_t row = (size_t)ck * 128 + l;
        const float rinv = 1.0f / sqrtf(((part[l * 4] + part[l * 4 + 1]) + (part[l * 4 + 2] + part[l * 4 + 3])) * (1.0f / 256.0f) + EPS);
#pragma unroll
        for (int pb = 0; pb < 2; ++pb)
#pragma unroll
            for (int gq = 0; gq < 4; ++gq) { const int p0 = pb * 32 + 8 * gq + 4 * hh;
                const f32x4 gg = *(const f32x4*)(ng + p0);
                u32x2 o; o.x = pk2(acc[lbi][pb][4 * gq] * rinv * gg[0], acc[lbi][pb][4 * gq + 1] * rinv * gg[1]); o.y = pk2(acc[lbi][pb][4 * gq + 2] * rinv * gg[2], acc[lbi][pb][4 * gq + 3] * rinv * gg[3]);
                *(u32x2*)(cat + row * DMIX + DA + g * 256 + h * 64 + p0) = o; }
    }
    __syncthreads();
}

#ifndef MIX_GMLP_MFMA
#define MIX_GMLP_MFMA 1
#endif
#ifndef MIX_SSDA_MFMA
#define MIX_SSDA_MFMA 1
#endif
#ifndef MIX_SSDC_MFMA
#define MIX_SSDC_MFMA 1
#endif

__device__ __forceinline__ void phase_mix_a(const Ctx& c) {
    for (int it = c.bid; it < NCH * NGA + NCH * NGRP; it += c.nb) {
        if (it < NCH * NGA) { if (MIX_GMLP_MFMA) gmlp_item_mfma(c, it >> 4, it & 15); else gmlp_item(c, it >> 4, it & 15); }
        else { const int r = it - NCH * NGA; if (MIX_SSDA_MFMA) ssd_a_item_mfma(c, r >> 3, r & 7); else ssd_a_item(c, r >> 3, r & 7); }
    }
}

__device__ __forceinline__ void phase_scan(const Ctx& c) {
    unsigned* st = (unsigned*)(c.ws + WS_ST); const float* cdec = (const float*)(c.ws + WS_CDEC);
    for (int e = c.bid * 512 + c.tid; e < 32 * 64 * 64; e += c.nb * 512) {
        const int head = e >> 12; float h0 = 0.f, h1 = 0.f;
#pragma unroll 8
        for (int ck = 0; ck < NCH; ++ck) { const size_t idx = (size_t)ck * (32 * 64 * 64) + e; const unsigned w = st[idx]; const float dc = cdec[ck * 32 + head];
            st[idx] = pk2(h0, h1); h0 = dc * h0 + bflo(w); h1 = dc * h1 + bfhi(w); }
    }
    bf16_t* uv = (bf16_t*)(c.ws + WS_UV); const float* sq = (const float*)(c.ws + WS_SSQA);
    for (int i = c.bid * 512 + c.tid; i < S * (DA / 8); i += c.nb * 512) { const int row = i >> 8, ch = i & 255;
        const f32x4 q0 = *(const f32x4*)(sq + row * 16), q1 = *(const f32x4*)(sq + row * 16 + 4), q2 = *(const f32x4*)(sq + row * 16 + 8), q3 = *(const f32x4*)(sq + row * 16 + 12);
        float s = 0.f;
#pragma unroll
        for (int e = 0; e < 4; ++e) s += q0[e] + q1[e] + q2[e] + q3[e];
        const float rinv = 1.0f / sqrtf(s * (1.0f / DA) + EPS);
        u32x4* pp = (u32x4*)(uv + (size_t)row * DMIX + ch * 8); const u32x4 w = *pp; u32x4 o;
        o.x = pk2(bflo(w.x) * rinv, bfhi(w.x) * rinv); o.y = pk2(bflo(w.y) * rinv, bfhi(w.y) * rinv); o.z = pk2(bflo(w.z) * rinv, bfhi(w.z) * rinv); o.w = pk2(bflo(w.w) * rinv, bfhi(w.w) * rinv);
        *pp = o; }
}

__device__ __forceinline__ void ssd_c_item(const Ctx& c, int ck, int g) {
    LAS float* sdt = (LAS float*)(c.lds + L_SDT); LAS float* sacs = (LAS float*)(c.lds + L_SACS); LAS float* part = (LAS float*)(c.lds + L_SW);
    ssd_tables(c, ck, g, sdt, sacs);
    stage_conv_tile<256>(c, c.lds + L_XS, XS_PITCH, g * 256, ck * 128, nullptr);
    stage_conv_tile<128>(c, c.lds + L_B, BC_PITCH, DSSM + g * 128, ck * 128, nullptr);
    stage_conv_tile<128>(c, c.lds + L_C, BC_PITCH, DSSM + NGRP * NST + g * 128, ck * 128, nullptr);
    __syncthreads();
    float* G = (float*)(c.ws + WS_GSCR) + (size_t)c.bid * 16384;
    for (int o = c.tid; o < 16384; o += 512) { const int s = o & 127, l = o >> 7; float a = 0.f;
        if (s <= l) for (int n = 0; n < 128; ++n) a += bf2f(*(LAS bf16_t*)(c.lds + L_C + l * BC_PITCH + n * 2)) * bf2f(*(LAS bf16_t*)(c.lds + L_B + s * BC_PITCH + n * 2));
        __hip_atomic_store(G + o, a, __ATOMIC_RELAXED, __HIP_MEMORY_SCOPE_AGENT); }
    asm volatile("s_waitcnt vmcnt(0)" ::: "memory");
    __syncthreads();
    const bf16_t* hin = (const bf16_t*)(c.ws + WS_ST) + (size_t)(ck * 32 + g * 4) * 64 * 128;
    const bf16_t* zs = (const bf16_t*)(c.ws + WS_ZS); bf16_t* cat = (bf16_t*)(c.ws + WS_UV); const float* dsk = c.in[13]; const float* ng = c.in[14];
    const int hp = c.tid & 255, h = hp >> 6; const float Dh = dsk[g * 4 + h];
    for (int j = 0; j < 64; ++j) { const int l = (c.tid >> 8) + 2 * j; const float al = sacs[l * 4 + h];
        float y = 0.f;
        for (int s = 0; s <= l; ++s) y += __hip_atomic_load(G + l * 128 + s, __ATOMIC_RELAXED, __HIP_MEMORY_SCOPE_AGENT) * __expf(al - sacs[s * 4 + h]) * sdt[s * 4 + h] * bf2f(*(LAS bf16_t*)(c.lds + L_XS + s * XS_PITCH + hp * 2));
        float yo = 0.f;
        for (int n = 0; n < 128; ++n) yo += bf2f(*(LAS bf16_t*)(c.lds + L_C + l * BC_PITCH + n * 2)) * bf2f(hin[hp * 128 + n]);
        y += __expf(al) * yo + Dh * bf2f(*(LAS bf16_t*)(c.lds + L_XS + l * XS_PITCH + hp * 2));
        const size_t row = (size_t)ck * 128 + l;
        y *= bf2f(zs[row * DSSM + g * 256 + hp]);
        const float q = wave_sum(y * y);
        if (c.lane == 0) part[l * 4 + (c.wave & 3)] = q;
        cat[row * DMIX + DA + g * 256 + hp] = (bf16_t)f2bf(y);
    }
    __syncthreads();
    for (int j = 0; j < 64; ++j) { const int l = (c.tid >> 8) + 2 * j; const size_t row = (size_t)ck * 128 + l;
        const float rinv = 1.0f / sqrtf(((part[l * 4] + part[l * 4 + 1]) + (part[l * 4 + 2] + part[l * 4 + 3])) * (1.0f / 256.0f) + EPS);
        bf16_t* pp = cat + row * DMIX + DA + g * 256 + hp;
        *pp = (bf16_t)f2bf(bf2f(*pp) * rinv * ng[g * 256 + hp]); }
    __syncthreads();
}

__device__ __forceinline__ void phase_mix_c(const Ctx& c) {
    for (int it = c.bid; it < NCH * NGRP; it += c.nb) { if (MIX_SSDC_MFMA) ssd_c_item_mfma(c, it >> 3, it & 7); else ssd_c_item(c, it >> 3, it & 7); }
}

__device__ __forceinline__ void phase_final(const Ctx& c) {
    const int gw = c.bid * 8 + c.wave, NGW = c.nb * 8; const float* g = c.in[24]; const float* sq = (const float*)(c.ws + WS_SSQ3);
    for (int m = gw; m < S; m += NGW) {
        const f32x4 q0 = *(const f32x4*)(sq + (size_t)m * 8), q1 = *(const f32x4*)(sq + (size_t)m * 8 + 4);
        const float rinv = 1.0f / sqrtf(((q0[0] + q0[1]) + (q0[2] + q0[3]) + (q1[0] + q1[1]) + (q1[2] + q1[3])) * (1.0f / D) + EPS);
        float* orow = c.out + (size_t)m * D + 4 * c.lane;
#pragma unroll
        for (int j = 0; j < 8; ++j) { const f32x4 v = *(const f32x4*)(orow + 256 * j), gg = *(const f32x4*)(g + 4 * c.lane + 256 * j); *(f32x4*)(orow + 256 * j) = v * rinv * gg; }
    }
}

#define XB_TMO      128
#define XB_XCNT(j)  (256  + 64 * (j))
#define XB_XSUB(j)  (1280 + 64 * (j))
#define XB_XGEN(j)  (2304 + 64 * (j))
#define XB_TOP      3328
#define XB_TOPGEN   3392
#define XCD_BAR_WORDS 3456
#define XB_SPIN_CAP (1u << 20)
__device__ __forceinline__ unsigned xb_ld(unsigned* p)              { return __hip_atomic_load(p, __ATOMIC_RELAXED, __HIP_MEMORY_SCOPE_AGENT); }
__device__ __forceinline__ unsigned xb_add(unsigned* p, unsigned v) { return __hip_atomic_fetch_add(p, v, __ATOMIC_RELAXED, __HIP_MEMORY_SCOPE_AGENT); }
__device__ __forceinline__ unsigned xb_xcc_id() { return (unsigned)__builtin_amdgcn_s_getreg((3 << 11) | 20) & 0xFu; }
#define XB_SPIN(cond, bar) do { unsigned _sp = 0; while (cond) { __builtin_amdgcn_s_sleep(1); \
    if ((++_sp & 255u) == 0u) { if (xb_ld(&(bar)[XB_TMO])) break; if (_sp > XB_SPIN_CAP) { atomicAdd(&(bar)[XB_TMO], 1u); break; } } } } while (0)
struct XcdBarrier { unsigned* bar; unsigned x; volatile LAS unsigned* st; };
__device__ __forceinline__ XcdBarrier xcd_barrier_post(unsigned* bar, volatile LAS unsigned* st) {
    XcdBarrier b; b.bar = bar; b.x = xb_xcc_id(); b.st = st;
    if (threadIdx.x == 0) (void)xb_add(&bar[XB_XCNT(b.x)], 1u);
    return b;
}
__device__ __forceinline__ void xcd_barrier_complete(unsigned* bar, unsigned x, unsigned& nloc, unsigned& nx) {
    const unsigned G = gridDim.x * gridDim.y * gridDim.z;
    unsigned sum, cnt, mine, sp = 0u;
    for (;;) {
        sum = 0u; cnt = 0u; mine = 0u;
#pragma unroll
        for (unsigned j = 0; j < 16; ++j) { const unsigned c = xb_ld(&bar[XB_XCNT(j)]); sum += c; cnt += (c > 0u) ? 1u : 0u; mine = (j == x) ? c : mine; }
        if (sum == G) break;
        __builtin_amdgcn_s_sleep(1);
        if ((++sp & 255u) == 0u) { if (xb_ld(&bar[XB_TMO])) break; if (sp > XB_SPIN_CAP) { atomicAdd(&bar[XB_TMO], 1u); break; } }
    }
    nloc = mine > 0u ? mine : 1u; nx = cnt > 0u ? cnt : 1u;
}
__device__ __forceinline__ void xcd_barrier(const XcdBarrier& b) {
    asm volatile("s_waitcnt vmcnt(0)" ::: "memory");
    __syncthreads();
    if (threadIdx.x == 0) {
        unsigned* bar = b.bar;
        __builtin_amdgcn_s_waitcnt(0);
        unsigned nloc = b.st[0], nx = b.st[1];
        if (nloc == 0u) { xcd_barrier_complete(bar, b.x, nloc, nx); b.st[0] = nloc; b.st[1] = nx; }
        const unsigned old = xb_add(&bar[XB_XSUB(b.x)], 1u);
        const unsigned gen = old / nloc;
        if (old + 1u == (gen + 1u) * nloc) {
            __builtin_amdgcn_fence(__ATOMIC_RELEASE, "agent");
            asm volatile("s_waitcnt vmcnt(0)" ::: "memory");
            const unsigned og = xb_add(&bar[XB_TOP], 1u);
            const unsigned tg = og / nx;
            if (og + 1u == (tg + 1u) * nx) xb_add(&bar[XB_TOPGEN], 1u);
            else XB_SPIN(xb_ld(&bar[XB_TOPGEN]) == tg, bar);
            __builtin_amdgcn_fence(__ATOMIC_ACQUIRE, "agent");
            xb_add(&bar[XB_XGEN(b.x)], 1u);
            asm volatile("s_waitcnt vmcnt(0)" ::: "memory");
        } else {
            XB_SPIN(xb_ld(&bar[XB_XGEN(b.x)]) == gen, bar);
            __builtin_amdgcn_fence(__ATOMIC_ACQUIRE, "agent");
            asm volatile("s_waitcnt vmcnt(0)" ::: "memory");
        }
    }
    __syncthreads();
}

__global__ void __launch_bounds__(512, 2) mega_fwd(Params P, int ph_lo, int ph_hi) {
    extern __shared__ __attribute__((aligned(16))) unsigned char lds_raw[];
    Ctx c;
    c.lds = (LAS unsigned char*)lds_raw; c.tid = threadIdx.x; c.lane = c.tid & 63; c.wave = __builtin_amdgcn_readfirstlane(c.tid >> 6);
    c.nb = gridDim.x; c.bid = blockIdx.x; c.in = P.in; c.out = P.out; c.ws = P.ws;
    unsigned char* ws = P.ws;
    volatile LAS unsigned* bst = (volatile LAS unsigned*)(c.lds + L_MISC);
    if (c.tid < 2) bst[c.tid] = 0u;
    __syncthreads();
    const XcdBarrier xbar = xcd_barrier_post((unsigned*)ws, bst);
#ifndef PH_MASK
#define PH_MASK 0x3ff
#endif
#define IN(k) (((PH_MASK >> (k)) & 1) && ph_lo <= (k) && (k) < ph_hi)
#ifndef CG_SEAM
#define CG_SEAM -1
#endif
#define SEAM(k) do { if (IN(k) && IN((k) + 1)) { if ((k) == CG_SEAM) cg::this_grid().sync(); else xcd_barrier(xbar); } } while (0)
    if (IN(0)) phase_prep(c);
    SEAM(0);
    if (IN(1)) {
        pg8::Gemm g{(const bf16_t*)(ws + WS_A), (const bf16_t*)(ws + WS_WIN), D}; pg8::StaticOrder So; So.init(32, 40, c.nb, c.bid);
        EpiProj E{(bf16_t*)(ws + WS_UV), (bf16_t*)(ws + WS_ZS), (bf16_t*)(ws + WS_XBC)};
        pg8::gemm_phase<EpiProj, true, true>(c.lds, g, So, E);
        phase_dt(c);
    }
    SEAM(1);
    if (IN(2)) phase_mix_a(c);
    SEAM(2);
    if (IN(3)) phase_scan(c);
    SEAM(3);
    if (IN(4)) phase_mix_c(c);
    SEAM(4);
    if (IN(5)) {
        { pg8::Gemm g{(const bf16_t*)(ws + WS_UV), (const bf16_t*)(ws + WS_WOUT), DMIX}; pg8::StaticOrder So; So.init(32, 8, c.nb, c.bid);
          EpiResid E{P.in[0], P.out, (bf16_t*)(ws + WS_HG), (bf16_t*)(ws + WS_HG) + (size_t)S * D, P.in[16], (float*)(ws + WS_SSQ1)};
          pg8::gemm_phase<EpiResid, false, true>(c.lds, g, So, E); }
        { pg8::Gemm g{(const bf16_t*)(ws + WS_P16), (const bf16_t*)(ws + WS_WPLE), DPLE}; pg8::StaticOrder So; So.init(32, 8, c.nb, c.bid);
          EpiPlain E{(bf16_t*)(ws + WS_E), D};
          pg8::gemm_phase<EpiPlain, true, true>(c.lds, g, So, E); }
    }
    SEAM(5);
    if (IN(6)) {
        pg8::Gemm g{(const bf16_t*)(ws + WS_HG), (const bf16_t*)(ws + WS_WUP), D}; pg8::StaticOrder So; So.init(34, 44, c.nb, c.bid);
        EpiFfn E{(bf16_t*)(ws + WS_ACT), (const float*)(ws + WS_SSQ1), P.in[18], P.in[19]};
        pg8::gemm_phase<EpiFfn, true, true>(c.lds, g, So, E);
    }
    SEAM(6);
    if (IN(7)) {
        pg8::Gemm g{(const bf16_t*)(ws + WS_ACT), (const bf16_t*)(ws + WS_WDN), DFF}; pg8::StaticOrder So; So.init(32, 8, c.nb, c.bid);
        EpiResid E{P.out, P.out, (bf16_t*)(ws + WS_H2G), nullptr, P.in[21], (float*)(ws + WS_SSQ2)};
        pg8::gemm_phase<EpiResid, false, true>(c.lds, g, So, E);
    }
    SEAM(7);
    if (IN(8)) {
        pg8::Gemm g{(const bf16_t*)(ws + WS_H2G), (const bf16_t*)(ws + WS_WPG), D}; pg8::StaticOrder So; So.init(32, 8, c.nb, c.bid);
        EpiPle E{P.out, (const bf16_t*)(ws + WS_E), (const float*)(ws + WS_SSQ2), (float*)(ws + WS_SSQ3)};
        pg8::gemm_phase<EpiPle, false, true>(c.lds, g, So, E);
    }
    SEAM(8);
    if (IN(9)) phase_final(c);
#undef IN
#undef SEAM
}

extern "C" void kernel_launch(void* const* d_in, const int* in_sizes, int n_in, void* d_out, int out_size, void* d_ws, size_t ws_size, hipStream_t stream) {
    static int grid = 0;
    if (grid == 0) {
        if (n_in != 25 || out_size != S * D || ws_size < WS_END) { fprintf(stderr, "kernel_launch: unexpected shapes (n_in %d out %d ws %zu)\n", n_in, out_size, ws_size); grid = -1; return; }
        int dev = 0, cus = 0, per_cu = 0;
        (void)hipGetDevice(&dev); (void)hipDeviceGetAttribute(&cus, hipDeviceAttributeMultiprocessorCount, dev);
        if (hipFuncSetAttribute((const void*)mega_fwd, hipFuncAttributeMaxDynamicSharedMemorySize, LDS_BYTES) != hipSuccess) { fprintf(stderr, "kernel_launch: hipFuncSetAttribute failed\n"); grid = -1; return; }
        (void)hipOccupancyMaxActiveBlocksPerMultiprocessor(&per_cu, (const void*)mega_fwd, 512, LDS_BYTES);
        if (per_cu < 1) { fprintf(stderr, "kernel_launch: occupancy query says %d blocks/CU\n", per_cu); per_cu = 1; }
        (void)hipGetLastError();
        grid = cus;
        fprintf(stderr, "kernel_launch: grid %d (cus %d, per_cu %d)\n", grid, cus, per_cu);
    }
    if (grid < 0) return;
    if (hipMemsetAsync(d_ws, 0, 16384, stream) != hipSuccess) { fprintf(stderr, "kernel_launch: memset failed\n"); return; }
    Params P{};
    for (int i = 0; i < 25; ++i) P.in[i] = (const float*)d_in[i];
    P.out = (float*)d_out; P.ws = (unsigned char*)d_ws;
#if MK_LAUNCHES == 1
    int lo = 0, hi = NPH;
    void* args[] = {&P, &lo, &hi};
#if CG_SEAM >= 0
    hipError_t e = hipLaunchCooperativeKernel((const void*)mega_fwd, dim3(grid), dim3(512), args, LDS_BYTES, stream);
#else
    (void)args;
    hipLaunchKernelGGL(mega_fwd, dim3(grid), dim3(512), LDS_BYTES, stream, P, lo, hi);
    hipError_t e = hipPeekAtLastError();
#endif
    if (e != hipSuccess) fprintf(stderr, "kernel_launch: launch failed: %s\n", hipGetErrorString(e));
#else
    for (int k = 0; k < NPH; ++k) {
        int lo = k, hi = k + 1;
        void* args[] = {&P, &lo, &hi};
        hipError_t e = hipLaunchCooperativeKernel((const void*)mega_fwd, dim3(grid), dim3(512), args, LDS_BYTES, stream);
        if (e != hipSuccess) { fprintf(stderr, "kernel_launch: launch %d failed: %s\n", k, hipGetErrorString(e)); break; }
    }
#endif
}
```

```cpp
#include <hip/hip_runtime.h>
#include <hip/hip_cooperative_groups.h>
#include <cstdio>
#include <cstdint>
namespace cg = cooperative_groups;

#ifndef MK_LAUNCHES
#define MK_LAUNCHES 1
#endif

#define LAS __attribute__((address_space(3)))
typedef unsigned short bf16_t;
typedef short bf16x8 __attribute__((ext_vector_type(8)));
typedef float f32x4 __attribute__((ext_vector_type(4)));
typedef float f32x2 __attribute__((ext_vector_type(2)));
typedef float f32x16 __attribute__((ext_vector_type(16)));
typedef unsigned u32x4 __attribute__((ext_vector_type(4)));
typedef unsigned u32x2 __attribute__((ext_vector_type(2)));

constexpr int S = 8192, D = 2048, DIN = 10272, DA = 2048, DSSM = 2048, DXBC = 4096, NH = 32, NGRP = 8, NST = 128;
constexpr int DFF = 5632, DPLE = 256, DMIX = 4096, NCH = 64, CH = 128, NGA = 16;
constexpr float EPS = 1e-6f;
constexpr int NPH = 10;

constexpr size_t MiB = 1u << 20;
constexpr size_t WS_WUP = 1 * MiB;
constexpr size_t WS_WDN = 45 * MiB;
constexpr size_t WS_WPG = 67 * MiB;
constexpr size_t WS_WPLE = 75 * MiB;
constexpr size_t WS_WIN = 76 * MiB;
constexpr size_t WS_WOUT = 117 * MiB;
constexpr size_t WS_UV = 133 * MiB;
constexpr size_t WS_ACT = 133 * MiB;
constexpr size_t WS_ZS = 197 * MiB;
constexpr size_t WS_XBC = 229 * MiB;
constexpr size_t WS_HG = 229 * MiB;
constexpr size_t WS_H2G = 229 * MiB;
constexpr size_t WS_A = 293 * MiB;
constexpr size_t WS_ST = 293 * MiB;
constexpr size_t WS_E = 293 * MiB;
constexpr size_t WS_P16 = 325 * MiB;
constexpr size_t WS_DT = 329 * MiB;
constexpr size_t WS_SSQA = 330 * MiB;
constexpr size_t WS_SSQ1 = 331 * MiB;
constexpr size_t WS_SSQ2 = WS_SSQ1 + 256 * 1024;
constexpr size_t WS_SSQ3 = WS_SSQ2 + 256 * 1024;
constexpr size_t WS_CDEC = WS_SSQ3 + 256 * 1024;
constexpr size_t WS_GSCR = 332 * MiB;
constexpr size_t WS_END = 348 * MiB;

constexpr int LDS_BYTES = 163840;

struct Params {
    const float* in[25];
    float* out;
    unsigned char* ws;
};

__device__ __forceinline__ unsigned f2bf(float f) { unsigned u = __builtin_bit_cast(unsigned, f); return (u + 0x7fffu + ((u >> 16) & 1u)) >> 16; }
__device__ __forceinline__ unsigned pk2(float lo, float hi) { return f2bf(lo) | (f2bf(hi) << 16); }
__device__ __forceinline__ float bf2f(unsigned short b) { return __builtin_bit_cast(float, ((unsigned)b) << 16); }
__device__ __forceinline__ float bflo(unsigned w) { return __builtin_bit_cast(float, w << 16); }
__device__ __forceinline__ float bfhi(unsigned w) { return __builtin_bit_cast(float, w & 0xffff0000u); }
__device__ __forceinline__ float fast_sigmoid(float x) { return __builtin_amdgcn_rcpf(1.0f + __builtin_amdgcn_exp2f(-1.4426950408889634f * x)); }
__device__ __forceinline__ float silu_f(float x) { return x * fast_sigmoid(x); }
__device__ __forceinline__ float gelu_tanh_f(float x) { const float t = x + 0.044715f * x * x * x; return x * __builtin_amdgcn_rcpf(1.0f + __builtin_amdgcn_exp2f(-2.3022081986f * t)); }
__device__ __forceinline__ float wave_sum(float v) {
#pragma unroll
    for (int o = 1; o < 64; o <<= 1) v += __shfl_xor(v, o);
    return v;
}

namespace pg8 {
constexpr int BM = 256, BK = 64, HALF = 128, HTB = HALF * BK * 2, STAGE_BYTES = 8 * HTB, NXCD = 8, WGM = 8;
__host__ __device__ __forceinline__ int lds_byte(int r, int c) { const int st = (r >> 4) * 2 + (c >> 5), rr = r & 15, cc = c & 31, ob = rr * 64 + cc * 2; return st * 1024 + (ob ^ (((ob >> 9) & 1) << 5)); }
__host__ __device__ __forceinline__ void stage_rc(int b, int& R, int& C) { const int st = b / 1024, sb = b % 1024, swz = sb ^ (((sb >> 9) & 1) << 5); R = (st >> 1) * 16 + swz / 64; C = (st & 1) * 32 + (swz % 64) / 2; }
__host__ __device__ __forceinline__ int perm32(int rho) { const int n = rho >> 4, i = rho & 15; return 8 * (i >> 2) + 4 * n + (i & 3); }

struct Unit { int pm, pn; };
struct Gemm { const bf16_t* A; const bf16_t* Bt; int K; };

struct StaticOrder {
    int nM, nN, nwg, G, c;
    __device__ void init(int nM_, int nN_, int G_, int c_) { nM = nM_; nN = nN_; nwg = nM * nN; G = G_; c = c_; }
    __device__ bool next(int i, Unit& u) const {
        const long L = (long)i * G + c; if (L >= nwg) return false;
        int wgid = (int)L; { const int q = nwg / NXCD, r = nwg % NXCD, xcd = wgid % NXCD, off = wgid / NXCD; wgid = (xcd < r ? xcd * (q + 1) : r * (q + 1) + (xcd - r) * q) + off; }
        const int nig = WGM * nN, gid = wgid / nig, fm = gid * WGM, gsz = (nM - fm) < WGM ? (nM - fm) : WGM;
        u.pm = fm + ((wgid % nig) % gsz); u.pn = (wgid % nig) / gsz; return true;
    }
};

__device__ __forceinline__ unsigned cvt_pk_bf16(float lo, float hi) { unsigned r; asm volatile("v_cvt_pk_bf16_f32 %0, %1, %2" : "=v"(r) : "v"(lo), "v"(hi)); return r; }

template <class Epi, bool ALIGN_EPI, bool SP2>
__device__ __forceinline__ void gemm_phase(LAS unsigned char* lds, const Gemm g, const StaticOrder& S, const Epi& E) {
    const int tid = threadIdx.x, wid = __builtin_amdgcn_readfirstlane(tid >> 6), lane = tid & 63, wr = wid >> 2, wc = wid & 3, fr = lane & 15, fq = lane >> 4;
    const int K = g.K, nt = K / BK;
    unsigned voffA[2], voffB[2];
#pragma unroll
    for (int i = 0; i < 2; ++i) { int R, C; stage_rc(tid * 16 + i * 8192, R, C); const int Rb = (R & ~31) + perm32(R & 31);
        voffA[i] = (unsigned)(R * K + C) * 2u; voffB[i] = (unsigned)(Rb * K + C) * 2u; }
    const size_t kstep = (size_t)(BK * 2);
    const size_t hstep = (size_t)HALF * K * 2;
    const size_t tstep = 2 * hstep;
    const unsigned ldsw = (unsigned)wid * 1024u;
    const int aoff = lds_byte(wr * 64 + fr, fq * 8), boff = lds_byte(wc * 32 + fr, fq * 8);
#define PG8_SA(b, h) (((b) * 2 + (h)) * HTB)
#define PG8_SB(b, h) ((4 + (b) * 2 + (h)) * HTB)
#define PG8_STAGE(bufoff, gbase, voff) do { _Pragma("unroll") for (int _i = 0; _i < 2; ++_i) \
        __builtin_amdgcn_global_load_lds((const unsigned*)((const char*)(gbase) + (voff)[_i]), (LAS unsigned*)(lds + (bufoff) + ldsw + _i * 8192), 16, 0, 0); } while (0)
#define PG8_LDA(dst, b, h) do { _Pragma("unroll") for (int m = 0; m < 4; ++m) _Pragma("unroll") for (int k = 0; k < 2; ++k) dst[m][k] = *(const LAS bf16x8*)(lds + PG8_SA(b, h) + aoff + m * 2048 + k * 1024); } while (0)
#define PG8_LDB(dst, b, h) do { _Pragma("unroll") for (int n = 0; n < 2; ++n) _Pragma("unroll") for (int k = 0; k < 2; ++k) dst[n][k] = *(const LAS bf16x8*)(lds + PG8_SB(b, h) + boff + n * 2048 + k * 1024); } while (0)
#define PG8_MMA(ai, bj, At, Bt) do { __builtin_amdgcn_s_setprio(1); _Pragma("unroll") for (int m = 0; m < 4; ++m) _Pragma("unroll") for (int n = 0; n < 2; ++n) _Pragma("unroll") for (int k = 0; k < 2; ++k) \
        acc[ai][bj][m][n] = __builtin_amdgcn_mfma_f32_16x16x32_bf16(Bt[n][k], At[m][k], acc[ai][bj][m][n], 0, 0, 0); __builtin_amdgcn_s_setprio(0); } while (0)
#define PG8_WAIT_V(n) asm volatile("s_waitcnt vmcnt(" #n ")" ::: "memory")
#define PG8_WAIT_L(n) asm volatile("s_waitcnt lgkmcnt(" #n ")" ::: "memory")
#define PG8_BAR __builtin_amdgcn_s_barrier()
#define PG8_SCHED __builtin_amdgcn_sched_barrier(0)
    Unit cur, nxt; int ui = 0;
    if (!S.next(0, cur)) return;
    f32x4 acc[2][2][4][2];
#pragma unroll
    for (int a = 0; a < 2; ++a)
#pragma unroll
        for (int b = 0; b < 2; ++b)
#pragma unroll
            for (int m = 0; m < 4; ++m)
#pragma unroll
                for (int n = 0; n < 2; ++n) acc[a][b][m][n] = (f32x4){0.f, 0.f, 0.f, 0.f};
    bf16x8 At[4][2], B0[2][2], B1[2][2];
    const char* cA = (const char*)g.A + (size_t)cur.pm * tstep; const char* cB = (const char*)g.Bt + (size_t)cur.pn * tstep;
    if constexpr (SP2) {
        PG8_STAGE(PG8_SB(0, 0), cB, voffB); PG8_STAGE(PG8_SB(0, 1), cB + hstep, voffB); PG8_STAGE(PG8_SA(0, 0), cA, voffA); PG8_STAGE(PG8_SA(0, 1), cA + hstep, voffA);
        if (wr == 1) PG8_BAR;
        PG8_WAIT_V(2); PG8_BAR;
        PG8_STAGE(PG8_SB(1, 0), cB + kstep, voffB); PG8_STAGE(PG8_SA(1, 0), cA + kstep, voffA); PG8_STAGE(PG8_SB(1, 1), cB + hstep + kstep, voffB);
        PG8_WAIT_V(6); PG8_BAR;
    } else {
        PG8_STAGE(PG8_SB(0, 0), cB, voffB); PG8_STAGE(PG8_SA(0, 0), cA, voffA); PG8_STAGE(PG8_SB(0, 1), cB + hstep, voffB); PG8_STAGE(PG8_SA(0, 1), cA + hstep, voffA);
        if (wr == 1) PG8_BAR;
        PG8_WAIT_V(4); PG8_BAR;
        PG8_STAGE(PG8_SB(1, 0), cB + kstep, voffB); PG8_STAGE(PG8_SA(1, 0), cA + kstep, voffA); PG8_STAGE(PG8_SB(1, 1), cB + hstep + kstep, voffB);
        PG8_WAIT_V(6); PG8_BAR;
    }
    for (;;) {
        const bool has_next = S.next(ui + 1, nxt);
        const char* nA = has_next ? (const char*)g.A + (size_t)nxt.pm * tstep : cA; const char* nB = has_next ? (const char*)g.Bt + (size_t)nxt.pn * tstep : cB;
#pragma nounroll
        for (int t = 0; t < nt; t += 2) {
            const bool last = (t == nt - 2);
            const char* a1 = cA + (size_t)(t + 1) * kstep;
            const char* a2 = last ? nA : cA + (size_t)(t + 2) * kstep; const char* b2 = last ? nB : cB + (size_t)(t + 2) * kstep;
            const char* a3 = a2 + kstep; const char* b3 = b2 + kstep;
            if constexpr (SP2) {
            PG8_LDB(B0, 0, 0); PG8_LDB(B1, 0, 1); PG8_SCHED; PG8_LDA(At, 0, 0); PG8_STAGE(PG8_SA(1, 1), a1 + hstep, voffA);
            PG8_WAIT_V(8); PG8_WAIT_L(0); PG8_BAR; PG8_MMA(0, 0, At, B0); PG8_MMA(0, 1, At, B1); PG8_BAR; PG8_SCHED;
            PG8_LDA(At, 0, 1); PG8_STAGE(PG8_SB(0, 0), b2, voffB); PG8_STAGE(PG8_SB(0, 1), b2 + hstep, voffB); PG8_STAGE(PG8_SA(0, 0), a2, voffA);
            PG8_WAIT_V(8); PG8_WAIT_L(0); PG8_BAR; PG8_MMA(1, 0, At, B0); PG8_MMA(1, 1, At, B1); PG8_BAR; PG8_SCHED;
            PG8_LDB(B0, 1, 0); PG8_LDB(B1, 1, 1); PG8_SCHED; PG8_LDA(At, 1, 0); PG8_STAGE(PG8_SA(0, 1), a2 + hstep, voffA);
            PG8_WAIT_V(8); PG8_WAIT_L(0); PG8_BAR; PG8_MMA(0, 0, At, B0); PG8_MMA(0, 1, At, B1); PG8_BAR; PG8_SCHED;
            PG8_LDA(At, 1, 1); PG8_STAGE(PG8_SB(1, 0), b3, voffB); PG8_STAGE(PG8_SB(1, 1), b3 + hstep, voffB); PG8_STAGE(PG8_SA(1, 0), a3, voffA);
            PG8_WAIT_V(8); PG8_WAIT_L(0); PG8_BAR; PG8_MMA(1, 0, At, B0); PG8_MMA(1, 1, At, B1); PG8_BAR; PG8_SCHED;
            } else {
            PG8_LDB(B0, 0, 0); PG8_SCHED; PG8_LDA(At, 0, 0); PG8_STAGE(PG8_SA(1, 1), a1 + hstep, voffA);
            PG8_WAIT_L(8); PG8_BAR; PG8_WAIT_L(0); PG8_MMA(0, 0, At, B0); PG8_BAR; PG8_SCHED;
            PG8_LDB(B1, 0, 1); PG8_STAGE(PG8_SB(0, 0), b2, voffB);
            PG8_BAR; PG8_WAIT_L(0); PG8_MMA(0, 1, At, B1); PG8_BAR;
            PG8_LDA(At, 0, 1); PG8_STAGE(PG8_SA(0, 0), a2, voffA);
            PG8_BAR; PG8_WAIT_L(0); PG8_MMA(1, 0, At, B0); PG8_BAR; PG8_SCHED;
            PG8_STAGE(PG8_SB(0, 1), b2 + hstep, voffB);
            PG8_WAIT_V(6); PG8_BAR; PG8_MMA(1, 1, At, B1); PG8_BAR;
            PG8_LDB(B0, 1, 0); PG8_SCHED; PG8_LDA(At, 1, 0); PG8_STAGE(PG8_SA(0, 1), a2 + hstep, voffA);
            PG8_WAIT_L(8); PG8_BAR; PG8_WAIT_L(0); PG8_MMA(0, 0, At, B0); PG8_BAR; PG8_SCHED;
            PG8_LDB(B1, 1, 1); PG8_STAGE(PG8_SB(1, 0), b3, voffB);
            PG8_BAR; PG8_WAIT_L(0); PG8_MMA(0, 1, At, B1); PG8_BAR;
            PG8_LDA(At, 1, 1); PG8_STAGE(PG8_SA(1, 0), a3, voffA);
            PG8_BAR; PG8_WAIT_L(0); PG8_MMA(1, 0, At, B0); PG8_BAR; PG8_SCHED;
            PG8_STAGE(PG8_SB(1, 1), b3 + hstep, voffB);
            PG8_WAIT_V(6); PG8_BAR; PG8_MMA(1, 1, At, B1); PG8_BAR;
            }
        }
        if constexpr (ALIGN_EPI) { if (wr == 0) PG8_BAR; }
        if constexpr (!Epi::AFTER_DRAIN) { E(acc, cur, wr, wc, fr, fq); }
        if (!has_next) break;
#pragma unroll
        for (int a = 0; a < 2; ++a)
#pragma unroll
            for (int b = 0; b < 2; ++b)
#pragma unroll
                for (int m = 0; m < 4; ++m)
#pragma unroll
                    for (int n = 0; n < 2; ++n) acc[a][b][m][n] = (f32x4){0.f, 0.f, 0.f, 0.f};
        cur = nxt; cA = nA; cB = nB; ++ui;
        if constexpr (ALIGN_EPI) { if (wr == 1) PG8_BAR; }
    }
    PG8_WAIT_V(0);
    if constexpr (!ALIGN_EPI) { if (wr == 0) PG8_BAR; }
    PG8_BAR;
    if constexpr (Epi::AFTER_DRAIN) { E.fused(acc, cur, wr, wc, fr, fq, lds, wid, lane); }
#undef PG8_SA
#undef PG8_SB
#undef PG8_STAGE
#undef PG8_LDA
#undef PG8_LDB
#undef PG8_MMA
#undef PG8_WAIT_V
#undef PG8_WAIT_L
#undef PG8_BAR
#undef PG8_SCHED
}
}
using pg8::Unit; using pg8::cvt_pk_bf16;
typedef f32x4 AccT[2][2][4][2];

__device__ __forceinline__ u32x4 pack8(const f32x4 v0, const f32x4 v1) { u32x4 w; w.x = cvt_pk_bf16(v0[0], v0[1]); w.y = cvt_pk_bf16(v0[2], v0[3]); w.z = cvt_pk_bf16(v1[0], v1[1]); w.w = cvt_pk_bf16(v1[2], v1[3]); return w; }

struct EpiProj {
    static constexpr bool AFTER_DRAIN = false;
    bf16_t *uv, *zs, *xbc;
    __device__ __forceinline__ void operator()(const AccT& acc, const Unit& u, int wr, int wc, int fr, int fq) const {
        const int row0 = u.pm * 256 + wr * 64 + fr; const int ct = wc * 32 + 8 * fq;
        bf16_t* base; int ld, mode;
        if (u.pn < 16) { base = uv + u.pn * 256; ld = DMIX; mode = 0; }
        else if (u.pn < 24) { base = zs + (u.pn - 16) * 256; ld = DSSM; mode = 1; }
        else { base = xbc + (u.pn - 24) * 256; ld = DXBC; mode = 2; }
#pragma unroll
        for (int ai = 0; ai < 2; ++ai)
#pragma unroll
            for (int m = 0; m < 4; ++m) { bf16_t* rowp = base + (size_t)(row0 + ai * 128 + m * 16) * ld + ct;
#pragma unroll
                for (int bj = 0; bj < 2; ++bj) { f32x4 v0 = acc[ai][bj][m][0], v1 = acc[ai][bj][m][1];
                    if (mode == 0) {
#pragma unroll
                        for (int j = 0; j < 4; ++j) { v0[j] = gelu_tanh_f(v0[j]); v1[j] = gelu_tanh_f(v1[j]); } }
                    else if (mode == 1) {
#pragma unroll
                        for (int j = 0; j < 4; ++j) { v0[j] = silu_f(v0[j]); v1[j] = silu_f(v1[j]); } }
                    *(u32x4*)(rowp + bj * 128) = pack8(v0, v1); } }
    }
};
struct EpiPlain {
    static constexpr bool AFTER_DRAIN = false;
    bf16_t* O; int ld;
    __device__ __forceinline__ void operator()(const AccT& acc, const Unit& u, int wr, int wc, int fr, int fq) const {
        const int row0 = u.pm * 256 + wr * 64 + fr; const int col0 = u.pn * 256 + wc * 32 + 8 * fq;
#pragma unroll
        for (int ai = 0; ai < 2; ++ai)
#pragma unroll
            for (int m = 0; m < 4; ++m) { bf16_t* rowp = O + (size_t)(row0 + ai * 128 + m * 16) * ld + col0;
#pragma unroll
                for (int bj = 0; bj < 2; ++bj) *(u32x4*)(rowp + bj * 128) = pack8(acc[ai][bj][m][0], acc[ai][bj][m][1]); }
    }
};
struct EpiResid {
    static constexpr bool AFTER_DRAIN = true;
    const float* base; float* out; bf16_t* hn; bf16_t* halo; const float* gain; float* ssq;
    __device__ __forceinline__ void fused(AccT& acc, const Unit& u, int wr, int wc, int fr, int fq, LAS unsigned char* lds, int wid, int lane) const {
        asm volatile("" : "+v"(fr), "+v"(fq));
        LAS float* P = (LAS float*)lds;
        const int col0 = u.pn * 256 + wc * 32 + 8 * fq;
#pragma unroll
        for (int ai = 0; ai < 2; ++ai)
#pragma unroll
            for (int m = 0; m < 4; ++m) { const int rl = ai * 128 + wr * 64 + m * 16 + fr; const int row = u.pm * 256 + rl; const size_t off = (size_t)row * D + col0;
                float ss = 0.f;
                bf16_t* hrow = nullptr;
                if (halo) { const int r6 = row & 63; if (r6 >= 62) { if ((row >> 6) <= 126) hrow = halo + (size_t)(4 * (row >> 6) + (row & 1)) * D; } else if (r6 < 2 && row >= 64) hrow = halo + (size_t)(4 * ((row >> 6) - 1) + 2 + (row & 1)) * D; }
#pragma unroll
                for (int bj = 0; bj < 2; ++bj) { const f32x4 b0 = *(const f32x4*)(base + off + bj * 128), b1 = *(const f32x4*)(base + off + bj * 128 + 4);
                    const f32x4 v0 = acc[ai][bj][m][0] + b0, v1 = acc[ai][bj][m][1] + b1;
                    *(f32x4*)(out + off + bj * 128) = v0; *(f32x4*)(out + off + bj * 128 + 4) = v1;
                    ss += (v0[0] * v0[0] + v0[1] * v0[1]) + (v0[2] * v0[2] + v0[3] * v0[3]) + (v1[0] * v1[0] + v1[1] * v1[1]) + (v1[2] * v1[2] + v1[3] * v1[3]);
                    const f32x4 g0 = *(const f32x4*)(gain + col0 + bj * 128), g1 = *(const f32x4*)(gain + col0 + bj * 128 + 4);
                    const u32x4 w = pack8(v0 * g0, v1 * g1);
                    *(u32x4*)(hn + off + bj * 128) = w;
                    if (hrow) *(u32x4*)(hrow + col0 + bj * 128) = w; }
                ss += __shfl_xor(ss, 16); ss += __shfl_xor(ss, 32);
                if (fq == 0) P[rl * 4 + wc] = ss;
                asm volatile("" ::: "memory"); }
        __syncthreads();
        if (threadIdx.x < 256) { const int t = threadIdx.x; ssq[(size_t)(u.pm * 256 + t) * 8 + u.pn] = (P[t * 4 + 0] + P[t * 4 + 1]) + (P[t * 4 + 2] + P[t * 4 + 3]); }
        __syncthreads();
    }
};
struct EpiPle {
    static constexpr bool AFTER_DRAIN = true;
    float* out; const bf16_t* Eb; const float* ssq_in; float* ssq;
    __device__ __forceinline__ void fused(AccT& acc, const Unit& u, int wr, int wc, int fr, int fq, LAS unsigned char* lds, int wid, int lane) const {
        asm volatile("" : "+v"(fr), "+v"(fq));
        LAS float* P = (LAS float*)lds;
        const int col0 = u.pn * 256 + wc * 32 + 8 * fq;
#pragma unroll
        for (int ai = 0; ai < 2; ++ai)
#pragma unroll
            for (int m = 0; m < 4; ++m) { const int rl = ai * 128 + wr * 64 + m * 16 + fr; const int row = u.pm * 256 + rl; const size_t off = (size_t)row * D + col0;
                const f32x4 q0 = *(const f32x4*)(ssq_in + (size_t)row * 8), q1 = *(const f32x4*)(ssq_in + (size_t)row * 8 + 4);
                const float rinv = 1.0f / sqrtf(((q0[0] + q0[1]) + (q0[2] + q0[3]) + (q1[0] + q1[1]) + (q1[2] + q1[3])) * (1.0f / D) + EPS);
                float ss = 0.f;
#pragma unroll
                for (int bj = 0; bj < 2; ++bj) { const f32x4 b0 = *(const f32x4*)(out + off + bj * 128), b1 = *(const f32x4*)(out + off + bj * 128 + 4);
                    const u32x4 ew = *(const u32x4*)(Eb + off + bj * 128);
                    f32x4 e0 = {bflo(ew.x), bfhi(ew.x), bflo(ew.y), bfhi(ew.y)}, e1 = {bflo(ew.z), bfhi(ew.z), bflo(ew.w), bfhi(ew.w)};
                    f32x4 v0, v1;
#pragma unroll
                    for (int j = 0; j < 4; ++j) { v0[j] = b0[j] + fast_sigmoid(acc[ai][bj][m][0][j] * rinv) * e0[j]; v1[j] = b1[j] + fast_sigmoid(acc[ai][bj][m][1][j] * rinv) * e1[j]; }
                    *(f32x4*)(out + off + bj * 128) = v0; *(f32x4*)(out + off + bj * 128 + 4) = v1;
                    ss += (v0[0] * v0[0] + v0[1] * v0[1]) + (v0[2] * v0[2] + v0[3] * v0[3]) + (v1[0] * v1[0] + v1[1] * v1[1]) + (v1[2] * v1[2] + v1[3] * v1[3]); }
                ss += __shfl_xor(ss, 16); ss += __shfl_xor(ss, 32);
                if (fq == 0) P[rl * 4 + wc] = ss;
                asm volatile("" ::: "memory"); }
        __syncthreads();
        if (threadIdx.x < 256) { const int t = threadIdx.x; ssq[(size_t)(u.pm * 256 + t) * 8 + u.pn] = (P[t * 4 + 0] + P[t * 4 + 1]) + (P[t * 4 + 2] + P[t * 4 + 3]); }
        __syncthreads();
    }
};
struct EpiFfn {
    static constexpr bool AFTER_DRAIN = false;
    bf16_t* act; const float* ssq1; const float* cw; const float* cb;
    __device__ __forceinline__ int grow_of(const Unit& u, int rl) const {
        if (u.pm < 32) return u.pm * 256 + rl;
        const int R = (u.pm - 32) * 256 + rl; int q = (R >> 2) + 1; if (q > 127) q = 127; return 64 * q - 2 + (R & 3);
    }
    __device__ __forceinline__ void operator()(AccT& acc, const Unit& u, int wr, int wc, int fr, int fq) const {
        asm volatile("" : "+v"(fr), "+v"(fq));
        const bool halo = u.pm >= 32;
        const int lane = fq * 16 + fr;
        const int s1 = (lane & 48) | ((fr + 15) & 15), s2 = (lane & 48) | ((fr + 14) & 15);
#pragma unroll
        for (int ai = 0; ai < 2; ++ai)
#pragma unroll
            for (int m = 0; m < 4; ++m) {
                const int gr = grow_of(u, ai * 128 + wr * 64 + m * 16 + fr);
                const f32x4 q0 = *(const f32x4*)(ssq1 + (size_t)gr * 8), q1 = *(const f32x4*)(ssq1 + (size_t)gr * 8 + 4);
                const float rinv = 1.0f / sqrtf(((q0[0] + q0[1]) + (q0[2] + q0[3]) + (q1[0] + q1[1]) + (q1[2] + q1[3])) * (1.0f / D) + EPS);
#pragma unroll
                for (int bj = 0; bj < 2; ++bj)
#pragma unroll
                    for (int n = 0; n < 2; ++n) acc[ai][bj][m][n] = acc[ai][bj][m][n] * rinv;
                asm volatile("" ::: "memory");
            }
#pragma unroll
        for (int n = 0; n < 2; ++n) {
            const int gc = u.pn * 128 + wc * 32 + 8 * fq + 4 * n;
#pragma unroll
            for (int bj = 0; bj < 2; ++bj) {
                const int cc = bj * DFF + gc;
                asm volatile("" ::: "memory");
                const f32x4 w0 = *(const f32x4*)(cw + cc), w1 = *(const f32x4*)(cw + 2 * DFF + cc), w2 = *(const f32x4*)(cw + 4 * DFF + cc), bb = *(const f32x4*)(cb + cc);
#pragma unroll
                for (int ai = 0; ai < 2; ++ai) {
                    f32x4 p1 = {0.f, 0.f, 0.f, 0.f}, p2 = p1;
#pragma unroll
                    for (int m = 0; m < 4; ++m) {
                        f32x4 v = acc[ai][bj][m][n];
                        asm volatile("" : "+v"(v));
                        f32x4 r1, r2, hh;
#pragma unroll
                        for (int j = 0; j < 4; ++j) { r1[j] = __shfl(v[j], s1); r2[j] = __shfl(v[j], s2); }
#pragma unroll
                        for (int j = 0; j < 4; ++j) { const float x1 = fr >= 1 ? r1[j] : p1[j], x2 = fr >= 2 ? r2[j] : p2[j]; hh[j] = bb[j] + w2[j] * v[j] + w1[j] * x1 + w0[j] * x2; }
                        asm volatile("" : "+v"(hh));
                        acc[ai][bj][m][n] = hh; p1 = r1; p2 = r2;
                    }
                }
            }
            asm volatile("" ::: "memory");
#pragma unroll
            for (int ai = 0; ai < 2; ++ai)
#pragma unroll
                for (int m = 0; m < 4; ++m) {
                    const int rl = ai * 128 + wr * 64 + m * 16 + fr;
                    bool st;
                    if (!halo) st = !(m == 0 && fr < 2) || (u.pm == 0 && ai == 0 && wr == 0);
                    else st = ((fr & 3) >= 2) && ((((u.pm - 32) * 256 + rl) >> 2) + 1 <= 127);
                    if (st) { const f32x4 hg_ = acc[ai][0][m][n], hu_ = acc[ai][1][m][n];
                        u32x2 w; w.x = cvt_pk_bf16(silu_f(hg_[0]) * hu_[0], silu_f(hg_[1]) * hu_[1]); w.y = cvt_pk_bf16(silu_f(hg_[2]) * hu_[2], silu_f(hg_[3]) * hu_[3]);
                        *(u32x2*)(act + (size_t)grow_of(u, rl) * DFF + gc) = w; }
                }
        }
    }
};

struct Ctx {
    LAS unsigned char* lds;
    int tid, lane, wave, nb, bid;
    const float* const* in;
    float* out;
    unsigned char* ws;
};

template <int MODE>
__device__ __forceinline__ void prep_w_item(const float* __restrict__ W, int K, int N, bf16_t* __restrict__ Wt, int item, int lane) {
    const int nkb = K / 64, nb = item / nkb, kb = item % nkb;
    const int n4 = nb * 256 + lane * 4; if (n4 >= N) return;
    int orow = n4;
    if (MODE == 1) orow = (n4 < DFF) ? 256 * (n4 >> 7) + (n4 & 127) : 256 * ((n4 - DFF) >> 7) + 128 + ((n4 - DFF) & 127);
    const float* src = W + (size_t)(kb * 64) * N + n4;
    bf16_t* dst = Wt + (size_t)orow * K + kb * 64;
#pragma unroll 1
    for (int half = 0; half < 2; ++half) {
        f32x4 v[32];
#pragma unroll
        for (int j = 0; j < 32; ++j) v[j] = __builtin_nontemporal_load((const f32x4*)(src + (size_t)(half * 32 + j) * N));
#pragma unroll
        for (int q = 0; q < 4; ++q)
#pragma unroll
            for (int e = 0; e < 4; ++e) { u32x4 o; o.x = pk2(v[8 * e][q], v[8 * e + 1][q]); o.y = pk2(v[8 * e + 2][q], v[8 * e + 3][q]); o.z = pk2(v[8 * e + 4][q], v[8 * e + 5][q]); o.w = pk2(v[8 * e + 6][q], v[8 * e + 7][q]);
                *(u32x4*)(dst + (size_t)q * K + half * 32 + e * 8) = o; }
    }
}
__device__ __forceinline__ void phase_prep(const Ctx& c) {
    const int gw = c.bid * 8 + c.wave, NGW = c.nb * 8;
    const float* w_in = c.in[3]; const float* w_out = c.in[15]; const float* w_up = c.in[17]; const float* w_dn = c.in[20]; const float* w_pg = c.in[22]; const float* w_ple = c.in[23];
    constexpr int I_IN = 41 * (D / 64), I_OUT = 8 * (DMIX / 64), I_UP = 44 * (D / 64), I_DN = 8 * (DFF / 64), I_PG = 8 * (D / 64), I_PLE = 8 * (DPLE / 64);
    constexpr int NIT = I_IN + I_OUT + I_UP + I_DN + I_PG + I_PLE;
    for (int it = gw; it < NIT; it += NGW) {
        int r = it;
        if (r < I_IN) { prep_w_item<0>(w_in, D, DIN, (bf16_t*)(c.ws + WS_WIN), r, c.lane); continue; } r -= I_IN;
        if (r < I_UP) { prep_w_item<1>(w_up, D, 2 * DFF, (bf16_t*)(c.ws + WS_WUP), r, c.lane); continue; } r -= I_UP;
        if (r < I_OUT) { prep_w_item<0>(w_out, DMIX, D, (bf16_t*)(c.ws + WS_WOUT), r, c.lane); continue; } r -= I_OUT;
        if (r < I_DN) { prep_w_item<0>(w_dn, DFF, D, (bf16_t*)(c.ws + WS_WDN), r, c.lane); continue; } r -= I_DN;
        if (r < I_PG) { prep_w_item<0>(w_pg, D, D, (bf16_t*)(c.ws + WS_WPG), r, c.lane); continue; } r -= I_PG;
        prep_w_item<0>(w_ple, DPLE, D, (bf16_t*)(c.ws + WS_WPLE), r, c.lane);
    }
    const float* x = c.in[0]; const float* g = c.in[2]; bf16_t* A = (bf16_t*)(c.ws + WS_A);
    for (int m = gw * 2; m < S; m += NGW * 2) {
        const float* xr = x + (size_t)m * D + 8 * c.lane; f32x4 v[2][4][2]; float s0 = 0.f, s1 = 0.f;
#pragma unroll
        for (int rr = 0; rr < 2; ++rr)
#pragma unroll
            for (int j = 0; j < 4; ++j) { v[rr][j][0] = __builtin_nontemporal_load((const f32x4*)(xr + (size_t)rr * D + 512 * j)); v[rr][j][1] = __builtin_nontemporal_load((const f32x4*)(xr + (size_t)rr * D + 512 * j + 4)); }
#pragma unroll
        for (int j = 0; j < 4; ++j)
#pragma unroll
            for (int e = 0; e < 4; ++e) { s0 += v[0][j][0][e] * v[0][j][0][e] + v[0][j][1][e] * v[0][j][1][e]; s1 += v[1][j][0][e] * v[1][j][0][e] + v[1][j][1][e] * v[1][j][1][e]; }
#pragma unroll
        for (int o = 1; o < 64; o <<= 1) { s0 += __shfl_xor(s0, o); s1 += __shfl_xor(s1, o); }
        const float ri[2] = {1.0f / sqrtf(s0 * (1.0f / D) + EPS), 1.0f / sqrtf(s1 * (1.0f / D) + EPS)};
#pragma unroll
        for (int j = 0; j < 4; ++j) { const f32x4 g0 = *(const f32x4*)(g + 8 * c.lane + 512 * j), g1 = *(const f32x4*)(g + 8 * c.lane + 512 * j + 4);
#pragma unroll
            for (int rr = 0; rr < 2; ++rr) { const f32x4 a0 = v[rr][j][0] * ri[rr] * g0, a1 = v[rr][j][1] * ri[rr] * g1;
                u32x4 o; o.x = pk2(a0[0], a0[1]); o.y = pk2(a0[2], a0[3]); o.z = pk2(a1[0], a1[1]); o.w = pk2(a1[2], a1[3]);
                *(u32x4*)(A + (size_t)(m + rr) * D + 8 * c.lane + 512 * j) = o; } }
    }
    const float* p = c.in[1]; bf16_t* P16 = (bf16_t*)(c.ws + WS_P16);
    for (size_t i = ((size_t)c.bid * 512 + c.tid) * 8; i < (size_t)S * DPLE; i += (size_t)c.nb * 512 * 8) {
        const f32x4 a0 = *(const f32x4*)(p + i), a1 = *(const f32x4*)(p + i + 4);
        u32x4 o; o.x = pk2(a0[0], a0[1]); o.y = pk2(a0[2], a0[3]); o.z = pk2(a1[0], a1[1]); o.w = pk2(a1[2], a1[3]);
        *(u32x4*)(P16 + i) = o;
    }
}

__device__ __forceinline__ void phase_dt(const Ctx& c) {
    const bf16_t* A = (const bf16_t*)(c.ws + WS_A); const bf16_t* Wdt = (const bf16_t*)(c.ws + WS_WIN) + (size_t)10240 * D;
    float* dt = (float*)(c.ws + WS_DT); const float* dtb = c.in[11];
    LAS float* red = (LAS float*)c.lds;
    const int r = c.lane & 31, h = c.lane >> 5;
    for (int item = c.bid; item < S / 32; item += c.nb) {
        const int row0 = item * 32;
        f32x16 acc; for (int i = 0; i < 16; ++i) acc[i] = 0.f;
        const bf16_t* ap = A + (size_t)(row0 + r) * D + c.wave * 256 + 8 * h;
        const bf16_t* bp = Wdt + (size_t)r * D + c.wave * 256 + 8 * h;
#pragma unroll 4
        for (int s = 0; s < 16; ++s) { const bf16x8 af = *(const bf16x8*)(ap + 16 * s), bfr = *(const bf16x8*)(bp + 16 * s);
            acc = __builtin_amdgcn_mfma_f32_32x32x16_bf16(af, bfr, acc, 0, 0, 0); }
#pragma unroll
        for (int i = 0; i < 16; ++i) red[(c.wave * 32 + ((i & 3) + 8 * (i >> 2) + 4 * h)) * 32 + r] = acc[i];
        __syncthreads();
        for (int o = c.tid; o < 1024; o += 512) { float s = 0.f;
#pragma unroll
            for (int w = 0; w < 8; ++w) s += red[w * 1024 + o];
            const int hd = o & 31; const float xv = s + dtb[hd];
            const float sp = xv > 20.f ? xv : log1pf(__expf(xv));
            dt[(size_t)(row0 + (o >> 5)) * 32 + hd] = sp; }
        __syncthreads();
    }
}

template <int W>
__device__ __forceinline__ void stage_conv_tile(const Ctx& c, LAS unsigned char* dst, int pitchB, int col0, int t0, const LAS float* scale) {
    const bf16_t* xbc = (const bf16_t*)(c.ws + WS_XBC); const float* cw = c.in[9]; const float* cb = c.in[10];
    constexpr int NCHK = W / 8, NGRPS = 512 / NCHK, RPT = 128 / NGRPS;
    const int ch = c.tid % NCHK, grp = c.tid / NCHK; const int cc = col0 + ch * 8;
    float w[4][8], b[8];
#pragma unroll
    for (int k = 0; k < 4; ++k) { const f32x4 a0 = *(const f32x4*)(cw + (size_t)k * DXBC + cc), a1 = *(const f32x4*)(cw + (size_t)k * DXBC + cc + 4);
#pragma unroll
        for (int e = 0; e < 4; ++e) { w[k][e] = a0[e]; w[k][4 + e] = a1[e]; } }
    { const f32x4 a0 = *(const f32x4*)(cb + cc), a1 = *(const f32x4*)(cb + cc + 4);
#pragma unroll
      for (int e = 0; e < 4; ++e) { b[e] = a0[e]; b[4 + e] = a1[e]; } }
    const int r0 = grp * RPT;
    float x0[8], x1[8], x2[8];
#pragma unroll
    for (int e = 0; e < 8; ++e) { x0[e] = 0.f; x1[e] = 0.f; x2[e] = 0.f; }
    {
        const int t = t0 + r0;
        if (t - 3 >= 0) { const u32x4 q = *(const u32x4*)(xbc + (size_t)(t - 3) * DXBC + cc); x0[0] = bflo(q.x); x0[1] = bfhi(q.x); x0[2] = bflo(q.y); x0[3] = bfhi(q.y); x0[4] = bflo(q.z); x0[5] = bfhi(q.z); x0[6] = bflo(q.w); x0[7] = bfhi(q.w); }
        if (t - 2 >= 0) { const u32x4 q = *(const u32x4*)(xbc + (size_t)(t - 2) * DXBC + cc); x1[0] = bflo(q.x); x1[1] = bfhi(q.x); x1[2] = bflo(q.y); x1[3] = bfhi(q.y); x1[4] = bflo(q.z); x1[5] = bfhi(q.z); x1[6] = bflo(q.w); x1[7] = bfhi(q.w); }
        if (t - 1 >= 0) { const u32x4 q = *(const u32x4*)(xbc + (size_t)(t - 1) * DXBC + cc); x2[0] = bflo(q.x); x2[1] = bfhi(q.x); x2[2] = bflo(q.y); x2[3] = bfhi(q.y); x2[4] = bflo(q.z); x2[5] = bfhi(q.z); x2[6] = bflo(q.w); x2[7] = bfhi(q.w); }
    }
#pragma unroll
    for (int i = 0; i < RPT; ++i) {
        const int rl = r0 + i, t = t0 + rl;
        const u32x4 q = *(const u32x4*)(xbc + (size_t)t * DXBC + cc);
        float x3[8]; x3[0] = bflo(q.x); x3[1] = bfhi(q.x); x3[2] = bflo(q.y); x3[3] = bfhi(q.y); x3[4] = bflo(q.z); x3[5] = bfhi(q.z); x3[6] = bflo(q.w); x3[7] = bfhi(q.w);
        float sc = 1.f; if (scale) sc = scale[rl * 4 + (ch * 8) / 64];
        float o[8];
#pragma unroll
        for (int e = 0; e < 8; ++e) { const float hsum = b[e] + w[0][e] * x0[e] + w[1][e] * x1[e] + w[2][e] * x2[e] + w[3][e] * x3[e]; o[e] = silu_f(hsum) * sc; x0[e] = x1[e]; x1[e] = x2[e]; x2[e] = x3[e]; }
        u32x4 ov; ov.x = pk2(o[0], o[1]); ov.y = pk2(o[2], o[3]); ov.z = pk2(o[4], o[5]); ov.w = pk2(o[6], o[7]);
        *(LAS u32x4*)(dst + rl * pitchB + ch * 16) = ov;
    }
}

__device__ __forceinline__ void ssd_tables(const Ctx& c, int ck, int g, LAS float* sdt, LAS float* sacs) {
    const float* dt = (const float*)(c.ws + WS_DT); const float* alog = c.in[12];
    { const int l = c.tid >> 2, h = c.tid & 3; const float dv = dt[(size_t)(ck * 128 + l) * 32 + g * 4 + h]; sdt[l * 4 + h] = dv; sacs[l * 4 + h] = dv * (-__expf(alog[g * 4 + h])); }
    __syncthreads();
    if (c.wave < 4) { const int h = c.wave; const float v0 = sacs[(2 * c.lane) * 4 + h], v1 = sacs[(2 * c.lane + 1) * 4 + h]; float s = v0 + v1;
#pragma unroll
        for (int d = 1; d < 64; d <<= 1) { const float t = __shfl_up(s, d); if (c.lane >= d) s += t; }
        const float ex = s - (v0 + v1);
        sacs[(2 * c.lane) * 4 + h] = ex + v0; sacs[(2 * c.lane + 1) * 4 + h] = s; }
    __syncthreads();
}

constexpr int XS_PITCH = 576, BC_PITCH = 320;
constexpr int L_XS = 0, L_B = 128 * XS_PITCH, L_C = L_B + 128 * BC_PITCH, L_TAB = L_C + 128 * BC_PITCH;
constexpr int L_SDT = L_TAB, L_SACS = L_TAB + 2048, L_SW = L_TAB + 4096, L_MISC = L_TAB + 6144;
static_assert(L_MISC + 2048 <= LDS_BYTES, "mixer LDS map");

__device__ __forceinline__ void ssd_a_item(const Ctx& c, int ck, int g) {
    LAS float* sdt = (LAS float*)(c.lds + L_SDT); LAS float* sacs = (LAS float*)(c.lds + L_SACS); LAS float* sw = (LAS float*)(c.lds + L_SW);
    ssd_tables(c, ck, g, sdt, sacs);
    { const int l = c.tid >> 2, h = c.tid & 3; sw[l * 4 + h] = sdt[l * 4 + h] * __expf(sacs[127 * 4 + h] - sacs[l * 4 + h]); }
    if (c.tid < 4) ((float*)(c.ws + WS_CDEC))[ck * 32 + g * 4 + c.tid] = __expf(sacs[127 * 4 + c.tid]);
    __syncthreads();
    stage_conv_tile<256>(c, c.lds + L_XS, XS_PITCH, g * 256, ck * 128, sw);
    stage_conv_tile<128>(c, c.lds + L_B, BC_PITCH, DSSM + g * 128, ck * 128, nullptr);
    __syncthreads();
    bf16_t* st = (bf16_t*)(c.ws + WS_ST) + (size_t)(ck * 32 + g * 4) * 64 * 128;
    for (int o = c.tid; o < 4 * 64 * 128; o += 512) { const int n = o & 127, hp = o >> 7; float s = 0.f;
        for (int l = 0; l < 128; ++l) s += bf2f(*(LAS bf16_t*)(c.lds + L_B + l * BC_PITCH + n * 2)) * bf2f(*(LAS bf16_t*)(c.lds + L_XS + l * XS_PITCH + hp * 2));
        st[o] = (bf16_t)f2bf(s); }
    __syncthreads();
}

__device__ __forceinline__ void gmlp_item(const Ctx& c, int ck, int g) {
    bf16_t* uv = (bf16_t*)(c.ws + WS_UV);
    LAS float* vn = (LAS float*)c.lds;
    LAS float* ssq = (LAS float*)(c.lds + 65536);
    const float* lng = c.in[4] + g * 128; const float* lnb = c.in[5] + g * 128; const float* Ws = c.in[6] + (size_t)g * 128 * 128; const float* bs = c.in[7] + g * 128; const float* nag = c.in[8] + g * 128;
    for (int s = c.wave; s < 128; s += 8) {
        const bf16_t* vr = uv + (size_t)(ck * 128 + s) * DMIX + DA + g * 128;
        const float a0 = bf2f(vr[c.lane]), a1 = bf2f(vr[c.lane + 64]);
        const float mu = wave_sum(a0 + a1) * (1.0f / 128.0f); const float d0 = a0 - mu, d1 = a1 - mu;
        const float var = wave_sum(d0 * d0 + d1 * d1) * (1.0f / 128.0f); const float rs = 1.0f / sqrtf(var + EPS);
        vn[s * 128 + c.lane] = d0 * rs * lng[c.lane] + lnb[c.lane]; vn[s * 128 + c.lane + 64] = d1 * rs * lng[c.lane + 64] + lnb[c.lane + 64];
    }
    __syncthreads();
    const int d = c.tid & 127;
    for (int j = 0; j < 32; ++j) {
        const int t = (c.tid >> 7) + 4 * j; float sg = bs[t]; const float* wr_ = Ws + t * 128;
        for (int s = 0; s <= t; ++s) sg += wr_[s] * vn[s * 128 + d];
        bf16_t* up = uv + (size_t)(ck * 128 + t) * DMIX + g * 128 + d;
        const float y = bf2f(*up) * sg;
        *up = (bf16_t)f2bf(y * nag[d]);
        const float q = wave_sum(y * y);
        if (c.lane == 0) ssq[t * 2 + (c.wave & 1)] = q;
    }
    __syncthreads();
    if (c.tid < 128) ((float*)(c.ws + WS_SSQA))[(size_t)(ck * 128 + c.tid) * 16 + g] = ssq[c.tid * 2] + ssq[c.tid * 2 + 1];
    __syncthreads();
}

typedef short s16x4 __attribute__((ext_vector_type(4)));
typedef short v4i16_t __attribute__((ext_vector_type(4)));
__device__ __forceinline__ s16x4 ds_tr(LAS const unsigned char* p) { return __builtin_bit_cast(s16x4, __builtin_amdgcn_ds_read_tr16_b64_v4i16((LAS v4i16_t*)p)); }
__device__ __forceinline__ bf16x8 frag_tr(LAS const unsigned char* tile, int pitch, int k0, int c0, int lane) {
    const int hh = lane >> 5, blk = (lane >> 4) & 1, q = (lane & 15) >> 2, p = lane & 3;
    LAS const unsigned char* a = tile + (k0 + 8 * hh + q) * pitch + (c0 + 16 * blk + 4 * p) * 2;
    const s16x4 lo = ds_tr(a), hi = ds_tr(a + 4 * pitch);
    return __builtin_shufflevector(lo, hi, 0, 1, 2, 3, 4, 5, 6, 7);
}
__device__ __forceinline__ bf16x8 frag_tr_perm(LAS const unsigned char* tile, int pitch, int k0, int c0, int lane) {
    const int hh = lane >> 5, blk = (lane >> 4) & 1, q = (lane & 15) >> 2, p = lane & 3;
    LAS const unsigned char* a = tile + (k0 + 4 * hh + q) * pitch + (c0 + 16 * blk + 4 * p) * 2;
    const s16x4 lo = ds_tr(a), hi = ds_tr(a + 8 * pitch);
    return __builtin_shufflevector(lo, hi, 0, 1, 2, 3, 4, 5, 6, 7);
}
__device__ __forceinline__ bf16x8 frag_row(LAS const unsigned char* tile, int pitch, int r0, int k0, int lane) {
    return *(LAS const bf16x8*)(tile + (r0 + (lane & 31)) * pitch + (k0 + 8 * (lane >> 5)) * 2);
}
__device__ __forceinline__ bf16x8 pack_frag(const float* v) {
    u32x4 w; w.x = cvt_pk_bf16(v[0], v[1]); w.y = cvt_pk_bf16(v[2], v[3]); w.z = cvt_pk_bf16(v[4], v[5]); w.w = cvt_pk_bf16(v[6], v[7]);
    return __builtin_bit_cast(bf16x8, w);
}
#define MFMA32(a, b, c) __builtin_amdgcn_mfma_f32_32x32x16_bf16((a), (b), (c), 0, 0, 0)

constexpr int G_WP = 272, G_VP = 320, GL_WS = 0, GL_VT = 128 * G_WP, GL_PART = GL_VT + 128 * G_VP;
__device__ __forceinline__ void gmlp_stage_ws(const Ctx& c, int g) {
    const float* Ws = c.in[6] + (size_t)g * 128 * 128;
#pragma unroll
    for (int i = 0; i < 4; ++i) { const int idx = c.tid + 512 * i, t = idx >> 4, s8 = (idx & 15) * 8;
        const f32x4 w0 = *(const f32x4*)(Ws + t * 128 + s8), w1 = *(const f32x4*)(Ws + t * 128 + s8 + 4);
        float wv[8];
#pragma unroll
        for (int j = 0; j < 4; ++j) { wv[j] = (s8 + j <= t) ? w0[j] : 0.f; wv[4 + j] = (s8 + 4 + j <= t) ? w1[j] : 0.f; }
        *(LAS bf16x8*)(c.lds + GL_WS + t * G_WP + s8 * 2) = pack_frag(wv); }
}
__device__ __forceinline__ void gmlp_load_v(const Ctx& c, int ck, int g, u32x4 (&vr)[4]) {
    const bf16_t* uv = (const bf16_t*)(c.ws + WS_UV);
#pragma unroll
    for (int i = 0; i < 4; ++i) { const int row = (c.tid >> 4) + 32 * i; vr[i] = *(const u32x4*)(uv + (size_t)(ck * 128 + row) * DMIX + DA + g * 128 + (c.tid & 15) * 8); }
}
__device__ __forceinline__ void gmlp_items(const Ctx& c, int g, int ck0, int ckstep, int nitems) {
    bf16_t* uv = (bf16_t*)(c.ws + WS_UV);
    LAS unsigned char* vt = c.lds + GL_VT; LAS float* part = (LAS float*)(c.lds + GL_PART);
    const float* lng = c.in[4] + g * 128; const float* lnb = c.in[5] + g * 128; const float* bs = c.in[7] + g * 128; const float* nag = c.in[8] + g * 128;
    const int lane = c.lane, d8 = (c.tid & 15) * 8;
    gmlp_stage_ws(c, g);
    const f32x4 lg0 = *(const f32x4*)(lng + d8), lg1 = *(const f32x4*)(lng + d8 + 4), lb0 = *(const f32x4*)(lnb + d8), lb1 = *(const f32x4*)(lnb + d8 + 4);
    u32x4 vr[4];
    gmlp_load_v(c, ck0, g, vr);
    const int db = c.wave & 3, hh = lane >> 5, r = lane & 31;
    for (int it = 0; it < nitems; ++it) {
        const int ck = ck0 + it * ckstep;
#pragma unroll
        for (int i = 0; i < 4; ++i) { const int row = (c.tid >> 4) + 32 * i;
            float x[8] = {bflo(vr[i].x), bfhi(vr[i].x), bflo(vr[i].y), bfhi(vr[i].y), bflo(vr[i].z), bfhi(vr[i].z), bflo(vr[i].w), bfhi(vr[i].w)};
            float s1 = 0.f, s2 = 0.f;
#pragma unroll
            for (int j = 0; j < 8; ++j) { s1 += x[j]; s2 += x[j] * x[j]; }
#pragma unroll
            for (int o = 1; o < 16; o <<= 1) { s1 += __shfl_xor(s1, o); s2 += __shfl_xor(s2, o); }
            const float mu = s1 * (1.0f / 128.0f); const float var = fmaxf(s2 * (1.0f / 128.0f) - mu * mu, 0.f); const float rs = 1.0f / sqrtf(var + EPS);
            float y[8];
#pragma unroll
            for (int j = 0; j < 4; ++j) { y[j] = (x[j] - mu) * rs * lg0[j] + lb0[j]; y[4 + j] = (x[4 + j] - mu) * rs * lg1[j] + lb1[j]; }
            *(LAS bf16x8*)(vt + row * G_VP + d8 * 2) = pack_frag(y); }
        __syncthreads();
        u32x2 uw[2][4];
#pragma unroll
        for (int tt = 0; tt < 2; ++tt) { const int tb = (c.wave < 4) ? (tt ? 3 : 0) : (tt ? 2 : 1);
            const bf16_t* urow = uv + (size_t)(ck * 128 + tb * 32 + r) * DMIX + g * 128 + db * 32;
#pragma unroll
            for (int gq = 0; gq < 4; ++gq) uw[tt][gq] = *(const u32x2*)(urow + 8 * gq + 4 * hh); }
        if (it + 1 < nitems) gmlp_load_v(c, ck + ckstep, g, vr);
#pragma unroll
        for (int tt = 0; tt < 2; ++tt) {
            const int tb = (c.wave < 4) ? (tt ? 3 : 0) : (tt ? 2 : 1);
            f32x16 acc; for (int i = 0; i < 16; ++i) acc[i] = 0.f;
            const int t = tb * 32 + r;
            for (int ks = 0; ks < 2 * (tb + 1); ++ks)
                acc = MFMA32(frag_tr(vt, G_VP, 16 * ks, db * 32, lane), frag_row(c.lds + GL_WS, G_WP, tb * 32, 16 * ks, lane), acc);
            const float bst = bs[t];
            bf16_t* urow = uv + (size_t)(ck * 128 + t) * DMIX + g * 128 + db * 32;
            float ss = 0.f;
#pragma unroll
            for (int gq = 0; gq < 4; ++gq) {
                const int dl = 8 * gq + 4 * hh;
                const f32x4 na = *(const f32x4*)(nag + db * 32 + dl);
                const float y0 = bflo(uw[tt][gq].x) * (acc[4 * gq] + bst), y1 = bfhi(uw[tt][gq].x) * (acc[4 * gq + 1] + bst), y2 = bflo(uw[tt][gq].y) * (acc[4 * gq + 2] + bst), y3 = bfhi(uw[tt][gq].y) * (acc[4 * gq + 3] + bst);
                ss += (y0 * y0 + y1 * y1) + (y2 * y2 + y3 * y3);
                u32x2 o; o.x = pk2(y0 * na[0], y1 * na[1]); o.y = pk2(y2 * na[2], y3 * na[3]);
                *(u32x2*)(urow + dl) = o;
            }
            ss += __shfl_xor(ss, 32);
            if (hh == 0) part[t * 4 + db] = ss;
        }
        __syncthreads();
        if (c.tid < 128) ((float*)(c.ws + WS_SSQA))[(size_t)(ck * 128 + c.tid) * 16 + g] = (part[c.tid * 4] + part[c.tid * 4 + 1]) + (part[c.tid * 4 + 2] + part[c.tid * 4 + 3]);
    }
    __syncthreads();
}

__device__ __forceinline__ void ssd_a_item_mfma(const Ctx& c, int ck, int g) {
    LAS float* sdt = (LAS float*)(c.lds + L_SDT); LAS float* sacs = (LAS float*)(c.lds + L_SACS); LAS float* sw = (LAS float*)(c.lds + L_SW);
    ssd_tables(c, ck, g, sdt, sacs);
    { const int l = c.tid >> 2, h = c.tid & 3; sw[l * 4 + h] = sdt[l * 4 + h] * __expf(sacs[127 * 4 + h] - sacs[l * 4 + h]); }
    if (c.tid < 4) ((float*)(c.ws + WS_CDEC))[ck * 32 + g * 4 + c.tid] = __expf(sacs[127 * 4 + c.tid]);
    __syncthreads();
    stage_conv_tile<256>(c, c.lds + L_XS, XS_PITCH, g * 256, ck * 128, sw);
    stage_conv_tile<128>(c, c.lds + L_B, BC_PITCH, DSSM + g * 128, ck * 128, nullptr);
    __syncthreads();
    const int lane = c.lane, h = c.wave >> 1, pb = c.wave & 1, hh = lane >> 5, r = lane & 31;
    f32x16 acc[4];
#pragma unroll
    for (int nb = 0; nb < 4; ++nb) for (int i = 0; i < 16; ++i) acc[nb][i] = 0.f;
#pragma unroll 2
    for (int ks = 0; ks < 8; ++ks) {
        const bf16x8 xf = frag_tr(c.lds + L_XS, XS_PITCH, 16 * ks, h * 64 + pb * 32, lane);
#pragma unroll
        for (int nb = 0; nb < 4; ++nb) { const bf16x8 bfg = frag_tr(c.lds + L_B, BC_PITCH, 16 * ks, nb * 32, lane); acc[nb] = MFMA32(bfg, xf, acc[nb]); }
    }
    bf16_t* st = (bf16_t*)(c.ws + WS_ST) + ((size_t)(ck * 32 + g * 4 + h) * 64 + pb * 32 + r) * 128;
#pragma unroll
    for (int nb = 0; nb < 4; ++nb)
#pragma unroll
        for (int gq = 0; gq < 4; ++gq) { u32x2 o; o.x = pk2(acc[nb][4 * gq], acc[nb][4 * gq + 1]); o.y = pk2(acc[nb][4 * gq + 2], acc[nb][4 * gq + 3]);
            *(u32x2*)(st + nb * 32 + 8 * gq + 4 * hh) = o; }
    __syncthreads();
}

constexpr int BC2_PITCH = 272;
__device__ __forceinline__ void ssd_c_item_mfma(const Ctx& c, int ck, int g) {
    LAS float* sdt = (LAS float*)(c.lds + L_SDT); LAS float* sacs = (LAS float*)(c.lds + L_SACS); LAS float* part = (LAS float*)(c.lds + L_SW);
    ssd_tables(c, ck, g, sdt, sacs);
    stage_conv_tile<256>(c, c.lds + L_XS, XS_PITCH, g * 256, ck * 128, nullptr);
    stage_conv_tile<128>(c, c.lds + L_B, BC2_PITCH, DSSM + g * 128, ck * 128, nullptr);
    stage_conv_tile<128>(c, c.lds + L_C, BC2_PITCH, DSSM + NGRP * NST + g * 128, ck * 128, nullptr);
    __syncthreads();
    const int lane = c.lane, h = c.wave >> 1, hh = lane >> 5, r = lane & 31;
    const float Dh = c.in[13][g * 4 + h];
    const bf16_t* hin = (const bf16_t*)(c.ws + WS_ST) + (size_t)(ck * 32 + g * 4 + h) * 64 * 128;
    LAS const unsigned char* xs = c.lds + L_XS; LAS const unsigned char* bt = c.lds + L_B; LAS const unsigned char* ct = c.lds + L_C;
    f32x16 acc[2][2];
#pragma unroll
    for (int lbi = 0; lbi < 2; ++lbi) {
        const int lb = (c.wave & 1) ? (lbi ? 2 : 1) : (lbi ? 3 : 0);
        const int l = lb * 32 + r;
        bf16x8 cf[8];
#pragma unroll
        for (int ks = 0; ks < 8; ++ks) cf[ks] = frag_row(ct, BC2_PITCH, lb * 32, 16 * ks, lane);
        f32x16 a0, a1; for (int i = 0; i < 16; ++i) { a0[i] = 0.f; a1[i] = 0.f; }
#pragma unroll
        for (int ks = 0; ks < 8; ++ks) {
            const bf16x8 h0 = *(const bf16x8*)(hin + (size_t)r * 128 + 16 * ks + 8 * hh), h1 = *(const bf16x8*)(hin + (size_t)(32 + r) * 128 + 16 * ks + 8 * hh);
            a0 = MFMA32(h0, cf[ks], a0); a1 = MFMA32(h1, cf[ks], a1);
        }
        const float al = sacs[l * 4 + h]; const float ea = __expf(al);
        a0 = a0 * ea; a1 = a1 * ea;
        for (int sb = 0; sb <= lb; ++sb) {
            f32x16 X; for (int i = 0; i < 16; ++i) X[i] = 0.f;
#pragma unroll
            for (int ks = 0; ks < 8; ++ks) X = MFMA32(frag_row(bt, BC2_PITCH, sb * 32, 16 * ks, lane), cf[ks], X);
            bf16x8 mf[2];
#pragma unroll
            for (int kk = 0; kk < 2; ++kk) {
                float mv[8];
#pragma unroll
                for (int j = 0; j < 8; ++j) {
                    const int sidx = sb * 32 + 16 * kk + 8 * (j >> 2) + 4 * hh + (j & 3);
                    float v = X[8 * kk + j] * __expf(al - sacs[sidx * 4 + h]) * sdt[sidx * 4 + h];
                    v = (sidx <= l) ? v : 0.f;
                    mv[j] = (sidx == l) ? v + Dh : v;
                }
                mf[kk] = pack_frag(mv);
            }
#pragma unroll
            for (int kk = 0; kk < 2; ++kk) {
                const bf16x8 x0 = frag_tr_perm(xs, XS_PITCH, sb * 32 + 16 * kk, h * 64, lane), x1 = frag_tr_perm(xs, XS_PITCH, sb * 32 + 16 * kk, h * 64 + 32, lane);
                a0 = MFMA32(x0, mf[kk], a0); a1 = MFMA32(x1, mf[kk], a1);
            }
        }
        acc[lbi][0] = a0; acc[lbi][1] = a1;
    }
    const bf16_t* zs = (const bf16_t*)(c.ws + WS_ZS); bf16_t* cat = (bf16_t*)(c.ws + WS_UV); const float* ng = c.in[14] + g * 256 + h * 64;
#pragma unroll
    for (int lbi = 0; lbi < 2; ++lbi) {
        const int lb = (c.wave & 1) ? (lbi ? 2 : 1) : (lbi ? 3 : 0);
        const int l = lb * 32 + r; const size_t row = (size_t)ck * 128 + l;
        float ss = 0.f;
#pragma unroll
        for (int pb = 0; pb < 2; ++pb)
#pragma unroll
            for (int gq = 0; gq < 4; ++gq) { const int p0 = pb * 32 + 8 * gq + 4 * hh;
                const u32x2 zw = *(const u32x2*)(zs + row * DSSM + g * 256 + h * 64 + p0);
                const float y0 = acc[lbi][pb][4 * gq] * bflo(zw.x), y1 = acc[lbi][pb][4 * gq + 1] * bfhi(zw.x), y2 = acc[lbi][pb][4 * gq + 2] * bflo(zw.y), y3 = acc[lbi][pb][4 * gq + 3] * bfhi(zw.y);
                acc[lbi][pb][4 * gq] = y0; acc[lbi][pb][4 * gq + 1] = y1; acc[lbi][pb][4 * gq + 2] = y2; acc[lbi][pb][4 * gq + 3] = y3;
                ss += (y0 * y0 + y1 * y1) + (y2 * y2 + y3 * y3); }
        ss += __shfl_xor(ss, 32);
        if (hh == 0) part[l * 4 + h] = ss;
    }
    __syncthreads();
#pragma unroll
    for (int lbi = 0; lbi < 2; ++lbi) {
        const int lb = (c.wave & 1) ? (lbi ? 2 : 1) : (lbi ? 3 : 0);
        const int l = lb * 32 + r; const size_t row = (size_t)ck * 128 + l;
        const float rinv = 1.0f / sqrtf(((part[l * 4] + part[l * 4 + 1]) + (part[l * 4 + 2] + part[l * 4 + 3])) * (1.0f / 256.0f) + EPS);
#pragma unroll
        for (int pb = 0; pb < 2; ++pb)
#pragma unroll
            for (int gq = 0; gq < 4; ++gq) { const int p0 = pb * 32 + 8 * gq + 4 * hh;
                const f32x4 gg = *(const f32x4*)(ng + p0);
                u32x2 o; o.x = pk2(acc[lbi][pb][4 * gq] * rinv * gg[0], acc[lbi][pb][4 * gq + 1] * rinv * gg[1]); o.y = pk2(acc[lbi][pb][4 * gq + 2] * rinv * gg[2], acc[lbi][pb][4 * gq + 3] * rinv * gg[3]);
                *(u32x2*)(cat + row * DMIX + DA + g * 256 + h * 64 + p0) = o; }
    }
    __syncthreads();
}

#ifndef MIX_GMLP_MFMA
#define MIX_GMLP_MFMA 1
#endif
#ifndef MIX_SSDA_MFMA
#define MIX_SSDA_MFMA 1
#endif
#ifndef MIX_SSDC_MFMA
#define MIX_SSDC_MFMA 1
#endif

__device__ __forceinline__ void phase_mix_a(const Ctx& c) {
    if (MIX_GMLP_MFMA && (c.nb % NGA) == 0 && (NCH * NGA) % c.nb == 0) {
        gmlp_items(c, c.bid & 15, c.bid >> 4, c.nb >> 4, (NCH * NGA) / c.nb);
    } else {
        for (int it = c.bid; it < NCH * NGA; it += c.nb) gmlp_item(c, it >> 4, it & 15);
    }
    for (int it = c.bid; it < NCH * NGRP; it += c.nb) { if (MIX_SSDA_MFMA) ssd_a_item_mfma(c, it >> 3, it & 7); else ssd_a_item(c, it >> 3, it & 7); }
}

__device__ __forceinline__ void phase_scan(const Ctx& c) {
    unsigned* st = (unsigned*)(c.ws + WS_ST); const float* cdec = (const float*)(c.ws + WS_CDEC);
    for (int e = c.bid * 512 + c.tid; e < 32 * 64 * 64; e += c.nb * 512) {
        const int head = e >> 12; float h0 = 0.f, h1 = 0.f;
#pragma unroll 8
        for (int ck = 0; ck < NCH; ++ck) { const size_t idx = (size_t)ck * (32 * 64 * 64) + e; const unsigned w = st[idx]; const float dc = cdec[ck * 32 + head];
            st[idx] = pk2(h0, h1); h0 = dc * h0 + bflo(w); h1 = dc * h1 + bfhi(w); }
    }
    bf16_t* uv = (bf16_t*)(c.ws + WS_UV); const float* sq = (const float*)(c.ws + WS_SSQA);
    for (int i = c.bid * 512 + c.tid; i < S * (DA / 8); i += c.nb * 512) { const int row = i >> 8, ch = i & 255;
        const f32x4 q0 = *(const f32x4*)(sq + row * 16), q1 = *(const f32x4*)(sq + row * 16 + 4), q2 = *(const f32x4*)(sq + row * 16 + 8), q3 = *(const f32x4*)(sq + row * 16 + 12);
        float s = 0.f;
#pragma unroll
        for (int e = 0; e < 4; ++e) s += q0[e] + q1[e] + q2[e] + q3[e];
        const float rinv = 1.0f / sqrtf(s * (1.0f / DA) + EPS);
        u32x4* pp = (u32x4*)(uv + (size_t)row * DMIX + ch * 8); const u32x4 w = *pp; u32x4 o;
        o.x = pk2(bflo(w.x) * rinv, bfhi(w.x) * rinv); o.y = pk2(bflo(w.y) * rinv, bfhi(w.y) * rinv); o.z = pk2(bflo(w.z) * rinv, bfhi(w.z) * rinv); o.w = pk2(bflo(w.w) * rinv, bfhi(w.w) * rinv);
        *pp = o; }
}

__device__ __forceinline__ void ssd_c_item(const Ctx& c, int ck, int g) {
    LAS float* sdt = (LAS float*)(c.lds + L_SDT); LAS float* sacs = (LAS float*)(c.lds + L_SACS); LAS float* part = (LAS float*)(c.lds + L_SW);
    ssd_tables(c, ck, g, sdt, sacs);
    stage_conv_tile<256>(c, c.lds + L_XS, XS_PITCH, g * 256, ck * 128, nullptr);
    stage_conv_tile<128>(c, c.lds + L_B, BC_PITCH, DSSM + g * 128, ck * 128, nullptr);
    stage_conv_tile<128>(c, c.lds + L_C, BC_PITCH, DSSM + NGRP * NST + g * 128, ck * 128, nullptr);
    __syncthreads();
    float* G = (float*)(c.ws + WS_GSCR) + (size_t)c.bid * 16384;
    for (int o = c.tid; o < 16384; o += 512) { const int s = o & 127, l = o >> 7; float a = 0.f;
        if (s <= l) for (int n = 0; n < 128; ++n) a += bf2f(*(LAS bf16_t*)(c.lds + L_C + l * BC_PITCH + n * 2)) * bf2f(*(LAS bf16_t*)(c.lds + L_B + s * BC_PITCH + n * 2));
        __hip_atomic_store(G + o, a, __ATOMIC_RELAXED, __HIP_MEMORY_SCOPE_AGENT); }
    asm volatile("s_waitcnt vmcnt(0)" ::: "memory");
    __syncthreads();
    const bf16_t* hin = (const bf16_t*)(c.ws + WS_ST) + (size_t)(ck * 32 + g * 4) * 64 * 128;
    const bf16_t* zs = (const bf16_t*)(c.ws + WS_ZS); bf16_t* cat = (bf16_t*)(c.ws + WS_UV); const float* dsk = c.in[13]; const float* ng = c.in[14];
    const int hp = c.tid & 255, h = hp >> 6; const float Dh = dsk[g * 4 + h];
    for (int j = 0; j < 64; ++j) { const int l = (c.tid >> 8) + 2 * j; const float al = sacs[l * 4 + h];
        float y = 0.f;
        for (int s = 0; s <= l; ++s) y += __hip_atomic_load(G + l * 128 + s, __ATOMIC_RELAXED, __HIP_MEMORY_SCOPE_AGENT) * __expf(al - sacs[s * 4 + h]) * sdt[s * 4 + h] * bf2f(*(LAS bf16_t*)(c.lds + L_XS + s * XS_PITCH + hp * 2));
        float yo = 0.f;
        for (int n = 0; n < 128; ++n) yo += bf2f(*(LAS bf16_t*)(c.lds + L_C + l * BC_PITCH + n * 2)) * bf2f(hin[hp * 128 + n]);
        y += __expf(al) * yo + Dh * bf2f(*(LAS bf16_t*)(c.lds + L_XS + l * XS_PITCH + hp * 2));
        const size_t row = (size_t)ck * 128 + l;
        y *= bf2f(zs[row * DSSM + g * 256 + hp]);
        const float q = wave_sum(y * y);
        if (c.lane == 0) part[l * 4 + (c.wave & 3)] = q;
        cat[row * DMIX + DA + g * 256 + hp] = (bf16_t)f2bf(y);
    }
    __syncthreads();
    for (int j = 0; j < 64; ++j) { const int l = (c.tid >> 8) + 2 * j; const size_t row = (size_t)ck * 128 + l;
        const float rinv = 1.0f / sqrtf(((part[l * 4] + part[l * 4 + 1]) + (part[l * 4 + 2] + part[l * 4 + 3])) * (1.0f / 256.0f) + EPS);
        bf16_t* pp = cat + row * DMIX + DA + g * 256 + hp;
        *pp = (bf16_t)f2bf(bf2f(*pp) * rinv * ng[g * 256 + hp]); }
    __syncthreads();
}

__device__ __forceinline__ void phase_mix_c(const Ctx& c) {
    for (int it = c.bid; it < NCH * NGRP; it += c.nb) { if (MIX_SSDC_MFMA) ssd_c_item_mfma(c, it >> 3, it & 7); else ssd_c_item(c, it >> 3, it & 7); }
}

__device__ __forceinline__ void phase_final(const Ctx& c) {
    const int gw = c.bid * 8 + c.wave, NGW = c.nb * 8; const float* g = c.in[24]; const float* sq = (const float*)(c.ws + WS_SSQ3);
    for (int m = gw; m < S; m += NGW) {
        const f32x4 q0 = *(const f32x4*)(sq + (size_t)m * 8), q1 = *(const f32x4*)(sq + (size_t)m * 8 + 4);
        const float rinv = 1.0f / sqrtf(((q0[0] + q0[1]) + (q0[2] + q0[3]) + (q1[0] + q1[1]) + (q1[2] + q1[3])) * (1.0f / D) + EPS);
        float* orow = c.out + (size_t)m * D + 4 * c.lane;
#pragma unroll
        for (int j = 0; j < 8; ++j) { const f32x4 v = *(const f32x4*)(orow + 256 * j), gg = *(const f32x4*)(g + 4 * c.lane + 256 * j); *(f32x4*)(orow + 256 * j) = v * rinv * gg; }
    }
}

#define XB_TMO      128
#define XB_XCNT(j)  (256  + 64 * (j))
#define XB_XSUB(j)  (1280 + 64 * (j))
#define XB_XGEN(j)  (2304 + 64 * (j))
#define XB_TOP      3328
#define XB_TOPGEN   3392
#define XCD_BAR_WORDS 3456
#define XB_SPIN_CAP (1u << 20)
__device__ __forceinline__ unsigned xb_ld(unsigned* p)              { return __hip_atomic_load(p, __ATOMIC_RELAXED, __HIP_MEMORY_SCOPE_AGENT); }
__device__ __forceinline__ unsigned xb_add(unsigned* p, unsigned v) { return __hip_atomic_fetch_add(p, v, __ATOMIC_RELAXED, __HIP_MEMORY_SCOPE_AGENT); }
__device__ __forceinline__ unsigned xb_xcc_id() { return (unsigned)__builtin_amdgcn_s_getreg((3 << 11) | 20) & 0xFu; }
#define XB_SPIN(cond, bar) do { unsigned _sp = 0; while (cond) { __builtin_amdgcn_s_sleep(1); \
    if ((++_sp & 255u) == 0u) { if (xb_ld(&(bar)[XB_TMO])) break; if (_sp > XB_SPIN_CAP) { atomicAdd(&(bar)[XB_TMO], 1u); break; } } } } while (0)
struct XcdBarrier { unsigned* bar; unsigned x; volatile LAS unsigned* st; };
__device__ __forceinline__ XcdBarrier xcd_barrier_post(unsigned* bar, volatile LAS unsigned* st) {
    XcdBarrier b; b.bar = bar; b.x = xb_xcc_id(); b.st = st;
    if (threadIdx.x == 0) (void)xb_add(&bar[XB_XCNT(b.x)], 1u);
    return b;
}
__device__ __forceinline__ void xcd_barrier_complete(unsigned* bar, unsigned x, unsigned& nloc, unsigned& nx) {
    const unsigned G = gridDim.x * gridDim.y * gridDim.z;
    unsigned sum, cnt, mine, sp = 0u;
    for (;;) {
        sum = 0u; cnt = 0u; mine = 0u;
#pragma unroll
        for (unsigned j = 0; j < 16; ++j) { const unsigned c = xb_ld(&bar[XB_XCNT(j)]); sum += c; cnt += (c > 0u) ? 1u : 0u; mine = (j == x) ? c : mine; }
        if (sum == G) break;
        __builtin_amdgcn_s_sleep(1);
        if ((++sp & 255u) == 0u) { if (xb_ld(&bar[XB_TMO])) break; if (sp > XB_SPIN_CAP) { atomicAdd(&bar[XB_TMO], 1u); break; } }
    }
    nloc = mine > 0u ? mine : 1u; nx = cnt > 0u ? cnt : 1u;
}
__device__ __forceinline__ void xcd_barrier(const XcdBarrier& b) {
    asm volatile("s_waitcnt vmcnt(0)" ::: "memory");
    __syncthreads();
    if (threadIdx.x == 0) {
        unsigned* bar = b.bar;
        __builtin_amdgcn_s_waitcnt(0);
        unsigned nloc = b.st[0], nx = b.st[1];
        if (nloc == 0u) { xcd_barrier_complete(bar, b.x, nloc, nx); b.st[0] = nloc; b.st[1] = nx; }
        const unsigned old = xb_add(&bar[XB_XSUB(b.x)], 1u);
        const unsigned gen = old / nloc;
        if (old + 1u == (gen + 1u) * nloc) {
            __builtin_amdgcn_fence(__ATOMIC_RELEASE, "agent");
            asm volatile("s_waitcnt vmcnt(0)" ::: "memory");
            const unsigned og = xb_add(&bar[XB_TOP], 1u);
            const unsigned tg = og / nx;
            if (og + 1u == (tg + 1u) * nx) xb_add(&bar[XB_TOPGEN], 1u);
            else XB_SPIN(xb_ld(&bar[XB_TOPGEN]) == tg, bar);
            __builtin_amdgcn_fence(__ATOMIC_ACQUIRE, "agent");
            xb_add(&bar[XB_XGEN(b.x)], 1u);
            asm volatile("s_waitcnt vmcnt(0)" ::: "memory");
        } else {
            XB_SPIN(xb_ld(&bar[XB_XGEN(b.x)]) == gen, bar);
            __builtin_amdgcn_fence(__ATOMIC_ACQUIRE, "agent");
            asm volatile("s_waitcnt vmcnt(0)" ::: "memory");
        }
    }
    __syncthreads();
}

__global__ void __launch_bounds__(512, 2) mega_fwd(Params P, int ph_lo, int ph_hi) {
    extern __shared__ __attribute__((aligned(16))) unsigned char lds_raw[];
    Ctx c;
    c.lds = (LAS unsigned char*)lds_raw; c.tid = threadIdx.x; c.lane = c.tid & 63; c.wave = __builtin_amdgcn_readfirstlane(c.tid >> 6);
    c.nb = gridDim.x; c.bid = blockIdx.x; c.in = P.in; c.out = P.out; c.ws = P.ws;
    unsigned char* ws = P.ws;
    volatile LAS unsigned* bst = (volatile LAS unsigned*)(c.lds + L_MISC);
    if (c.tid < 2) bst[c.tid] = 0u;
    __syncthreads();
    const XcdBarrier xbar = xcd_barrier_post((unsigned*)ws, bst);
#ifndef PH_MASK
#define PH_MASK 0x3ff
#endif
#define IN(k) (((PH_MASK >> (k)) & 1) && ph_lo <= (k) && (k) < ph_hi)
#ifndef CG_SEAM
#define CG_SEAM -1
#endif
#define SEAM(k) do { if (IN(k) && IN((k) + 1)) { if ((k) == CG_SEAM) cg::this_grid().sync(); else xcd_barrier(xbar); } } while (0)
    if (IN(0)) phase_prep(c);
    SEAM(0);
    if (IN(1)) {
        pg8::Gemm g{(const bf16_t*)(ws + WS_A), (const bf16_t*)(ws + WS_WIN), D}; pg8::StaticOrder So; So.init(32, 40, c.nb, c.bid);
        EpiProj E{(bf16_t*)(ws + WS_UV), (bf16_t*)(ws + WS_ZS), (bf16_t*)(ws + WS_XBC)};
        pg8::gemm_phase<EpiProj, true, true>(c.lds, g, So, E);
        phase_dt(c);
    }
    SEAM(1);
    if (IN(2)) phase_mix_a(c);
    SEAM(2);
    if (IN(3)) phase_scan(c);
    SEAM(3);
    if (IN(4)) phase_mix_c(c);
    SEAM(4);
    if (IN(5)) {
        { pg8::Gemm g{(const bf16_t*)(ws + WS_UV), (const bf16_t*)(ws + WS_WOUT), DMIX}; pg8::StaticOrder So; So.init(32, 8, c.nb, c.bid);
          EpiResid E{P.in[0], P.out, (bf16_t*)(ws + WS_HG), (bf16_t*)(ws + WS_HG) + (size_t)S * D, P.in[16], (float*)(ws + WS_SSQ1)};
          pg8::gemm_phase<EpiResid, false, true>(c.lds, g, So, E); }
        { pg8::Gemm g{(const bf16_t*)(ws + WS_P16), (const bf16_t*)(ws + WS_WPLE), DPLE}; pg8::StaticOrder So; So.init(32, 8, c.nb, c.bid);
          EpiPlain E{(bf16_t*)(ws + WS_E), D};
          pg8::gemm_phase<EpiPlain, true, true>(c.lds, g, So, E); }
    }
    SEAM(5);
    if (IN(6)) {
        pg8::Gemm g{(const bf16_t*)(ws + WS_HG), (const bf16_t*)(ws + WS_WUP), D}; pg8::StaticOrder So; So.init(34, 44, c.nb, c.bid);
        EpiFfn E{(bf16_t*)(ws + WS_ACT), (const float*)(ws + WS_SSQ1), P.in[18], P.in[19]};
        pg8::gemm_phase<EpiFfn, true, true>(c.lds, g, So, E);
    }
    SEAM(6);
    if (IN(7)) {
        pg8::Gemm g{(const bf16_t*)(ws + WS_ACT), (const bf16_t*)(ws + WS_WDN), DFF}; pg8::StaticOrder So; So.init(32, 8, c.nb, c.bid);
        EpiResid E{P.out, P.out, (bf16_t*)(ws + WS_H2G), nullptr, P.in[21], (float*)(ws + WS_SSQ2)};
        pg8::gemm_phase<EpiResid, false, true>(c.lds, g, So, E);
    }
    SEAM(7);
    if (IN(8)) {
        pg8::Gemm g{(const bf16_t*)(ws + WS_H2G), (const bf16_t*)(ws + WS_WPG), D}; pg8::StaticOrder So; So.init(32, 8, c.nb, c.bid);
        EpiPle E{P.out, (const bf16_t*)(ws + WS_E), (const float*)(ws + WS_SSQ2), (float*)(ws + WS_SSQ3)};
        pg8::gemm_phase<EpiPle, false, true>(c.lds, g, So, E);
    }
    SEAM(8);
    if (IN(9)) phase_final(c);
#undef IN
#undef SEAM
}

extern "C" void kernel_launch(void* const* d_in, const int* in_sizes, int n_in, void* d_out, int out_size, void* d_ws, size_t ws_size, hipStream_t stream) {
    static int grid = 0;
    if (grid == 0) {
        if (n_in != 25 || out_size != S * D || ws_size < WS_END) { fprintf(stderr, "kernel_launch: unexpected shapes (n_in %d out %d ws %zu)\n", n_in, out_size, ws_size); grid = -1; return; }
        int dev = 0, cus = 0, per_cu = 0;
        (void)hipGetDevice(&dev); (void)hipDeviceGetAttribute(&cus, hipDeviceAttributeMultiprocessorCount, dev);
        if (hipFuncSetAttribute((const void*)mega_fwd, hipFuncAttributeMaxDynamicSharedMemorySize, LDS_BYTES) != hipSuccess) { fprintf(stderr, "kernel_launch: hipFuncSetAttribute failed\n"); grid = -1; return; }
        (void)hipOccupancyMaxActiveBlocksPerMultiprocessor(&per_cu, (const void*)mega_fwd, 512, LDS_BYTES);
        if (per_cu < 1) { fprintf(stderr, "kernel_launch: occupancy query says %d blocks/CU\n", per_cu); per_cu = 1; }
        (void)hipGetLastError();
        grid = cus;
        fprintf(stderr, "kernel_launch: grid %d (cus %d, per_cu %d)\n", grid, cus, per_cu);
    }
    if (grid < 0) return;
    if (hipMemsetAsync(d_ws, 0, 16384, stream) != hipSuccess) { fprintf(stderr, "kernel_launch: memset failed\n"); return; }
    Params P{};
    for (int i = 0; i < 25; ++i) P.in[i] = (const float*)d_in[i];
    P.out = (float*)d_out; P.ws = (unsigned char*)d_ws;
#if MK_LAUNCHES == 1
    int lo = 0, hi = NPH;
    void* args[] = {&P, &lo, &hi};
#if CG_SEAM >= 0
    hipError_t e = hipLaunchCooperativeKernel((const void*)mega_fwd, dim3(grid), dim3(512), args, LDS_BYTES, stream);
#else
    (void)args;
    hipLaunchKernelGGL(mega_fwd, dim3(grid), dim3(512), LDS_BYTES, stream, P, lo, hi);
    hipError_t e = hipPeekAtLastError();
#endif
    if (e != hipSuccess) fprintf(stderr, "kernel_launch: launch failed: %s\n", hipGetErrorString(e));
#else
    for (int k = 0; k < NPH; ++k) {
        int lo = k, hi = k + 1;
        void* args[] = {&P, &lo, &hi};
        hipError_t e = hipLaunchCooperativeKernel((const void*)mega_fwd, dim3(grid), dim3(512), args, LDS_BYTES, stream);
        if (e != hipSuccess) { fprintf(stderr, "kernel_launch: launch %d failed: %s\n", k, hipGetErrorString(e)); break; }
    }
#endif
}
```

```cpp
#include <hip/hip_runtime.h>
#include <hip/hip_cooperative_groups.h>
#include <cstdio>
#include <cstdint>
namespace cg = cooperative_groups;

#ifndef MK_LAUNCHES
#define MK_LAUNCHES 1
#endif

#define LAS __attribute__((address_space(3)))
typedef unsigned short bf16_t;
typedef short bf16x8 __attribute__((ext_vector_type(8)));
typedef float f32x4 __attribute__((ext_vector_type(4)));
typedef float f32x2 __attribute__((ext_vector_type(2)));
typedef float f32x16 __attribute__((ext_vector_type(16)));
typedef unsigned u32x4 __attribute__((ext_vector_type(4)));
typedef unsigned u32x2 __attribute__((ext_vector_type(2)));

constexpr int S = 8192, D = 2048, DIN = 10272, DA = 2048, DSSM = 2048, DXBC = 4096, NH = 32, NGRP = 8, NST = 128;
constexpr int DFF = 5632, DPLE = 256, DMIX = 4096, NCH = 64, CH = 128, NGA = 16;
constexpr float EPS = 1e-6f;
constexpr int NPH = 10;

constexpr size_t MiB = 1u << 20;
constexpr size_t WS_WUP = 1 * MiB;
constexpr size_t WS_WDN = 45 * MiB;
constexpr size_t WS_WPG = 67 * MiB;
constexpr size_t WS_WPLE = 75 * MiB;
constexpr size_t WS_WIN = 76 * MiB;
constexpr size_t WS_WOUT = 117 * MiB;
constexpr size_t WS_UV = 133 * MiB;
constexpr size_t WS_ACT = 133 * MiB;
constexpr size_t WS_ZS = 197 * MiB;
constexpr size_t WS_XBC = 229 * MiB;
constexpr size_t WS_HG = 229 * MiB;
constexpr size_t WS_H2G = 229 * MiB;
constexpr size_t WS_A = 293 * MiB;
constexpr size_t WS_ST = 293 * MiB;
constexpr size_t WS_E = 293 * MiB;
constexpr size_t WS_P16 = 325 * MiB;
constexpr size_t WS_DT = 329 * MiB;
constexpr size_t WS_SSQA = 330 * MiB;
constexpr size_t WS_SSQ1 = 331 * MiB;
constexpr size_t WS_SSQ2 = WS_SSQ1 + 256 * 1024;
constexpr size_t WS_SSQ3 = WS_SSQ2 + 256 * 1024;
constexpr size_t WS_CDEC = WS_SSQ3 + 256 * 1024;
constexpr size_t WS_GSCR = 332 * MiB;
constexpr size_t WS_END = 348 * MiB;

constexpr int LDS_BYTES = 163840;

struct Params {
    const float* in[25];
    float* out;
    unsigned char* ws;
};

__device__ __forceinline__ unsigned f2bf(float f) { unsigned u = __builtin_bit_cast(unsigned, f); return (u + 0x7fffu + ((u >> 16) & 1u)) >> 16; }
__device__ __forceinline__ unsigned pk2(float lo, float hi) { return f2bf(lo) | (f2bf(hi) << 16); }
__device__ __forceinline__ float bf2f(unsigned short b) { return __builtin_bit_cast(float, ((unsigned)b) << 16); }
__device__ __forceinline__ float bflo(unsigned w) { return __builtin_bit_cast(float, w << 16); }
__device__ __forceinline__ float bfhi(unsigned w) { return __builtin_bit_cast(float, w & 0xffff0000u); }
__device__ __forceinline__ float fast_sigmoid(float x) { return __builtin_amdgcn_rcpf(1.0f + __builtin_amdgcn_exp2f(-1.4426950408889634f * x)); }
__device__ __forceinline__ float silu_f(float x) { return x * fast_sigmoid(x); }
__device__ __forceinline__ float gelu_tanh_f(float x) { const float t = x + 0.044715f * x * x * x; return x * __builtin_amdgcn_rcpf(1.0f + __builtin_amdgcn_exp2f(-2.3022081986f * t)); }
__device__ __forceinline__ float wave_sum(float v) {
#pragma unroll
    for (int o = 1; o < 64; o <<= 1) v += __shfl_xor(v, o);
    return v;
}

namespace pg8 {
constexpr int BM = 256, BK = 64, HALF = 128, HTB = HALF * BK * 2, STAGE_BYTES = 8 * HTB, NXCD = 8, WGM = 8;
__host__ __device__ __forceinline__ int lds_byte(int r, int c) { const int st = (r >> 4) * 2 + (c >> 5), rr = r & 15, cc = c & 31, ob = rr * 64 + cc * 2; return st * 1024 + (ob ^ (((ob >> 9) & 1) << 5)); }
__host__ __device__ __forceinline__ void stage_rc(int b, int& R, int& C) { const int st = b / 1024, sb = b % 1024, swz = sb ^ (((sb >> 9) & 1) << 5); R = (st >> 1) * 16 + swz / 64; C = (st & 1) * 32 + (swz % 64) / 2; }
__host__ __device__ __forceinline__ int perm32(int rho) { const int n = rho >> 4, i = rho & 15; return 8 * (i >> 2) + 4 * n + (i & 3); }

struct Unit { int pm, pn; };
struct Gemm { const bf16_t* A; const bf16_t* Bt; int K; };

struct StaticOrder {
    int nM, nN, nwg, G, c;
    __device__ void init(int nM_, int nN_, int G_, int c_) { nM = nM_; nN = nN_; nwg = nM * nN; G = G_; c = c_; }
    __device__ bool next(int i, Unit& u) const {
        const long L = (long)i * G + c; if (L >= nwg) return false;
        int wgid = (int)L; { const int q = nwg / NXCD, r = nwg % NXCD, xcd = wgid % NXCD, off = wgid / NXCD; wgid = (xcd < r ? xcd * (q + 1) : r * (q + 1) + (xcd - r) * q) + off; }
        const int nig = WGM * nN, gid = wgid / nig, fm = gid * WGM, gsz = (nM - fm) < WGM ? (nM - fm) : WGM;
        u.pm = fm + ((wgid % nig) % gsz); u.pn = (wgid % nig) / gsz; return true;
    }
};

__device__ __forceinline__ unsigned cvt_pk_bf16(float lo, float hi) { unsigned r; asm volatile("v_cvt_pk_bf16_f32 %0, %1, %2" : "=v"(r) : "v"(lo), "v"(hi)); return r; }

template <class Epi, bool ALIGN_EPI, bool SP2>
__device__ __forceinline__ void gemm_phase(LAS unsigned char* lds, const Gemm g, const StaticOrder& S, const Epi& E) {
    const int tid = threadIdx.x, wid = __builtin_amdgcn_readfirstlane(tid >> 6), lane = tid & 63, wr = wid >> 2, wc = wid & 3, fr = lane & 15, fq = lane >> 4;
    const int K = g.K, nt = K / BK;
    unsigned voffA[2], voffB[2];
#pragma unroll
    for (int i = 0; i < 2; ++i) { int R, C; stage_rc(tid * 16 + i * 8192, R, C); const int Rb = (R & ~31) + perm32(R & 31);
        voffA[i] = (unsigned)(R * K + C) * 2u; voffB[i] = (unsigned)(Rb * K + C) * 2u; }
    const size_t kstep = (size_t)(BK * 2);
    const size_t hstep = (size_t)HALF * K * 2;
    const size_t tstep = 2 * hstep;
    const unsigned ldsw = (unsigned)wid * 1024u;
    const int aoff = lds_byte(wr * 64 + fr, fq * 8), boff = lds_byte(wc * 32 + fr, fq * 8);
#define PG8_SA(b, h) (((b) * 2 + (h)) * HTB)
#define PG8_SB(b, h) ((4 + (b) * 2 + (h)) * HTB)
#define PG8_STAGE(bufoff, gbase, voff) do { _Pragma("unroll") for (int _i = 0; _i < 2; ++_i) \
        __builtin_amdgcn_global_load_lds((const unsigned*)((const char*)(gbase) + (voff)[_i]), (LAS unsigned*)(lds + (bufoff) + ldsw + _i * 8192), 16, 0, 0); } while (0)
#define PG8_LDA(dst, b, h) do { _Pragma("unroll") for (int m = 0; m < 4; ++m) _Pragma("unroll") for (int k = 0; k < 2; ++k) dst[m][k] = *(const LAS bf16x8*)(lds + PG8_SA(b, h) + aoff + m * 2048 + k * 1024); } while (0)
#define PG8_LDB(dst, b, h) do { _Pragma("unroll") for (int n = 0; n < 2; ++n) _Pragma("unroll") for (int k = 0; k < 2; ++k) dst[n][k] = *(const LAS bf16x8*)(lds + PG8_SB(b, h) + boff + n * 2048 + k * 1024); } while (0)
#define PG8_MMA(ai, bj, At, Bt) do { __builtin_amdgcn_s_setprio(1); _Pragma("unroll") for (int m = 0; m < 4; ++m) _Pragma("unroll") for (int n = 0; n < 2; ++n) _Pragma("unroll") for (int k = 0; k < 2; ++k) \
        acc[ai][bj][m][n] = __builtin_amdgcn_mfma_f32_16x16x32_bf16(Bt[n][k], At[m][k], acc[ai][bj][m][n], 0, 0, 0); __builtin_amdgcn_s_setprio(0); } while (0)
#define PG8_WAIT_V(n) asm volatile("s_waitcnt vmcnt(" #n ")" ::: "memory")
#define PG8_WAIT_L(n) asm volatile("s_waitcnt lgkmcnt(" #n ")" ::: "memory")
#define PG8_BAR __builtin_amdgcn_s_barrier()
#define PG8_SCHED __builtin_amdgcn_sched_barrier(0)
    Unit cur, nxt; int ui = 0;
    if (!S.next(0, cur)) return;
    f32x4 acc[2][2][4][2];
#pragma unroll
    for (int a = 0; a < 2; ++a)
#pragma unroll
        for (int b = 0; b < 2; ++b)
#pragma unroll
            for (int m = 0; m < 4; ++m)
#pragma unroll
                for (int n = 0; n < 2; ++n) acc[a][b][m][n] = (f32x4){0.f, 0.f, 0.f, 0.f};
    bf16x8 At[4][2], B0[2][2], B1[2][2];
    const char* cA = (const char*)g.A + (size_t)cur.pm * tstep; const char* cB = (const char*)g.Bt + (size_t)cur.pn * tstep;
    if constexpr (SP2) {
        PG8_STAGE(PG8_SB(0, 0), cB, voffB); PG8_STAGE(PG8_SB(0, 1), cB + hstep, voffB); PG8_STAGE(PG8_SA(0, 0), cA, voffA); PG8_STAGE(PG8_SA(0, 1), cA + hstep, voffA);
        if (wr == 1) PG8_BAR;
        PG8_WAIT_V(2); PG8_BAR;
        PG8_STAGE(PG8_SB(1, 0), cB + kstep, voffB); PG8_STAGE(PG8_SA(1, 0), cA + kstep, voffA); PG8_STAGE(PG8_SB(1, 1), cB + hstep + kstep, voffB);
        PG8_WAIT_V(6); PG8_BAR;
    } else {
        PG8_STAGE(PG8_SB(0, 0), cB, voffB); PG8_STAGE(PG8_SA(0, 0), cA, voffA); PG8_STAGE(PG8_SB(0, 1), cB + hstep, voffB); PG8_STAGE(PG8_SA(0, 1), cA + hstep, voffA);
        if (wr == 1) PG8_BAR;
        PG8_WAIT_V(4); PG8_BAR;
        PG8_STAGE(PG8_SB(1, 0), cB + kstep, voffB); PG8_STAGE(PG8_SA(1, 0), cA + kstep, voffA); PG8_STAGE(PG8_SB(1, 1), cB + hstep + kstep, voffB);
        PG8_WAIT_V(6); PG8_BAR;
    }
    for (;;) {
        const bool has_next = S.next(ui + 1, nxt);
        const char* nA = has_next ? (const char*)g.A + (size_t)nxt.pm * tstep : cA; const char* nB = has_next ? (const char*)g.Bt + (size_t)nxt.pn * tstep : cB;
#pragma nounroll
        for (int t = 0; t < nt; t += 2) {
            const bool last = (t == nt - 2);
            const char* a1 = cA + (size_t)(t + 1) * kstep;
            const char* a2 = last ? nA : cA + (size_t)(t + 2) * kstep; const char* b2 = last ? nB : cB + (size_t)(t + 2) * kstep;
            const char* a3 = a2 + kstep; const char* b3 = b2 + kstep;
            if constexpr (SP2) {
            PG8_LDB(B0, 0, 0); PG8_LDB(B1, 0, 1); PG8_SCHED; PG8_LDA(At, 0, 0); PG8_STAGE(PG8_SA(1, 1), a1 + hstep, voffA);
            PG8_WAIT_V(8); PG8_WAIT_L(0); PG8_BAR; PG8_MMA(0, 0, At, B0); PG8_MMA(0, 1, At, B1); PG8_BAR; PG8_SCHED;
            PG8_LDA(At, 0, 1); PG8_STAGE(PG8_SB(0, 0), b2, voffB); PG8_STAGE(PG8_SB(0, 1), b2 + hstep, voffB); PG8_STAGE(PG8_SA(0, 0), a2, voffA);
            PG8_WAIT_V(8); PG8_WAIT_L(0); PG8_BAR; PG8_MMA(1, 0, At, B0); PG8_MMA(1, 1, At, B1); PG8_BAR; PG8_SCHED;
            PG8_LDB(B0, 1, 0); PG8_LDB(B1, 1, 1); PG8_SCHED; PG8_LDA(At, 1, 0); PG8_STAGE(PG8_SA(0, 1), a2 + hstep, voffA);
            PG8_WAIT_V(8); PG8_WAIT_L(0); PG8_BAR; PG8_MMA(0, 0, At, B0); PG8_MMA(0, 1, At, B1); PG8_BAR; PG8_SCHED;
            PG8_LDA(At, 1, 1); PG8_STAGE(PG8_SB(1, 0), b3, voffB); PG8_STAGE(PG8_SB(1, 1), b3 + hstep, voffB); PG8_STAGE(PG8_SA(1, 0), a3, voffA);
            PG8_WAIT_V(8); PG8_WAIT_L(0); PG8_BAR; PG8_MMA(1, 0, At, B0); PG8_MMA(1, 1, At, B1); PG8_BAR; PG8_SCHED;
            } else {
            PG8_LDB(B0, 0, 0); PG8_SCHED; PG8_LDA(At, 0, 0); PG8_STAGE(PG8_SA(1, 1), a1 + hstep, voffA);
            PG8_WAIT_L(8); PG8_BAR; PG8_WAIT_L(0); PG8_MMA(0, 0, At, B0); PG8_BAR; PG8_SCHED;
            PG8_LDB(B1, 0, 1); PG8_STAGE(PG8_SB(0, 0), b2, voffB);
            PG8_BAR; PG8_WAIT_L(0); PG8_MMA(0, 1, At, B1); PG8_BAR;
            PG8_LDA(At, 0, 1); PG8_STAGE(PG8_SA(0, 0), a2, voffA);
            PG8_BAR; PG8_WAIT_L(0); PG8_MMA(1, 0, At, B0); PG8_BAR; PG8_SCHED;
            PG8_STAGE(PG8_SB(0, 1), b2 + hstep, voffB);
            PG8_WAIT_V(6); PG8_BAR; PG8_MMA(1, 1, At, B1); PG8_BAR;
            PG8_LDB(B0, 1, 0); PG8_SCHED; PG8_LDA(At, 1, 0); PG8_STAGE(PG8_SA(0, 1), a2 + hstep, voffA);
            PG8_WAIT_L(8); PG8_BAR; PG8_WAIT_L(0); PG8_MMA(0, 0, At, B0); PG8_BAR; PG8_SCHED;
            PG8_LDB(B1, 1, 1); PG8_STAGE(PG8_SB(1, 0), b3, voffB);
            PG8_BAR; PG8_WAIT_L(0); PG8_MMA(0, 1, At, B1); PG8_BAR;
            PG8_LDA(At, 1, 1); PG8_STAGE(PG8_SA(1, 0), a3, voffA);
            PG8_BAR; PG8_WAIT_L(0); PG8_MMA(1, 0, At, B0); PG8_BAR; PG8_SCHED;
            PG8_STAGE(PG8_SB(1, 1), b3 + hstep, voffB);
            PG8_WAIT_V(6); PG8_BAR; PG8_MMA(1, 1, At, B1); PG8_BAR;
            }
        }
        if constexpr (ALIGN_EPI) { if (wr == 0) PG8_BAR; }
        if constexpr (!Epi::AFTER_DRAIN) { E(acc, cur, wr, wc, fr, fq); }
        if (!has_next) break;
#pragma unroll
        for (int a = 0; a < 2; ++a)
#pragma unroll
            for (int b = 0; b < 2; ++b)
#pragma unroll
                for (int m = 0; m < 4; ++m)
#pragma unroll
                    for (int n = 0; n < 2; ++n) acc[a][b][m][n] = (f32x4){0.f, 0.f, 0.f, 0.f};
        cur = nxt; cA = nA; cB = nB; ++ui;
        if constexpr (ALIGN_EPI) { if (wr == 1) PG8_BAR; }
    }
    PG8_WAIT_V(0);
    if constexpr (!ALIGN_EPI) { if (wr == 0) PG8_BAR; }
    PG8_BAR;
    if constexpr (Epi::AFTER_DRAIN) { E.fused(acc, cur, wr, wc, fr, fq, lds, wid, lane); }
#undef PG8_SA
#undef PG8_SB
#undef PG8_STAGE
#undef PG8_LDA
#undef PG8_LDB
#undef PG8_MMA
#undef PG8_WAIT_V
#undef PG8_WAIT_L
#undef PG8_BAR
#undef PG8_SCHED
}
}
using pg8::Unit; using pg8::cvt_pk_bf16;
typedef f32x4 AccT[2][2][4][2];

__device__ __forceinline__ u32x4 pack8(const f32x4 v0, const f32x4 v1) { u32x4 w; w.x = cvt_pk_bf16(v0[0], v0[1]); w.y = cvt_pk_bf16(v0[2], v0[3]); w.z = cvt_pk_bf16(v1[0], v1[1]); w.w = cvt_pk_bf16(v1[2], v1[3]); return w; }

struct EpiProj {
    static constexpr bool AFTER_DRAIN = false;
    bf16_t *uv, *zs, *xbc;
    __device__ __forceinline__ void operator()(const AccT& acc, const Unit& u, int wr, int wc, int fr, int fq) const {
        const int row0 = u.pm * 256 + wr * 64 + fr; const int ct = wc * 32 + 8 * fq;
        bf16_t* base; int ld, mode;
        if (u.pn < 16) { base = uv + u.pn * 256; ld = DMIX; mode = 0; }
        else if (u.pn < 24) { base = zs + (u.pn - 16) * 256; ld = DSSM; mode = 1; }
        else { base = xbc + (u.pn - 24) * 256; ld = DXBC; mode = 2; }
#pragma unroll
        for (int ai = 0; ai < 2; ++ai)
#pragma unroll
            for (int m = 0; m < 4; ++m) { bf16_t* rowp = base + (size_t)(row0 + ai * 128 + m * 16) * ld + ct;
#pragma unroll
                for (int bj = 0; bj < 2; ++bj) { f32x4 v0 = acc[ai][bj][m][0], v1 = acc[ai][bj][m][1];
                    if (mode == 0) {
#pragma unroll
                        for (int j = 0; j < 4; ++j) { v0[j] = gelu_tanh_f(v0[j]); v1[j] = gelu_tanh_f(v1[j]); } }
                    else if (mode == 1) {
#pragma unroll
                        for (int j = 0; j < 4; ++j) { v0[j] = silu_f(v0[j]); v1[j] = silu_f(v1[j]); } }
                    *(u32x4*)(rowp + bj * 128) = pack8(v0, v1); } }
    }
};
struct EpiPlain {
    static constexpr bool AFTER_DRAIN = false;
    bf16_t* O; int ld;
    __device__ __forceinline__ void operator()(const AccT& acc, const Unit& u, int wr, int wc, int fr, int fq) const {
        const int row0 = u.pm * 256 + wr * 64 + fr; const int col0 = u.pn * 256 + wc * 32 + 8 * fq;
#pragma unroll
        for (int ai = 0; ai < 2; ++ai)
#pragma unroll
            for (int m = 0; m < 4; ++m) { bf16_t* rowp = O + (size_t)(row0 + ai * 128 + m * 16) * ld + col0;
#pragma unroll
                for (int bj = 0; bj < 2; ++bj) *(u32x4*)(rowp + bj * 128) = pack8(acc[ai][bj][m][0], acc[ai][bj][m][1]); }
    }
};
struct EpiResid {
    static constexpr bool AFTER_DRAIN = true;
    const float* base; float* out; bf16_t* hn; bf16_t* halo; const float* gain; float* ssq;
    __device__ __forceinline__ void fused(AccT& acc, const Unit& u, int wr, int wc, int fr, int fq, LAS unsigned char* lds, int wid, int lane) const {
        asm volatile("" : "+v"(fr), "+v"(fq));
        LAS float* P = (LAS float*)lds;
        const int col0 = u.pn * 256 + wc * 32 + 8 * fq;
#pragma unroll
        for (int ai = 0; ai < 2; ++ai)
#pragma unroll
            for (int m = 0; m < 4; ++m) { const int rl = ai * 128 + wr * 64 + m * 16 + fr; const int row = u.pm * 256 + rl; const size_t off = (size_t)row * D + col0;
                float ss = 0.f;
                bf16_t* hrow = nullptr;
                if (halo) { const int r6 = row & 63; if (r6 >= 62) { if ((row >> 6) <= 126) hrow = halo + (size_t)(4 * (row >> 6) + (row & 1)) * D; } else if (r6 < 2 && row >= 64) hrow = halo + (size_t)(4 * ((row >> 6) - 1) + 2 + (row & 1)) * D; }
#pragma unroll
                for (int bj = 0; bj < 2; ++bj) { const f32x4 b0 = *(const f32x4*)(base + off + bj * 128), b1 = *(const f32x4*)(base + off + bj * 128 + 4);
                    const f32x4 v0 = acc[ai][bj][m][0] + b0, v1 = acc[ai][bj][m][1] + b1;
                    *(f32x4*)(out + off + bj * 128) = v0; *(f32x4*)(out + off + bj * 128 + 4) = v1;
                    ss += (v0[0] * v0[0] + v0[1] * v0[1]) + (v0[2] * v0[2] + v0[3] * v0[3]) + (v1[0] * v1[0] + v1[1] * v1[1]) + (v1[2] * v1[2] + v1[3] * v1[3]);
                    const f32x4 g0 = *(const f32x4*)(gain + col0 + bj * 128), g1 = *(const f32x4*)(gain + col0 + bj * 128 + 4);
                    const u32x4 w = pack8(v0 * g0, v1 * g1);
                    *(u32x4*)(hn + off + bj * 128) = w;
                    if (hrow) *(u32x4*)(hrow + col0 + bj * 128) = w; }
                ss += __shfl_xor(ss, 16); ss += __shfl_xor(ss, 32);
                if (fq == 0) P[rl * 4 + wc] = ss;
                asm volatile("" ::: "memory"); }
        __syncthreads();
        if (threadIdx.x < 256) { const int t = threadIdx.x; ssq[(size_t)(u.pm * 256 + t) * 8 + u.pn] = (P[t * 4 + 0] + P[t * 4 + 1]) + (P[t * 4 + 2] + P[t * 4 + 3]); }
        __syncthreads();
    }
};
struct EpiPle {
    static constexpr bool AFTER_DRAIN = true;
    float* out; const bf16_t* Eb; const float* ssq_in; float* ssq;
    __device__ __forceinline__ void fused(AccT& acc, const Unit& u, int wr, int wc, int fr, int fq, LAS unsigned char* lds, int wid, int lane) const {
        asm volatile("" : "+v"(fr), "+v"(fq));
        LAS float* P = (LAS float*)lds;
        const int col0 = u.pn * 256 + wc * 32 + 8 * fq;
#pragma unroll
        for (int ai = 0; ai < 2; ++ai)
#pragma unroll
            for (int m = 0; m < 4; ++m) { const int rl = ai * 128 + wr * 64 + m * 16 + fr; const int row = u.pm * 256 + rl; const size_t off = (size_t)row * D + col0;
                const f32x4 q0 = *(const f32x4*)(ssq_in + (size_t)row * 8), q1 = *(const f32x4*)(ssq_in + (size_t)row * 8 + 4);
                const float rinv = 1.0f / sqrtf(((q0[0] + q0[1]) + (q0[2] + q0[3]) + (q1[0] + q1[1]) + (q1[2] + q1[3])) * (1.0f / D) + EPS);
                float ss = 0.f;
#pragma unroll
                for (int bj = 0; bj < 2; ++bj) { const f32x4 b0 = *(const f32x4*)(out + off + bj * 128), b1 = *(const f32x4*)(out + off + bj * 128 + 4);
                    const u32x4 ew = *(const u32x4*)(Eb + off + bj * 128);
                    f32x4 e0 = {bflo(ew.x), bfhi(ew.x), bflo(ew.y), bfhi(ew.y)}, e1 = {bflo(ew.z), bfhi(ew.z), bflo(ew.w), bfhi(ew.w)};
                    f32x4 v0, v1;
#pragma unroll
                    for (int j = 0; j < 4; ++j) { v0[j] = b0[j] + fast_sigmoid(acc[ai][bj][m][0][j] * rinv) * e0[j]; v1[j] = b1[j] + fast_sigmoid(acc[ai][bj][m][1][j] * rinv) * e1[j]; }
                    *(f32x4*)(out + off + bj * 128) = v0; *(f32x4*)(out + off + bj * 128 + 4) = v1;
                    ss += (v0[0] * v0[0] + v0[1] * v0[1]) + (v0[2] * v0[2] + v0[3] * v0[3]) + (v1[0] * v1[0] + v1[1] * v1[1]) + (v1[2] * v1[2] + v1[3] * v1[3]); }
                ss += __shfl_xor(ss, 16); ss += __shfl_xor(ss, 32);
                if (fq == 0) P[rl * 4 + wc] = ss;
                asm volatile("" ::: "memory"); }
        __syncthreads();
        if (threadIdx.x < 256) { const int t = threadIdx.x; ssq[(size_t)(u.pm * 256 + t) * 8 + u.pn] = (P[t * 4 + 0] + P[t * 4 + 1]) + (P[t * 4 + 2] + P[t * 4 + 3]); }
        __syncthreads();
    }
};
struct EpiFfn {
    static constexpr bool AFTER_DRAIN = false;
    bf16_t* act; const float* ssq1; const float* cw; const float* cb;
    __device__ __forceinline__ int grow_of(const Unit& u, int rl) const {
        if (u.pm < 32) return u.pm * 256 + rl;
        const int R = (u.pm - 32) * 256 + rl; int q = (R >> 2) + 1; if (q > 127) q = 127; return 64 * q - 2 + (R & 3);
    }
    __device__ __forceinline__ void operator()(AccT& acc, const Unit& u, int wr, int wc, int fr, int fq) const {
        asm volatile("" : "+v"(fr), "+v"(fq));
        const bool halo = u.pm >= 32;
        const int lane = fq * 16 + fr;
        const int s1 = (lane & 48) | ((fr + 15) & 15), s2 = (lane & 48) | ((fr + 14) & 15);
#pragma unroll
        for (int ai = 0; ai < 2; ++ai)
#pragma unroll
            for (int m = 0; m < 4; ++m) {
                const int gr = grow_of(u, ai * 128 + wr * 64 + m * 16 + fr);
                const f32x4 q0 = *(const f32x4*)(ssq1 + (size_t)gr * 8), q1 = *(const f32x4*)(ssq1 + (size_t)gr * 8 + 4);
                const float rinv = 1.0f / sqrtf(((q0[0] + q0[1]) + (q0[2] + q0[3]) + (q1[0] + q1[1]) + (q1[2] + q1[3])) * (1.0f / D) + EPS);
#pragma unroll
                for (int bj = 0; bj < 2; ++bj)
#pragma unroll
                    for (int n = 0; n < 2; ++n) acc[ai][bj][m][n] = acc[ai][bj][m][n] * rinv;
                asm volatile("" ::: "memory");
            }
#pragma unroll
        for (int n = 0; n < 2; ++n) {
            const int gc = u.pn * 128 + wc * 32 + 8 * fq + 4 * n;
#pragma unroll
            for (int bj = 0; bj < 2; ++bj) {
                const int cc = bj * DFF + gc;
                asm volatile("" ::: "memory");
                const f32x4 w0 = *(const f32x4*)(cw + cc), w1 = *(const f32x4*)(cw + 2 * DFF + cc), w2 = *(const f32x4*)(cw + 4 * DFF + cc), bb = *(const f32x4*)(cb + cc);
#pragma unroll
                for (int ai = 0; ai < 2; ++ai) {
                    f32x4 p1 = {0.f, 0.f, 0.f, 0.f}, p2 = p1;
#pragma unroll
                    for (int m = 0; m < 4; ++m) {
                        f32x4 v = acc[ai][bj][m][n];
                        asm volatile("" : "+v"(v));
                        f32x4 r1, r2, hh;
#pragma unroll
                        for (int j = 0; j < 4; ++j) { r1[j] = __shfl(v[j], s1); r2[j] = __shfl(v[j], s2); }
#pragma unroll
                        for (int j = 0; j < 4; ++j) { const float x1 = fr >= 1 ? r1[j] : p1[j], x2 = fr >= 2 ? r2[j] : p2[j]; hh[j] = bb[j] + w2[j] * v[j] + w1[j] * x1 + w0[j] * x2; }
                        asm volatile("" : "+v"(hh));
                        acc[ai][bj][m][n] = hh; p1 = r1; p2 = r2;
                    }
                }
            }
            asm volatile("" ::: "memory");
#pragma unroll
            for (int ai = 0; ai < 2; ++ai)
#pragma unroll
                for (int m = 0; m < 4; ++m) {
                    const int rl = ai * 128 + wr * 64 + m * 16 + fr;
                    bool st;
                    if (!halo) st = !(m == 0 && fr < 2) || (u.pm == 0 && ai == 0 && wr == 0);
                    else st = ((fr & 3) >= 2) && ((((u.pm - 32) * 256 + rl) >> 2) + 1 <= 127);
                    if (st) { const f32x4 hg_ = acc[ai][0][m][n], hu_ = acc[ai][1][m][n];
                        u32x2 w; w.x = cvt_pk_bf16(silu_f(hg_[0]) * hu_[0], silu_f(hg_[1]) * hu_[1]); w.y = cvt_pk_bf16(silu_f(hg_[2]) * hu_[2], silu_f(hg_[3]) * hu_[3]);
                        *(u32x2*)(act + (size_t)grow_of(u, rl) * DFF + gc) = w; }
                }
        }
    }
};

struct Ctx {
    LAS unsigned char* lds;
    int tid, lane, wave, nb, bid;
    const float* const* in;
    float* out;
    unsigned char* ws;
};

template <int MODE>
__device__ __forceinline__ void prep_w_item(const float* __restrict__ W, int K, int N, bf16_t* __restrict__ Wt, LAS float* scr, int item, int lane) {
    const int nblk = N / 32, kb = item / nblk, nb = item % nblk, k0 = 64 * kb, n0 = 32 * nb;
    int orow = n0;
    if (MODE == 1) orow = (n0 < DFF) ? 256 * (n0 >> 7) + (n0 & 127) : 256 * ((n0 - DFF) >> 7) + 128 + ((n0 - DFF) & 127);
    const float* src = W + (size_t)(k0 + (lane >> 5)) * N + n0 + (lane & 31);
    float v[32];
#pragma unroll
    for (int i = 0; i < 32; ++i) v[i] = __builtin_nontemporal_load(src + (size_t)(2 * i) * N);
#pragma unroll
    for (int i = 0; i < 32; ++i) scr[(2 * i + (lane >> 5)) * 33 + (lane & 31)] = v[i];
    asm volatile("s_waitcnt lgkmcnt(0)" ::: "memory");
    const int cchunk = lane & 7;
#pragma unroll
    for (int j = 0; j < 4; ++j) { const int n = (lane >> 3) + 8 * j; const LAS float* sp = scr + (8 * cchunk) * 33 + n;
        u32x4 o; o.x = pk2(sp[0 * 33], sp[1 * 33]); o.y = pk2(sp[2 * 33], sp[3 * 33]); o.z = pk2(sp[4 * 33], sp[5 * 33]); o.w = pk2(sp[6 * 33], sp[7 * 33]);
        *(u32x4*)(Wt + (size_t)(orow + n) * K + k0 + 8 * cchunk) = o; }
    asm volatile("s_waitcnt lgkmcnt(0)" ::: "memory");
}
__device__ __forceinline__ void phase_prep(const Ctx& c) {
    const int gw = c.bid * 8 + c.wave, NGW = c.nb * 8;
    const float* w_in = c.in[3]; const float* w_out = c.in[15]; const float* w_up = c.in[17]; const float* w_dn = c.in[20]; const float* w_pg = c.in[22]; const float* w_ple = c.in[23];
    LAS float* scr = (LAS float*)(c.lds + c.wave * 16384);
    constexpr int I_IN = (D / 64) * (DIN / 32), I_OUT = (DMIX / 64) * (D / 32), I_UP = (D / 64) * (2 * DFF / 32), I_DN = (DFF / 64) * (D / 32), I_PG = (D / 64) * (D / 32), I_PLE = (DPLE / 64) * (D / 32);
    constexpr int NIT = I_IN + I_OUT + I_UP + I_DN + I_PG + I_PLE;
#pragma unroll 1
    for (int it = gw; it < NIT; it += NGW) {
        int r = it;
        if (r < I_IN) { prep_w_item<0>(w_in, D, DIN, (bf16_t*)(c.ws + WS_WIN), scr, r, c.lane); continue; } r -= I_IN;
        if (r < I_UP) { prep_w_item<1>(w_up, D, 2 * DFF, (bf16_t*)(c.ws + WS_WUP), scr, r, c.lane); continue; } r -= I_UP;
        if (r < I_OUT) { prep_w_item<0>(w_out, DMIX, D, (bf16_t*)(c.ws + WS_WOUT), scr, r, c.lane); continue; } r -= I_OUT;
        if (r < I_DN) { prep_w_item<0>(w_dn, DFF, D, (bf16_t*)(c.ws + WS_WDN), scr, r, c.lane); continue; } r -= I_DN;
        if (r < I_PG) { prep_w_item<0>(w_pg, D, D, (bf16_t*)(c.ws + WS_WPG), scr, r, c.lane); continue; } r -= I_PG;
        prep_w_item<0>(w_ple, DPLE, D, (bf16_t*)(c.ws + WS_WPLE), scr, r, c.lane);
    }
    const float* x = c.in[0]; const float* g = c.in[2]; bf16_t* A = (bf16_t*)(c.ws + WS_A);
    for (int m = gw * 2; m < S; m += NGW * 2) {
        const float* xr = x + (size_t)m * D + 8 * c.lane; f32x4 v[2][4][2]; float s0 = 0.f, s1 = 0.f;
#pragma unroll
        for (int rr = 0; rr < 2; ++rr)
#pragma unroll
            for (int j = 0; j < 4; ++j) { v[rr][j][0] = __builtin_nontemporal_load((const f32x4*)(xr + (size_t)rr * D + 512 * j)); v[rr][j][1] = __builtin_nontemporal_load((const f32x4*)(xr + (size_t)rr * D + 512 * j + 4)); }
#pragma unroll
        for (int j = 0; j < 4; ++j)
#pragma unroll
            for (int e = 0; e < 4; ++e) { s0 += v[0][j][0][e] * v[0][j][0][e] + v[0][j][1][e] * v[0][j][1][e]; s1 += v[1][j][0][e] * v[1][j][0][e] + v[1][j][1][e] * v[1][j][1][e]; }
#pragma unroll
        for (int o = 1; o < 64; o <<= 1) { s0 += __shfl_xor(s0, o); s1 += __shfl_xor(s1, o); }
        const float ri[2] = {1.0f / sqrtf(s0 * (1.0f / D) + EPS), 1.0f / sqrtf(s1 * (1.0f / D) + EPS)};
#pragma unroll
        for (int j = 0; j < 4; ++j) { const f32x4 g0 = *(const f32x4*)(g + 8 * c.lane + 512 * j), g1 = *(const f32x4*)(g + 8 * c.lane + 512 * j + 4);
#pragma unroll
            for (int rr = 0; rr < 2; ++rr) { const f32x4 a0 = v[rr][j][0] * ri[rr] * g0, a1 = v[rr][j][1] * ri[rr] * g1;
                u32x4 o; o.x = pk2(a0[0], a0[1]); o.y = pk2(a0[2], a0[3]); o.z = pk2(a1[0], a1[1]); o.w = pk2(a1[2], a1[3]);
                *(u32x4*)(A + (size_t)(m + rr) * D + 8 * c.lane + 512 * j) = o; } }
    }
    const float* p = c.in[1]; bf16_t* P16 = (bf16_t*)(c.ws + WS_P16);
    for (size_t i = ((size_t)c.bid * 512 + c.tid) * 8; i < (size_t)S * DPLE; i += (size_t)c.nb * 512 * 8) {
        const f32x4 a0 = *(const f32x4*)(p + i), a1 = *(const f32x4*)(p + i + 4);
        u32x4 o; o.x = pk2(a0[0], a0[1]); o.y = pk2(a0[2], a0[3]); o.z = pk2(a1[0], a1[1]); o.w = pk2(a1[2], a1[3]);
        *(u32x4*)(P16 + i) = o;
    }
}

__device__ __forceinline__ void phase_dt(const Ctx& c) {
    const bf16_t* A = (const bf16_t*)(c.ws + WS_A); const bf16_t* Wdt = (const bf16_t*)(c.ws + WS_WIN) + (size_t)10240 * D;
    float* dt = (float*)(c.ws + WS_DT); const float* dtb = c.in[11];
    LAS float* red = (LAS float*)c.lds;
    const int r = c.lane & 31, h = c.lane >> 5;
    for (int item = c.bid; item < S / 32; item += c.nb) {
        const int row0 = item * 32;
        f32x16 acc; for (int i = 0; i < 16; ++i) acc[i] = 0.f;
        const bf16_t* ap = A + (size_t)(row0 + r) * D + c.wave * 256 + 8 * h;
        const bf16_t* bp = Wdt + (size_t)r * D + c.wave * 256 + 8 * h;
#pragma unroll 4
        for (int s = 0; s < 16; ++s) { const bf16x8 af = *(const bf16x8*)(ap + 16 * s), bfr = *(const bf16x8*)(bp + 16 * s);
            acc = __builtin_amdgcn_mfma_f32_32x32x16_bf16(af, bfr, acc, 0, 0, 0); }
#pragma unroll
        for (int i = 0; i < 16; ++i) red[(c.wave * 32 + ((i & 3) + 8 * (i >> 2) + 4 * h)) * 32 + r] = acc[i];
        __syncthreads();
        for (int o = c.tid; o < 1024; o += 512) { float s = 0.f;
#pragma unroll
            for (int w = 0; w < 8; ++w) s += red[w * 1024 + o];
            const int hd = o & 31; const float xv = s + dtb[hd];
            const float sp = xv > 20.f ? xv : log1pf(__expf(xv));
            dt[(size_t)(row0 + (o >> 5)) * 32 + hd] = sp; }
        __syncthreads();
    }
}

template <int W>
__device__ __forceinline__ void stage_conv_tile(const Ctx& c, LAS unsigned char* dst, int pitchB, int col0, int t0, const LAS float* scale) {
    const bf16_t* xbc = (const bf16_t*)(c.ws + WS_XBC); const float* cw = c.in[9]; const float* cb = c.in[10];
    constexpr int NCHK = W / 8, NGRPS = 512 / NCHK, RPT = 128 / NGRPS;
    const int ch = c.tid % NCHK, grp = c.tid / NCHK; const int cc = col0 + ch * 8;
    float w[4][8], b[8];
#pragma unroll
    for (int k = 0; k < 4; ++k) { const f32x4 a0 = *(const f32x4*)(cw + (size_t)k * DXBC + cc), a1 = *(const f32x4*)(cw + (size_t)k * DXBC + cc + 4);
#pragma unroll
        for (int e = 0; e < 4; ++e) { w[k][e] = a0[e]; w[k][4 + e] = a1[e]; } }
    { const f32x4 a0 = *(const f32x4*)(cb + cc), a1 = *(const f32x4*)(cb + cc + 4);
#pragma unroll
      for (int e = 0; e < 4; ++e) { b[e] = a0[e]; b[4 + e] = a1[e]; } }
    const int r0 = grp * RPT;
    float x0[8], x1[8], x2[8];
#pragma unroll
    for (int e = 0; e < 8; ++e) { x0[e] = 0.f; x1[e] = 0.f; x2[e] = 0.f; }
    {
        const int t = t0 + r0;
        if (t - 3 >= 0) { const u32x4 q = *(const u32x4*)(xbc + (size_t)(t - 3) * DXBC + cc); x0[0] = bflo(q.x); x0[1] = bfhi(q.x); x0[2] = bflo(q.y); x0[3] = bfhi(q.y); x0[4] = bflo(q.z); x0[5] = bfhi(q.z); x0[6] = bflo(q.w); x0[7] = bfhi(q.w); }
        if (t - 2 >= 0) { const u32x4 q = *(const u32x4*)(xbc + (size_t)(t - 2) * DXBC + cc); x1[0] = bflo(q.x); x1[1] = bfhi(q.x); x1[2] = bflo(q.y); x1[3] = bfhi(q.y); x1[4] = bflo(q.z); x1[5] = bfhi(q.z); x1[6] = bflo(q.w); x1[7] = bfhi(q.w); }
        if (t - 1 >= 0) { const u32x4 q = *(const u32x4*)(xbc + (size_t)(t - 1) * DXBC + cc); x2[0] = bflo(q.x); x2[1] = bfhi(q.x); x2[2] = bflo(q.y); x2[3] = bfhi(q.y); x2[4] = bflo(q.z); x2[5] = bfhi(q.z); x2[6] = bflo(q.w); x2[7] = bfhi(q.w); }
    }
#pragma unroll
    for (int i = 0; i < RPT; ++i) {
        const int rl = r0 + i, t = t0 + rl;
        const u32x4 q = *(const u32x4*)(xbc + (size_t)t * DXBC + cc);
        float x3[8]; x3[0] = bflo(q.x); x3[1] = bfhi(q.x); x3[2] = bflo(q.y); x3[3] = bfhi(q.y); x3[4] = bflo(q.z); x3[5] = bfhi(q.z); x3[6] = bflo(q.w); x3[7] = bfhi(q.w);
        float sc = 1.f; if (scale) sc = scale[rl * 4 + (ch * 8) / 64];
        float o[8];
#pragma unroll
        for (int e = 0; e < 8; ++e) { const float hsum = b[e] + w[0][e] * x0[e] + w[1][e] * x1[e] + w[2][e] * x2[e] + w[3][e] * x3[e]; o[e] = silu_f(hsum) * sc; x0[e] = x1[e]; x1[e] = x2[e]; x2[e] = x3[e]; }
        u32x4 ov; ov.x = pk2(o[0], o[1]); ov.y = pk2(o[2], o[3]); ov.z = pk2(o[4], o[5]); ov.w = pk2(o[6], o[7]);
        *(LAS u32x4*)(dst + rl * pitchB + ch * 16) = ov;
    }
}

__device__ __forceinline__ void ssd_tables(const Ctx& c, int ck, int g, LAS float* sdt, LAS float* sacs) {
    const float* dt = (const float*)(c.ws + WS_DT); const float* alog = c.in[12];
    { const int l = c.tid >> 2, h = c.tid & 3; const float dv = dt[(size_t)(ck * 128 + l) * 32 + g * 4 + h]; sdt[l * 4 + h] = dv; sacs[l * 4 + h] = dv * (-__expf(alog[g * 4 + h])); }
    __syncthreads();
    if (c.wave < 4) { const int h = c.wave; const float v0 = sacs[(2 * c.lane) * 4 + h], v1 = sacs[(2 * c.lane + 1) * 4 + h]; float s = v0 + v1;
#pragma unroll
        for (int d = 1; d < 64; d <<= 1) { const float t = __shfl_up(s, d); if (c.lane >= d) s += t; }
        const float ex = s - (v0 + v1);
        sacs[(2 * c.lane) * 4 + h] = ex + v0; sacs[(2 * c.lane + 1) * 4 + h] = s; }
    __syncthreads();
}

constexpr int XS_PITCH = 576, BC_PITCH = 320;
constexpr int L_XS = 0, L_B = 128 * XS_PITCH, L_C = L_B + 128 * BC_PITCH, L_TAB = L_C + 128 * BC_PITCH;
constexpr int L_SDT = L_TAB, L_SACS = L_TAB + 2048, L_SW = L_TAB + 4096, L_MISC = L_TAB + 6144;
static_assert(L_MISC + 2048 <= LDS_BYTES, "mixer LDS map");

__device__ __forceinline__ void ssd_a_item(const Ctx& c, int ck, int g) {
    LAS float* sdt = (LAS float*)(c.lds + L_SDT); LAS float* sacs = (LAS float*)(c.lds + L_SACS); LAS float* sw = (LAS float*)(c.lds + L_SW);
    ssd_tables(c, ck, g, sdt, sacs);
    { const int l = c.tid >> 2, h = c.tid & 3; sw[l * 4 + h] = sdt[l * 4 + h] * __expf(sacs[127 * 4 + h] - sacs[l * 4 + h]); }
    if (c.tid < 4) ((float*)(c.ws + WS_CDEC))[ck * 32 + g * 4 + c.tid] = __expf(sacs[127 * 4 + c.tid]);
    __syncthreads();
    stage_conv_tile<256>(c, c.lds + L_XS, XS_PITCH, g * 256, ck * 128, sw);
    stage_conv_tile<128>(c, c.lds + L_B, BC_PITCH, DSSM + g * 128, ck * 128, nullptr);
    __syncthreads();
    bf16_t* st = (bf16_t*)(c.ws + WS_ST) + (size_t)(ck * 32 + g * 4) * 64 * 128;
    for (int o = c.tid; o < 4 * 64 * 128; o += 512) { const int n = o & 127, hp = o >> 7; float s = 0.f;
        for (int l = 0; l < 128; ++l) s += bf2f(*(LAS bf16_t*)(c.lds + L_B + l * BC_PITCH + n * 2)) * bf2f(*(LAS bf16_t*)(c.lds + L_XS + l * XS_PITCH + hp * 2));
        st[o] = (bf16_t)f2bf(s); }
    __syncthreads();
}

__device__ __forceinline__ void gmlp_item(const Ctx& c, int ck, int g) {
    bf16_t* uv = (bf16_t*)(c.ws + WS_UV);
    LAS float* vn = (LAS float*)c.lds;
    LAS float* ssq = (LAS float*)(c.lds + 65536);
    const float* lng = c.in[4] + g * 128; const float* lnb = c.in[5] + g * 128; const float* Ws = c.in[6] + (size_t)g * 128 * 128; const float* bs = c.in[7] + g * 128; const float* nag = c.in[8] + g * 128;
    for (int s = c.wave; s < 128; s += 8) {
        const bf16_t* vr = uv + (size_t)(ck * 128 + s) * DMIX + DA + g * 128;
        const float a0 = bf2f(vr[c.lane]), a1 = bf2f(vr[c.lane + 64]);
        const float mu = wave_sum(a0 + a1) * (1.0f / 128.0f); const float d0 = a0 - mu, d1 = a1 - mu;
        const float var = wave_sum(d0 * d0 + d1 * d1) * (1.0f / 128.0f); const float rs = 1.0f / sqrtf(var + EPS);
        vn[s * 128 + c.lane] = d0 * rs * lng[c.lane] + lnb[c.lane]; vn[s * 128 + c.lane + 64] = d1 * rs * lng[c.lane + 64] + lnb[c.lane + 64];
    }
    __syncthreads();
    const int d = c.tid & 127;
    for (int j = 0; j < 32; ++j) {
        const int t = (c.tid >> 7) + 4 * j; float sg = bs[t]; const float* wr_ = Ws + t * 128;
        for (int s = 0; s <= t; ++s) sg += wr_[s] * vn[s * 128 + d];
        bf16_t* up = uv + (size_t)(ck * 128 + t) * DMIX + g * 128 + d;
        const float y = bf2f(*up) * sg;
        *up = (bf16_t)f2bf(y * nag[d]);
        const float q = wave_sum(y * y);
        if (c.lane == 0) ssq[t * 2 + (c.wave & 1)] = q;
    }
    __syncthreads();
    if (c.tid < 128) ((float*)(c.ws + WS_SSQA))[(size_t)(ck * 128 + c.tid) * 16 + g] = ssq[c.tid * 2] + ssq[c.tid * 2 + 1];
    __syncthreads();
}

typedef short s16x4 __attribute__((ext_vector_type(4)));
typedef short v4i16_t __attribute__((ext_vector_type(4)));
__device__ __forceinline__ s16x4 ds_tr(LAS const unsigned char* p) { return __builtin_bit_cast(s16x4, __builtin_amdgcn_ds_read_tr16_b64_v4i16((LAS v4i16_t*)p)); }
__device__ __forceinline__ bf16x8 frag_tr(LAS const unsigned char* tile, int pitch, int k0, int c0, int lane) {
    const int hh = lane >> 5, blk = (lane >> 4) & 1, q = (lane & 15) >> 2, p = lane & 3;
    LAS const unsigned char* a = tile + (k0 + 8 * hh + q) * pitch + (c0 + 16 * blk + 4 * p) * 2;
    const s16x4 lo = ds_tr(a), hi = ds_tr(a + 4 * pitch);
    return __builtin_shufflevector(lo, hi, 0, 1, 2, 3, 4, 5, 6, 7);
}
__device__ __forceinline__ bf16x8 frag_tr_perm(LAS const unsigned char* tile, int pitch, int k0, int c0, int lane) {
    const int hh = lane >> 5, blk = (lane >> 4) & 1, q = (lane & 15) >> 2, p = lane & 3;
    LAS const unsigned char* a = tile + (k0 + 4 * hh + q) * pitch + (c0 + 16 * blk + 4 * p) * 2;
    const s16x4 lo = ds_tr(a), hi = ds_tr(a + 8 * pitch);
    return __builtin_shufflevector(lo, hi, 0, 1, 2, 3, 4, 5, 6, 7);
}
__device__ __forceinline__ bf16x8 frag_row(LAS const unsigned char* tile, int pitch, int r0, int k0, int lane) {
    return *(LAS const bf16x8*)(tile + (r0 + (lane & 31)) * pitch + (k0 + 8 * (lane >> 5)) * 2);
}
__device__ __forceinline__ bf16x8 pack_frag(const float* v) {
    u32x4 w; w.x = cvt_pk_bf16(v[0], v[1]); w.y = cvt_pk_bf16(v[2], v[3]); w.z = cvt_pk_bf16(v[4], v[5]); w.w = cvt_pk_bf16(v[6], v[7]);
    return __builtin_bit_cast(bf16x8, w);
}
#define MFMA32(a, b, c) __builtin_amdgcn_mfma_f32_32x32x16_bf16((a), (b), (c), 0, 0, 0)

constexpr int G_WP = 272, G_VP = 320, GL_WS = 0, GL_VT = 128 * G_WP, GL_PART = GL_VT + 128 * G_VP;
__device__ __forceinline__ void gmlp_stage_ws(const Ctx& c, int g) {
    const float* Ws = c.in[6] + (size_t)g * 128 * 128;
#pragma unroll
    for (int i = 0; i < 4; ++i) { const int idx = c.tid + 512 * i, t = idx >> 4, s8 = (idx & 15) * 8;
        const f32x4 w0 = *(const f32x4*)(Ws + t * 128 + s8), w1 = *(const f32x4*)(Ws + t * 128 + s8 + 4);
        float wv[8];
#pragma unroll
        for (int j = 0; j < 4; ++j) { wv[j] = (s8 + j <= t) ? w0[j] : 0.f; wv[4 + j] = (s8 + 4 + j <= t) ? w1[j] : 0.f; }
        *(LAS bf16x8*)(c.lds + GL_WS + t * G_WP + s8 * 2) = pack_frag(wv); }
}
__device__ __forceinline__ void gmlp_load_v(const Ctx& c, int ck, int g, u32x4 (&vr)[4]) {
    const bf16_t* uv = (const bf16_t*)(c.ws + WS_UV);
#pragma unroll
    for (int i = 0; i < 4; ++i) { const int row = (c.tid >> 4) + 32 * i; vr[i] = *(const u32x4*)(uv + (size_t)(ck * 128 + row) * DMIX + DA + g * 128 + (c.tid & 15) * 8); }
}
__device__ __forceinline__ void gmlp_items(const Ctx& c, int g, int ck0, int ckstep, int nitems) {
    bf16_t* uv = (bf16_t*)(c.ws + WS_UV);
    LAS unsigned char* vt = c.lds + GL_VT; LAS float* part = (LAS float*)(c.lds + GL_PART);
    const float* lng = c.in[4] + g * 128; const float* lnb = c.in[5] + g * 128; const float* bs = c.in[7] + g * 128; const float* nag = c.in[8] + g * 128;
    const int lane = c.lane, d8 = (c.tid & 15) * 8;
    gmlp_stage_ws(c, g);
    const f32x4 lg0 = *(const f32x4*)(lng + d8), lg1 = *(const f32x4*)(lng + d8 + 4), lb0 = *(const f32x4*)(lnb + d8), lb1 = *(const f32x4*)(lnb + d8 + 4);
    u32x4 vr[4];
    gmlp_load_v(c, ck0, g, vr);
    const int db = c.wave & 3, hh = lane >> 5, r = lane & 31;
    for (int it = 0; it < nitems; ++it) {
        const int ck = ck0 + it * ckstep;
#pragma unroll
        for (int i = 0; i < 4; ++i) { const int row = (c.tid >> 4) + 32 * i;
            float x[8] = {bflo(vr[i].x), bfhi(vr[i].x), bflo(vr[i].y), bfhi(vr[i].y), bflo(vr[i].z), bfhi(vr[i].z), bflo(vr[i].w), bfhi(vr[i].w)};
            float s1 = 0.f, s2 = 0.f;
#pragma unroll
            for (int j = 0; j < 8; ++j) { s1 += x[j]; s2 += x[j] * x[j]; }
#pragma unroll
            for (int o = 1; o < 16; o <<= 1) { s1 += __shfl_xor(s1, o); s2 += __shfl_xor(s2, o); }
            const float mu = s1 * (1.0f / 128.0f); const float var = fmaxf(s2 * (1.0f / 128.0f) - mu * mu, 0.f); const float rs = 1.0f / sqrtf(var + EPS);
            float y[8];
#pragma unroll
            for (int j = 0; j < 4; ++j) { y[j] = (x[j] - mu) * rs * lg0[j] + lb0[j]; y[4 + j] = (x[4 + j] - mu) * rs * lg1[j] + lb1[j]; }
            *(LAS bf16x8*)(vt + row * G_VP + d8 * 2) = pack_frag(y); }
        __syncthreads();
        u32x2 uw[2][4];
#pragma unroll
        for (int tt = 0; tt < 2; ++tt) { const int tb = (c.wave < 4) ? (tt ? 3 : 0) : (tt ? 2 : 1);
            const bf16_t* urow = uv + (size_t)(ck * 128 + tb * 32 + r) * DMIX + g * 128 + db * 32;
#pragma unroll
            for (int gq = 0; gq < 4; ++gq) uw[tt][gq] = *(const u32x2*)(urow + 8 * gq + 4 * hh); }
        if (it + 1 < nitems) gmlp_load_v(c, ck + ckstep, g, vr);
#pragma unroll
        for (int tt = 0; tt < 2; ++tt) {
            const int tb = (c.wave < 4) ? (tt ? 3 : 0) : (tt ? 2 : 1);
            f32x16 acc; for (int i = 0; i < 16; ++i) acc[i] = 0.f;
            const int t = tb * 32 + r;
            for (int ks = 0; ks < 2 * (tb + 1); ++ks)
                acc = MFMA32(frag_tr(vt, G_VP, 16 * ks, db * 32, lane), frag_row(c.lds + GL_WS, G_WP, tb * 32, 16 * ks, lane), acc);
            const float bst = bs[t];
            bf16_t* urow = uv + (size_t)(ck * 128 + t) * DMIX + g * 128 + db * 32;
            float ss = 0.f;
#pragma unroll
            for (int gq = 0; gq < 4; ++gq) {
                const int dl = 8 * gq + 4 * hh;
                const f32x4 na = *(const f32x4*)(nag + db * 32 + dl);
                const float y0 = bflo(uw[tt][gq].x) * (acc[4 * gq] + bst), y1 = bfhi(uw[tt][gq].x) * (acc[4 * gq + 1] + bst), y2 = bflo(uw[tt][gq].y) * (acc[4 * gq + 2] + bst), y3 = bfhi(uw[tt][gq].y) * (acc[4 * gq + 3] + bst);
                ss += (y0 * y0 + y1 * y1) + (y2 * y2 + y3 * y3);
                u32x2 o; o.x = pk2(y0 * na[0], y1 * na[1]); o.y = pk2(y2 * na[2], y3 * na[3]);
                *(u32x2*)(urow + dl) = o;
            }
            ss += __shfl_xor(ss, 32);
            if (hh == 0) part[t * 4 + db] = ss;
        }
        __syncthreads();
        if (c.tid < 128) ((float*)(c.ws + WS_SSQA))[(size_t)(ck * 128 + c.tid) * 16 + g] = (part[c.tid * 4] + part[c.tid * 4 + 1]) + (part[c.tid * 4 + 2] + part[c.tid * 4 + 3]);
    }
    __syncthreads();
}

__device__ __forceinline__ void ssd_a_item_mfma(const Ctx& c, int ck, int g) {
    LAS float* sdt = (LAS float*)(c.lds + L_SDT); LAS float* sacs = (LAS float*)(c.lds + L_SACS); LAS float* sw = (LAS float*)(c.lds + L_SW);
    ssd_tables(c, ck, g, sdt, sacs);
    { const int l = c.tid >> 2, h = c.tid & 3; sw[l * 4 + h] = sdt[l * 4 + h] * __expf(sacs[127 * 4 + h] - sacs[l * 4 + h]); }
    if (c.tid < 4) ((float*)(c.ws + WS_CDEC))[ck * 32 + g * 4 + c.tid] = __expf(sacs[127 * 4 + c.tid]);
    __syncthreads();
    stage_conv_tile<256>(c, c.lds + L_XS, XS_PITCH, g * 256, ck * 128, sw);
    stage_conv_tile<128>(c, c.lds + L_B, BC_PITCH, DSSM + g * 128, ck * 128, nullptr);
    __syncthreads();
    const int lane = c.lane, h = c.wave >> 1, pb = c.wave & 1, hh = lane >> 5, r = lane & 31;
    f32x16 acc[4];
#pragma unroll
    for (int nb = 0; nb < 4; ++nb) for (int i = 0; i < 16; ++i) acc[nb][i] = 0.f;
#pragma unroll 2
    for (int ks = 0; ks < 8; ++ks) {
        const bf16x8 xf = frag_tr(c.lds + L_XS, XS_PITCH, 16 * ks, h * 64 + pb * 32, lane);
#pragma unroll
        for (int nb = 0; nb < 4; ++nb) { const bf16x8 bfg = frag_tr(c.lds + L_B, BC_PITCH, 16 * ks, nb * 32, lane); acc[nb] = MFMA32(bfg, xf, acc[nb]); }
    }
    bf16_t* st = (bf16_t*)(c.ws + WS_ST) + ((size_t)(ck * 32 + g * 4 + h) * 64 + pb * 32 + r) * 128;
#pragma unroll
    for (int nb = 0; nb < 4; ++nb)
#pragma unroll
        for (int gq = 0; gq < 4; ++gq) { u32x2 o; o.x = pk2(acc[nb][4 * gq], acc[nb][4 * gq + 1]); o.y = pk2(acc[nb][4 * gq + 2], acc[nb][4 * gq + 3]);
            *(u32x2*)(st + nb * 32 + 8 * gq + 4 * hh) = o; }
    __syncthreads();
}

constexpr int BC2_PITCH = 272;
__device__ __forceinline__ void ssd_c_item_mfma(const Ctx& c, int ck, int g) {
    LAS float* sdt = (LAS float*)(c.lds + L_SDT); LAS float* sacs = (LAS float*)(c.lds + L_SACS); LAS float* part = (LAS float*)(c.lds + L_SW);
    ssd_tables(c, ck, g, sdt, sacs);
    stage_conv_tile<256>(c, c.lds + L_XS, XS_PITCH, g * 256, ck * 128, nullptr);
    stage_conv_tile<128>(c, c.lds + L_B, BC2_PITCH, DSSM + g * 128, ck * 128, nullptr);
    stage_conv_tile<128>(c, c.lds + L_C, BC2_PITCH, DSSM + NGRP * NST + g * 128, ck * 128, nullptr);
    __syncthreads();
    const int lane = c.lane, h = c.wave >> 1, hh = lane >> 5, r = lane & 31;
    const float Dh = c.in[13][g * 4 + h];
    const bf16_t* hin = (const bf16_t*)(c.ws + WS_ST) + (size_t)(ck * 32 + g * 4 + h) * 64 * 128;
    LAS const unsigned char* xs = c.lds + L_XS; LAS const unsigned char* bt = c.lds + L_B; LAS const unsigned char* ct = c.lds + L_C;
    f32x16 acc[2][2];
#pragma unroll
    for (int lbi = 0; lbi < 2; ++lbi) {
        const int lb = (c.wave & 1) ? (lbi ? 2 : 1) : (lbi ? 3 : 0);
        const int l = lb * 32 + r;
        bf16x8 cf[8];
#pragma unroll
        for (int ks = 0; ks < 8; ++ks) cf[ks] = frag_row(ct, BC2_PITCH, lb * 32, 16 * ks, lane);
        f32x16 a0, a1; for (int i = 0; i < 16; ++i) { a0[i] = 0.f; a1[i] = 0.f; }
#pragma unroll
        for (int ks = 0; ks < 8; ++ks) {
            const bf16x8 h0 = *(const bf16x8*)(hin + (size_t)r * 128 + 16 * ks + 8 * hh), h1 = *(const bf16x8*)(hin + (size_t)(32 + r) * 128 + 16 * ks + 8 * hh);
            a0 = MFMA32(h0, cf[ks], a0); a1 = MFMA32(h1, cf[ks], a1);
        }
        const float al = sacs[l * 4 + h]; const float ea = __expf(al);
        a0 = a0 * ea; a1 = a1 * ea;
        for (int sb = 0; sb <= lb; ++sb) {
            f32x16 X; for (int i = 0; i < 16; ++i) X[i] = 0.f;
#pragma unroll
            for (int ks = 0; ks < 8; ++ks) X = MFMA32(frag_row(bt, BC2_PITCH, sb * 32, 16 * ks, lane), cf[ks], X);
            bf16x8 mf[2];
#pragma unroll
            for (int kk = 0; kk < 2; ++kk) {
                float mv[8];
#pragma unroll
                for (int j = 0; j < 8; ++j) {
                    const int sidx = sb * 32 + 16 * kk + 8 * (j >> 2) + 4 * hh + (j & 3);
                    float v = X[8 * kk + j] * __expf(al - sacs[sidx * 4 + h]) * sdt[sidx * 4 + h];
                    v = (sidx <= l) ? v : 0.f;
                    mv[j] = (sidx == l) ? v + Dh : v;
                }
                mf[kk] = pack_frag(mv);
            }
#pragma unroll
            for (int kk = 0; kk < 2; ++kk) {
                const bf16x8 x0 = frag_tr_perm(xs, XS_PITCH, sb * 32 + 16 * kk, h * 64, lane), x1 = frag_tr_perm(xs, XS_PITCH, sb * 32 + 16 * kk, h * 64 + 32, lane);
                a0 = MFMA32(x0, mf[kk], a0); a1 = MFMA32(x1, mf[kk], a1);
            }
        }
        acc[lbi][0] = a0; acc[lbi][1] = a1;
    }
    const bf16_t* zs = (const bf16_t*)(c.ws + WS_ZS); bf16_t* cat = (bf16_t*)(c.ws + WS_UV); const float* ng = c.in[14] + g * 256 + h * 64;
#pragma unroll
    for (int lbi = 0; lbi < 2; ++lbi) {
        const int lb = (c.wave & 1) ? (lbi ? 2 : 1) : (lbi ? 3 : 0);
        const int l = lb * 32 + r; const size_t row = (size_t)ck * 128 + l;
        float ss = 0.f;
#pragma unroll
        for (int pb = 0; pb < 2; ++pb)
#pragma unroll
            for (int gq = 0; gq < 4; ++gq) { const int p0 = pb * 32 + 8 * gq + 4 * hh;
                const u32x2 zw = *(const u32x2*)(zs + row * DSSM + g * 256 + h * 64 + p0);
                const float y0 = acc[lbi][pb][4 * gq] * bflo(zw.x), y1 = acc[lbi][pb][4 * gq + 1] * bfhi(zw.x), y2 = acc[lbi][pb][4 * gq + 2] * bflo(zw.y), y3 = acc[lbi][pb][4 * gq + 3] * bfhi(zw.y);
                acc[lbi][pb][4 * gq] = y0; acc[lbi][pb][4 * gq + 1] = y1; acc[lbi][pb][4 * gq + 2] = y2; acc[lbi][pb][4 * gq + 3] = y3;
                ss += (y0 * y0 + y1 * y1) + (y2 * y2 + y3 * y3); }
        ss += __shfl_xor(ss, 32);
        if (hh == 0) part[l * 4 + h] = ss;
    }
    __syncthreads();
#pragma unroll
    for (int lbi = 0; lbi < 2; ++lbi) {
        const int lb = (c.wave & 1) ? (lbi ? 2 : 1) : (lbi ? 3 : 0);
        const int l = lb * 32 + r; const size_t row = (size_t)ck * 128 + l;
        const float rinv = 1.0f / sqrtf(((part[l * 4] + part[l * 4 + 1]) + (part[l * 4 + 2] + part[l * 4 + 3])) * (1.0f / 256.0f) + EPS);
#pragma unroll
        for (int pb = 0; pb < 2; ++pb)
#pragma unroll
            for (int gq = 0; gq < 4; ++gq) { const int p0 = pb * 32 + 8 * gq + 4 * hh;
                const f32x4 gg = *(const f32x4*)(ng + p0);
                u32x2 o; o.x = pk2(acc[lbi][pb][4 * gq] * rinv * gg[0], acc[lbi][pb][4 * gq + 1] * rinv * gg[1]); o.y = pk2(acc[lbi][pb][4 * gq + 2] * rinv * gg[2], acc[lbi][pb][4 * gq + 3] * rinv * gg[3]);
                *(u32x2*)(cat + row * DMIX + DA + g * 256 + h * 64 + p0) = o; }
    }
    __syncthreads();
}

#ifndef MIX_GMLP_MFMA
#define MIX_GMLP_MFMA 1
#endif
#ifndef MIX_SSDA_MFMA
#define MIX_SSDA_MFMA 1
#endif
#ifndef MIX_SSDC_MFMA
#define MIX_SSDC_MFMA 1
#endif

__device__ __forceinline__ void phase_mix_a(const Ctx& c) {
    if (MIX_GMLP_MFMA && (c.nb % NGA) == 0 && (NCH * NGA) % c.nb == 0) {
        gmlp_items(c, c.bid & 15, c.bid >> 4, c.nb >> 4, (NCH * NGA) / c.nb);
    } else {
        for (int it = c.bid; it < NCH * NGA; it += c.nb) gmlp_item(c, it >> 4, it & 15);
    }
    for (int it = c.bid; it < NCH * NGRP; it += c.nb) { if (MIX_SSDA_MFMA) ssd_a_item_mfma(c, it >> 3, it & 7); else ssd_a_item(c, it >> 3, it & 7); }
}

__device__ __forceinline__ void phase_scan(const Ctx& c) {
    unsigned* st = (unsigned*)(c.ws + WS_ST); const float* cdec = (const float*)(c.ws + WS_CDEC);
    for (int e = c.bid * 512 + c.tid; e < 32 * 64 * 64; e += c.nb * 512) {
        const int head = e >> 12; float h0 = 0.f, h1 = 0.f;
#pragma unroll 8
        for (int ck = 0; ck < NCH; ++ck) { const size_t idx = (size_t)ck * (32 * 64 * 64) + e; const unsigned w = st[idx]; const float dc = cdec[ck * 32 + head];
            st[idx] = pk2(h0, h1); h0 = dc * h0 + bflo(w); h1 = dc * h1 + bfhi(w); }
    }
    bf16_t* uv = (bf16_t*)(c.ws + WS_UV); const float* sq = (const float*)(c.ws + WS_SSQA);
    for (int i = c.bid * 512 + c.tid; i < S * (DA / 8); i += c.nb * 512) { const int row = i >> 8, ch = i & 255;
        const f32x4 q0 = *(const f32x4*)(sq + row * 16), q1 = *(const f32x4*)(sq + row * 16 + 4), q2 = *(const f32x4*)(sq + row * 16 + 8), q3 = *(const f32x4*)(sq + row * 16 + 12);
        float s = 0.f;
#pragma unroll
        for (int e = 0; e < 4; ++e) s += q0[e] + q1[e] + q2[e] + q3[e];
        const float rinv = 1.0f / sqrtf(s * (1.0f / DA) + EPS);
        u32x4* pp = (u32x4*)(uv + (size_t)row * DMIX + ch * 8); const u32x4 w = *pp; u32x4 o;
        o.x = pk2(bflo(w.x) * rinv, bfhi(w.x) * rinv); o.y = pk2(bflo(w.y) * rinv, bfhi(w.y) * rinv); o.z = pk2(bflo(w.z) * rinv, bfhi(w.z) * rinv); o.w = pk2(bflo(w.w) * rinv, bfhi(w.w) * rinv);
        *pp = o; }
}

__device__ __forceinline__ void ssd_c_item(const Ctx& c, int ck, int g) {
    LAS float* sdt = (LAS float*)(c.lds + L_SDT); LAS float* sacs = (LAS float*)(c.lds + L_SACS); LAS float* part = (LAS float*)(c.lds + L_SW);
    ssd_tables(c, ck, g, sdt, sacs);
    stage_conv_tile<256>(c, c.lds + L_XS, XS_PITCH, g * 256, ck * 128, nullptr);
    stage_conv_tile<128>(c, c.lds + L_B, BC_PITCH, DSSM + g * 128, ck * 128, nullptr);
    stage_conv_tile<128>(c, c.lds + L_C, BC_PITCH, DSSM + NGRP * NST + g * 128, ck * 128, nullptr);
    __syncthreads();
    float* G = (float*)(c.ws + WS_GSCR) + (size_t)c.bid * 16384;
    for (int o = c.tid; o < 16384; o += 512) { const int s = o & 127, l = o >> 7; float a = 0.f;
        if (s <= l) for (int n = 0; n < 128; ++n) a += bf2f(*(LAS bf16_t*)(c.lds + L_C + l * BC_PITCH + n * 2)) * bf2f(*(LAS bf16_t*)(c.lds + L_B + s * BC_PITCH + n * 2));
        __hip_atomic_store(G + o, a, __ATOMIC_RELAXED, __HIP_MEMORY_SCOPE_AGENT); }
    asm volatile("s_waitcnt vmcnt(0)" ::: "memory");
    __syncthreads();
    const bf16_t* hin = (const bf16_t*)(c.ws + WS_ST) + (size_t)(ck * 32 + g * 4) * 64 * 128;
    const bf16_t* zs = (const bf16_t*)(c.ws + WS_ZS); bf16_t* cat = (bf16_t*)(c.ws + WS_UV); const float* dsk = c.in[13]; const float* ng = c.in[14];
    const int hp = c.tid & 255, h = hp >> 6; const float Dh = dsk[g * 4 + h];
    for (int j = 0; j < 64; ++j) { const int l = (c.tid >> 8) + 2 * j; const float al = sacs[l * 4 + h];
        float y = 0.f;
        for (int s = 0; s <= l; ++s) y += __hip_atomic_load(G + l * 128 + s, __ATOMIC_RELAXED, __HIP_MEMORY_SCOPE_AGENT) * __expf(al - sacs[s * 4 + h]) * sdt[s * 4 + h] * bf2f(*(LAS bf16_t*)(c.lds + L_XS + s * XS_PITCH + hp * 2));
        float yo = 0.f;
        for (int n = 0; n < 128; ++n) yo += bf2f(*(LAS bf16_t*)(c.lds + L_C + l * BC_PITCH + n * 2)) * bf2f(hin[hp * 128 + n]);
        y += __expf(al) * yo + Dh * bf2f(*(LAS bf16_t*)(c.lds + L_XS + l * XS_PITCH + hp * 2));
        const size_t row = (size_t)ck * 128 + l;
        y *= bf2f(zs[row * DSSM + g * 256 + hp]);
        const float q = wave_sum(y * y);
        if (c.lane == 0) part[l * 4 + (c.wave & 3)] = q;
        cat[row * DMIX + DA + g * 256 + hp] = (bf16_t)f2bf(y);
    }
    __syncthreads();
    for (int j = 0; j < 64; ++j) { const int l = (c.tid >> 8) + 2 * j; const size_t row = (size_t)ck * 128 + l;
        const float rinv = 1.0f / sqrtf(((part[l * 4] + part[l * 4 + 1]) + (part[l * 4 + 2] + part[l * 4 + 3])) * (1.0f / 256.0f) + EPS);
        bf16_t* pp = cat + row * DMIX + DA + g * 256 + hp;
        *pp = (bf16_t)f2bf(bf2f(*pp) * rinv * ng[g * 256 + hp]); }
    __syncthreads();
}

__device__ __forceinline__ void phase_mix_c(const Ctx& c) {
    for (int it = c.bid; it < NCH * NGRP; it += c.nb) { if (MIX_SSDC_MFMA) ssd_c_item_mfma(c, it >> 3, it & 7); else ssd_c_item(c, it >> 3, it & 7); }
}

__device__ __forceinline__ void phase_final(const Ctx& c) {
    const int gw = c.bid * 8 + c.wave, NGW = c.nb * 8; const float* g = c.in[24]; const float* sq = (const float*)(c.ws + WS_SSQ3);
    for (int m = gw; m < S; m += NGW) {
        const f32x4 q0 = *(const f32x4*)(sq + (size_t)m * 8), q1 = *(const f32x4*)(sq + (size_t)m * 8 + 4);
        const float rinv = 1.0f / sqrtf(((q0[0] + q0[1]) + (q0[2] + q0[3]) + (q1[0] + q1[1]) + (q1[2] + q1[3])) * (1.0f / D) + EPS);
        float* orow = c.out + (size_t)m * D + 4 * c.lane;
#pragma unroll
        for (int j = 0; j < 8; ++j) { const f32x4 v = *(const f32x4*)(orow + 256 * j), gg = *(const f32x4*)(g + 4 * c.lane + 256 * j); *(f32x4*)(orow + 256 * j) = v * rinv * gg; }
    }
}

#define XB_TMO      128
#define XB_XCNT(j)  (256  + 64 * (j))
#define XB_XSUB(j)  (1280 + 64 * (j))
#define XB_XGEN(j)  (2304 + 64 * (j))
#define XB_TOP      3328
#define XB_TOPGEN   3392
#define XCD_BAR_WORDS 3456
#define XB_SPIN_CAP (1u << 20)
__device__ __forceinline__ unsigned xb_ld(unsigned* p)              { return __hip_atomic_load(p, __ATOMIC_RELAXED, __HIP_MEMORY_SCOPE_AGENT); }
__device__ __forceinline__ unsigned xb_add(unsigned* p, unsigned v) { return __hip_atomic_fetch_add(p, v, __ATOMIC_RELAXED, __HIP_MEMORY_SCOPE_AGENT); }
__device__ __forceinline__ unsigned xb_xcc_id() { return (unsigned)__builtin_amdgcn_s_getreg((3 << 11) | 20) & 0xFu; }
#define XB_SPIN(cond, bar) do { unsigned _sp = 0; while (cond) { __builtin_amdgcn_s_sleep(1); \
    if ((++_sp & 255u) == 0u) { if (xb_ld(&(bar)[XB_TMO])) break; if (_sp > XB_SPIN_CAP) { atomicAdd(&(bar)[XB_TMO], 1u); break; } } } } while (0)
struct XcdBarrier { unsigned* bar; unsigned x; volatile LAS unsigned* st; };
__device__ __forceinline__ XcdBarrier xcd_barrier_post(unsigned* bar, volatile LAS unsigned* st) {
    XcdBarrier b; b.bar = bar; b.x = xb_xcc_id(); b.st = st;
    if (threadIdx.x == 0) (void)xb_add(&bar[XB_XCNT(b.x)], 1u);
    return b;
}
__device__ __forceinline__ void xcd_barrier_complete(unsigned* bar, unsigned x, unsigned& nloc, unsigned& nx) {
    const unsigned G = gridDim.x * gridDim.y * gridDim.z;
    unsigned sum, cnt, mine, sp = 0u;
    for (;;) {
        sum = 0u; cnt = 0u; mine = 0u;
#pragma unroll
        for (unsigned j = 0; j < 16; ++j) { const unsigned c = xb_ld(&bar[XB_XCNT(j)]); sum += c; cnt += (c > 0u) ? 1u : 0u; mine = (j == x) ? c : mine; }
        if (sum == G) break;
        __builtin_amdgcn_s_sleep(1);
        if ((++sp & 255u) == 0u) { if (xb_ld(&bar[XB_TMO])) break; if (sp > XB_SPIN_CAP) { atomicAdd(&bar[XB_TMO], 1u); break; } }
    }
    nloc = mine > 0u ? mine : 1u; nx = cnt > 0u ? cnt : 1u;
}
__device__ __forceinline__ void xcd_barrier(const XcdBarrier& b) {
    asm volatile("s_waitcnt vmcnt(0)" ::: "memory");
    __syncthreads();
    if (threadIdx.x == 0) {
        unsigned* bar = b.bar;
        __builtin_amdgcn_s_waitcnt(0);
        unsigned nloc = b.st[0], nx = b.st[1];
        if (nloc == 0u) { xcd_barrier_complete(bar, b.x, nloc, nx); b.st[0] = nloc; b.st[1] = nx; }
        const unsigned old = xb_add(&bar[XB_XSUB(b.x)], 1u);
        const unsigned gen = old / nloc;
        if (old + 1u == (gen + 1u) * nloc) {
            __builtin_amdgcn_fence(__ATOMIC_RELEASE, "agent");
            asm volatile("s_waitcnt vmcnt(0)" ::: "memory");
            const unsigned og = xb_add(&bar[XB_TOP], 1u);
            const unsigned tg = og / nx;
            if (og + 1u == (tg + 1u) * nx) xb_add(&bar[XB_TOPGEN], 1u);
            else XB_SPIN(xb_ld(&bar[XB_TOPGEN]) == tg, bar);
            __builtin_amdgcn_fence(__ATOMIC_ACQUIRE, "agent");
            xb_add(&bar[XB_XGEN(b.x)], 1u);
            asm volatile("s_waitcnt vmcnt(0)" ::: "memory");
        } else {
            XB_SPIN(xb_ld(&bar[XB_XGEN(b.x)]) == gen, bar);
            __builtin_amdgcn_fence(__ATOMIC_ACQUIRE, "agent");
            asm volatile("s_waitcnt vmcnt(0)" ::: "memory");
        }
    }
    __syncthreads();
}

__global__ void __launch_bounds__(512, 2) mega_fwd(Params P, int ph_lo, int ph_hi) {
    extern __shared__ __attribute__((aligned(16))) unsigned char lds_raw[];
    Ctx c;
    c.lds = (LAS unsigned char*)lds_raw; c.tid = threadIdx.x; c.lane = c.tid & 63; c.wave = __builtin_amdgcn_readfirstlane(c.tid >> 6);
    c.nb = gridDim.x; c.bid = blockIdx.x; c.in = P.in; c.out = P.out; c.ws = P.ws;
    unsigned char* ws = P.ws;
    volatile LAS unsigned* bst = (volatile LAS unsigned*)(c.lds + L_MISC);
    if (c.tid < 2) bst[c.tid] = 0u;
    __syncthreads();
    const XcdBarrier xbar = xcd_barrier_post((unsigned*)ws, bst);
#ifndef PH_MASK
#define PH_MASK 0x3ff
#endif
#define IN(k) (((PH_MASK >> (k)) & 1) && ph_lo <= (k) && (k) < ph_hi)
#ifndef CG_SEAM
#define CG_SEAM -1
#endif
#ifndef TPROBE
#define TPROBE -1
#endif
#ifndef TAMP
#define TAMP 4
#endif
    volatile LAS unsigned long long* tsl = (volatile LAS unsigned long long*)(c.lds + L_MISC + 64);
    if (TPROBE >= 0 && c.bid == 0 && c.tid == 0) tsl[0] = __builtin_amdgcn_s_memrealtime();
#define SEAM(k) do { if (IN(k) && IN((k) + 1)) { if ((k) == CG_SEAM) cg::this_grid().sync(); else xcd_barrier(xbar); } \
        if (TPROBE >= 0 && c.bid == 0 && c.tid == 0) tsl[(k) + 1] = __builtin_amdgcn_s_memrealtime(); } while (0)
    if (IN(0)) phase_prep(c);
    SEAM(0);
    if (IN(1)) {
        pg8::Gemm g{(const bf16_t*)(ws + WS_A), (const bf16_t*)(ws + WS_WIN), D}; pg8::StaticOrder So; So.init(32, 40, c.nb, c.bid);
        EpiProj E{(bf16_t*)(ws + WS_UV), (bf16_t*)(ws + WS_ZS), (bf16_t*)(ws + WS_XBC)};
        pg8::gemm_phase<EpiProj, true, true>(c.lds, g, So, E);
        phase_dt(c);
    }
    SEAM(1);
    if (IN(2)) phase_mix_a(c);
    SEAM(2);
    if (IN(3)) phase_scan(c);
    SEAM(3);
    if (IN(4)) phase_mix_c(c);
    SEAM(4);
    if (IN(5)) {
        { pg8::Gemm g{(const bf16_t*)(ws + WS_UV), (const bf16_t*)(ws + WS_WOUT), DMIX}; pg8::StaticOrder So; So.init(32, 8, c.nb, c.bid);
          EpiResid E{P.in[0], P.out, (bf16_t*)(ws + WS_HG), (bf16_t*)(ws + WS_HG) + (size_t)S * D, P.in[16], (float*)(ws + WS_SSQ1)};
          pg8::gemm_phase<EpiResid, false, true>(c.lds, g, So, E); }
        { pg8::Gemm g{(const bf16_t*)(ws + WS_P16), (const bf16_t*)(ws + WS_WPLE), DPLE}; pg8::StaticOrder So; So.init(32, 8, c.nb, c.bid);
          EpiPlain E{(bf16_t*)(ws + WS_E), D};
          pg8::gemm_phase<EpiPlain, true, true>(c.lds, g, So, E); }
    }
    SEAM(5);
    if (IN(6)) {
        pg8::Gemm g{(const bf16_t*)(ws + WS_HG), (const bf16_t*)(ws + WS_WUP), D}; pg8::StaticOrder So; So.init(34, 44, c.nb, c.bid);
        EpiFfn E{(bf16_t*)(ws + WS_ACT), (const float*)(ws + WS_SSQ1), P.in[18], P.in[19]};
        pg8::gemm_phase<EpiFfn, true, true>(c.lds, g, So, E);
    }
    SEAM(6);
    if (IN(7)) {
        pg8::Gemm g{(const bf16_t*)(ws + WS_ACT), (const bf16_t*)(ws + WS_WDN), DFF}; pg8::StaticOrder So; So.init(32, 8, c.nb, c.bid);
        EpiResid E{P.out, P.out, (bf16_t*)(ws + WS_H2G), nullptr, P.in[21], (float*)(ws + WS_SSQ2)};
        pg8::gemm_phase<EpiResid, false, true>(c.lds, g, So, E);
    }
    SEAM(7);
    if (IN(8)) {
        pg8::Gemm g{(const bf16_t*)(ws + WS_H2G), (const bf16_t*)(ws + WS_WPG), D}; pg8::StaticOrder So; So.init(32, 8, c.nb, c.bid);
        EpiPle E{P.out, (const bf16_t*)(ws + WS_E), (const float*)(ws + WS_SSQ2), (float*)(ws + WS_SSQ3)};
        pg8::gemm_phase<EpiPle, false, true>(c.lds, g, So, E);
    }
    SEAM(8);
    if (IN(9)) phase_final(c);
    if (TPROBE >= 0 && c.bid == 0) {
        asm volatile("s_waitcnt vmcnt(0)" ::: "memory"); __syncthreads();
        if (c.tid == 0) { tsl[10] = __builtin_amdgcn_s_memrealtime(); const unsigned long long d = (tsl[TPROBE + 1] - tsl[TPROBE]) * TAMP; const unsigned long long t0 = __builtin_amdgcn_s_memrealtime();
            while (__builtin_amdgcn_s_memrealtime() - t0 < d) __builtin_amdgcn_s_sleep(8); }
    }
#undef IN
#undef SEAM
}

extern "C" void kernel_launch(void* const* d_in, const int* in_sizes, int n_in, void* d_out, int out_size, void* d_ws, size_t ws_size, hipStream_t stream) {
    static int grid = 0;
    if (grid == 0) {
        if (n_in != 25 || out_size != S * D || ws_size < WS_END) { fprintf(stderr, "kernel_launch: unexpected shapes (n_in %d out %d ws %zu)\n", n_in, out_size, ws_size); grid = -1; return; }
        int dev = 0, cus = 0, per_cu = 0;
        (void)hipGetDevice(&dev); (void)hipDeviceGetAttribute(&cus, hipDeviceAttributeMultiprocessorCount, dev);
        if (hipFuncSetAttribute((const void*)mega_fwd, hipFuncAttributeMaxDynamicSharedMemorySize, LDS_BYTES) != hipSuccess) { fprintf(stderr, "kernel_launch: hipFuncSetAttribute failed\n"); grid = -1; return; }
        (void)hipOccupancyMaxActiveBlocksPerMultiprocessor(&per_cu, (const void*)mega_fwd, 512, LDS_BYTES);
        if (per_cu < 1) { fprintf(stderr, "kernel_launch: occupancy query says %d blocks/CU\n", per_cu); per_cu = 1; }
        (void)hipGetLastError();
        grid = cus;
        fprintf(stderr, "kernel_launch: grid %d (cus %d, per_cu %d)\n", grid, cus, per_cu);
    }
    if (grid < 0) return;
    if (hipMemsetAsync(d_ws, 0, 16384, stream) != hipSuccess) { fprintf(stderr, "kernel_launch: memset failed\n"); return; }
    Params P{};
    for (int i = 0; i < 25; ++i) P.in[i] = (const float*)d_in[i];
    P.out = (float*)d_out; P.ws = (unsigned char*)d_ws;
#if MK_LAUNCHES == 1
    int lo = 0, hi = NPH;
    void* args[] = {&P, &lo, &hi};
#if CG_SEAM >= 0
    hipError_t e = hipLaunchCooperativeKernel((const void*)mega_fwd, dim3(grid), dim3(512), args, LDS_BYTES, stream);
#else
    (void)args;
    hipLaunchKernelGGL(mega_fwd, dim3(grid), dim3(512), LDS_BYTES, stream, P, lo, hi);
    hipError_t e = hipPeekAtLastError();
#endif
    if (e != hipSuccess) fprintf(stderr, "kernel_launch: launch failed: %s\n", hipGetErrorString(e));
#else
    for (int k = 0; k < NPH; ++k) {
        int lo = k, hi = k + 1;
        void* args[] = {&P, &lo, &hi};
        hipError_t e = hipLaunchCooperativeKernel((const void*)mega_fwd, dim3(grid), dim3(512), args, LDS_BYTES, stream);
        if (e != hipSuccess) { fprintf(stderr, "kernel_launch: launch %d failed: %s\n", k, hipGetErrorString(e)); break; }
    }
#endif
}
```

```cpp
#include <hip/hip_runtime.h>
#include <hip/hip_cooperative_groups.h>
#include <cstdio>
#include <cstdint>
namespace cg = cooperative_groups;

#ifndef MK_LAUNCHES
#define MK_LAUNCHES 1
#endif

#define LAS __attribute__((address_space(3)))
typedef unsigned short bf16_t;
typedef short bf16x8 __attribute__((ext_vector_type(8)));
typedef float f32x4 __attribute__((ext_vector_type(4)));
typedef float f32x2 __attribute__((ext_vector_type(2)));
typedef float f32x16 __attribute__((ext_vector_type(16)));
typedef unsigned u32x4 __attribute__((ext_vector_type(4)));
typedef unsigned u32x2 __attribute__((ext_vector_type(2)));

constexpr int S = 8192, D = 2048, DIN = 10272, DA = 2048, DSSM = 2048, DXBC = 4096, NH = 32, NGRP = 8, NST = 128;
constexpr int DFF = 5632, DPLE = 256, DMIX = 4096, NCH = 64, CH = 128, NGA = 16;
constexpr float EPS = 1e-6f;
constexpr int NPH = 10;

constexpr size_t MiB = 1u << 20;
constexpr size_t WS_WUP = 1 * MiB;
constexpr size_t WS_WDN = 45 * MiB;
constexpr size_t WS_WPG = 67 * MiB;
constexpr size_t WS_WPLE = 75 * MiB;
constexpr size_t WS_WIN = 76 * MiB;
constexpr size_t WS_WOUT = 117 * MiB;
constexpr size_t WS_UV = 133 * MiB;
constexpr size_t WS_ACT = 133 * MiB;
constexpr size_t WS_ZS = 197 * MiB;
constexpr size_t WS_XBC = 229 * MiB;
constexpr size_t WS_HG = 229 * MiB;
constexpr size_t WS_H2G = 229 * MiB;
constexpr size_t WS_A = 293 * MiB;
constexpr size_t WS_ST = 293 * MiB;
constexpr size_t WS_E = 293 * MiB;
constexpr size_t WS_P16 = 325 * MiB;
constexpr size_t WS_DT = 329 * MiB;
constexpr size_t WS_SSQA = 330 * MiB;
constexpr size_t WS_SSQ1 = 331 * MiB;
constexpr size_t WS_SSQ2 = WS_SSQ1 + 256 * 1024;
constexpr size_t WS_SSQ3 = WS_SSQ2 + 256 * 1024;
constexpr size_t WS_CDEC = WS_SSQ3 + 256 * 1024;
constexpr size_t WS_GSCR = 332 * MiB;
constexpr size_t WS_END = 348 * MiB;

constexpr int LDS_BYTES = 163840;

struct Params {
    const float* in[25];
    float* out;
    unsigned char* ws;
};

__device__ __forceinline__ unsigned f2bf(float f) { unsigned u = __builtin_bit_cast(unsigned, f); return (u + 0x7fffu + ((u >> 16) & 1u)) >> 16; }
__device__ __forceinline__ unsigned pk2(float lo, float hi) { return f2bf(lo) | (f2bf(hi) << 16); }
__device__ __forceinline__ float bf2f(unsigned short b) { return __builtin_bit_cast(float, ((unsigned)b) << 16); }
__device__ __forceinline__ float bflo(unsigned w) { return __builtin_bit_cast(float, w << 16); }
__device__ __forceinline__ float bfhi(unsigned w) { return __builtin_bit_cast(float, w & 0xffff0000u); }
__device__ __forceinline__ float fast_sigmoid(float x) { return __builtin_amdgcn_rcpf(1.0f + __builtin_amdgcn_exp2f(-1.4426950408889634f * x)); }
__device__ __forceinline__ float silu_f(float x) { return x * fast_sigmoid(x); }
__device__ __forceinline__ float gelu_tanh_f(float x) { const float t = x + 0.044715f * x * x * x; return x * __builtin_amdgcn_rcpf(1.0f + __builtin_amdgcn_exp2f(-2.3022081986f * t)); }
__device__ __forceinline__ float wave_sum(float v) {
#pragma unroll
    for (int o = 1; o < 64; o <<= 1) v += __shfl_xor(v, o);
    return v;
}

namespace pg8 {
constexpr int BM = 256, BK = 64, HALF = 128, HTB = HALF * BK * 2, STAGE_BYTES = 8 * HTB, NXCD = 8, WGM = 8;
__host__ __device__ __forceinline__ int lds_byte(int r, int c) { const int st = (r >> 4) * 2 + (c >> 5), rr = r & 15, cc = c & 31, ob = rr * 64 + cc * 2; return st * 1024 + (ob ^ (((ob >> 9) & 1) << 5)); }
__host__ __device__ __forceinline__ void stage_rc(int b, int& R, int& C) { const int st = b / 1024, sb = b % 1024, swz = sb ^ (((sb >> 9) & 1) << 5); R = (st >> 1) * 16 + swz / 64; C = (st & 1) * 32 + (swz % 64) / 2; }
__host__ __device__ __forceinline__ int perm32(int rho) { const int n = rho >> 4, i = rho & 15; return 8 * (i >> 2) + 4 * n + (i & 3); }

struct Unit { int pm, pn; };
struct Gemm { const bf16_t* A; const bf16_t* Bt; int K; };

struct StaticOrder {
    int nM, nN, nwg, G, c;
    __device__ void init(int nM_, int nN_, int G_, int c_) { nM = nM_; nN = nN_; nwg = nM * nN; G = G_; c = c_; }
    __device__ bool next(int i, Unit& u) const {
        const long L = (long)i * G + c; if (L >= nwg) return false;
        int wgid = (int)L; { const int q = nwg / NXCD, r = nwg % NXCD, xcd = wgid % NXCD, off = wgid / NXCD; wgid = (xcd < r ? xcd * (q + 1) : r * (q + 1) + (xcd - r) * q) + off; }
        const int nig = WGM * nN, gid = wgid / nig, fm = gid * WGM, gsz = (nM - fm) < WGM ? (nM - fm) : WGM;
        u.pm = fm + ((wgid % nig) % gsz); u.pn = (wgid % nig) / gsz; return true;
    }
};

__device__ __forceinline__ unsigned cvt_pk_bf16(float lo, float hi) { unsigned r; asm volatile("v_cvt_pk_bf16_f32 %0, %1, %2" : "=v"(r) : "v"(lo), "v"(hi)); return r; }

template <class Epi, bool ALIGN_EPI, bool SP2>
__device__ __forceinline__ void gemm_phase(LAS unsigned char* lds, const Gemm g, const StaticOrder& S, const Epi& E) {
    const int tid = threadIdx.x, wid = __builtin_amdgcn_readfirstlane(tid >> 6), lane = tid & 63, wr = wid >> 2, wc = wid & 3, fr = lane & 15, fq = lane >> 4;
    const int K = g.K, nt = K / BK;
    unsigned voffA[2], voffB[2];
#pragma unroll
    for (int i = 0; i < 2; ++i) { int R, C; stage_rc(tid * 16 + i * 8192, R, C); const int Rb = (R & ~31) + perm32(R & 31);
        voffA[i] = (unsigned)(R * K + C) * 2u; voffB[i] = (unsigned)(Rb * K + C) * 2u; }
    const size_t kstep = (size_t)(BK * 2);
    const size_t hstep = (size_t)HALF * K * 2;
    const size_t tstep = 2 * hstep;
    const unsigned ldsw = (unsigned)wid * 1024u;
    const int aoff = lds_byte(wr * 64 + fr, fq * 8), boff = lds_byte(wc * 32 + fr, fq * 8);
#define PG8_SA(b, h) (((b) * 2 + (h)) * HTB)
#define PG8_SB(b, h) ((4 + (b) * 2 + (h)) * HTB)
#define PG8_STAGE(bufoff, gbase, voff) do { _Pragma("unroll") for (int _i = 0; _i < 2; ++_i) \
        __builtin_amdgcn_global_load_lds((const unsigned*)((const char*)(gbase) + (voff)[_i]), (LAS unsigned*)(lds + (bufoff) + ldsw + _i * 8192), 16, 0, 0); } while (0)
#define PG8_LDA(dst, b, h) do { _Pragma("unroll") for (int m = 0; m < 4; ++m) _Pragma("unroll") for (int k = 0; k < 2; ++k) dst[m][k] = *(const LAS bf16x8*)(lds + PG8_SA(b, h) + aoff + m * 2048 + k * 1024); } while (0)
#define PG8_LDB(dst, b, h) do { _Pragma("unroll") for (int n = 0; n < 2; ++n) _Pragma("unroll") for (int k = 0; k < 2; ++k) dst[n][k] = *(const LAS bf16x8*)(lds + PG8_SB(b, h) + boff + n * 2048 + k * 1024); } while (0)
#define PG8_MMA(ai, bj, At, Bt) do { __builtin_amdgcn_s_setprio(1); _Pragma("unroll") for (int m = 0; m < 4; ++m) _Pragma("unroll") for (int n = 0; n < 2; ++n) _Pragma("unroll") for (int k = 0; k < 2; ++k) \
        acc[ai][bj][m][n] = __builtin_amdgcn_mfma_f32_16x16x32_bf16(Bt[n][k], At[m][k], acc[ai][bj][m][n], 0, 0, 0); __builtin_amdgcn_s_setprio(0); } while (0)
#define PG8_WAIT_V(n) asm volatile("s_waitcnt vmcnt(" #n ")" ::: "memory")
#define PG8_WAIT_L(n) asm volatile("s_waitcnt lgkmcnt(" #n ")" ::: "memory")
#define PG8_BAR __builtin_amdgcn_s_barrier()
#define PG8_SCHED __builtin_amdgcn_sched_barrier(0)
    Unit cur, nxt; int ui = 0;
    if (!S.next(0, cur)) return;
    f32x4 acc[2][2][4][2];
#pragma unroll
    for (int a = 0; a < 2; ++a)
#pragma unroll
        for (int b = 0; b < 2; ++b)
#pragma unroll
            for (int m = 0; m < 4; ++m)
#pragma unroll
                for (int n = 0; n < 2; ++n) acc[a][b][m][n] = (f32x4){0.f, 0.f, 0.f, 0.f};
    bf16x8 At[4][2], B0[2][2], B1[2][2];
    const char* cA = (const char*)g.A + (size_t)cur.pm * tstep; const char* cB = (const char*)g.Bt + (size_t)cur.pn * tstep;
    if constexpr (SP2) {
        PG8_STAGE(PG8_SB(0, 0), cB, voffB); PG8_STAGE(PG8_SB(0, 1), cB + hstep, voffB); PG8_STAGE(PG8_SA(0, 0), cA, voffA); PG8_STAGE(PG8_SA(0, 1), cA + hstep, voffA);
        if (wr == 1) PG8_BAR;
        PG8_WAIT_V(2); PG8_BAR;
        PG8_STAGE(PG8_SB(1, 0), cB + kstep, voffB); PG8_STAGE(PG8_SA(1, 0), cA + kstep, voffA); PG8_STAGE(PG8_SB(1, 1), cB + hstep + kstep, voffB);
        PG8_WAIT_V(6); PG8_BAR;
    } else {
        PG8_STAGE(PG8_SB(0, 0), cB, voffB); PG8_STAGE(PG8_SA(0, 0), cA, voffA); PG8_STAGE(PG8_SB(0, 1), cB + hstep, voffB); PG8_STAGE(PG8_SA(0, 1), cA + hstep, voffA);
        if (wr == 1) PG8_BAR;
        PG8_WAIT_V(4); PG8_BAR;
        PG8_STAGE(PG8_SB(1, 0), cB + kstep, voffB); PG8_STAGE(PG8_SA(1, 0), cA + kstep, voffA); PG8_STAGE(PG8_SB(1, 1), cB + hstep + kstep, voffB);
        PG8_WAIT_V(6); PG8_BAR;
    }
    for (;;) {
        const bool has_next = S.next(ui + 1, nxt);
        const char* nA = has_next ? (const char*)g.A + (size_t)nxt.pm * tstep : cA; const char* nB = has_next ? (const char*)g.Bt + (size_t)nxt.pn * tstep : cB;
#pragma nounroll
        for (int t = 0; t < nt; t += 2) {
            const bool last = (t == nt - 2);
            const char* a1 = cA + (size_t)(t + 1) * kstep;
            const char* a2 = last ? nA : cA + (size_t)(t + 2) * kstep; const char* b2 = last ? nB : cB + (size_t)(t + 2) * kstep;
            const char* a3 = a2 + kstep; const char* b3 = b2 + kstep;
            if constexpr (SP2) {
            PG8_LDB(B0, 0, 0); PG8_LDB(B1, 0, 1); PG8_SCHED; PG8_LDA(At, 0, 0); PG8_STAGE(PG8_SA(1, 1), a1 + hstep, voffA);
            PG8_WAIT_V(8); PG8_WAIT_L(0); PG8_BAR; PG8_MMA(0, 0, At, B0); PG8_MMA(0, 1, At, B1); PG8_BAR; PG8_SCHED;
            PG8_LDA(At, 0, 1); PG8_STAGE(PG8_SB(0, 0), b2, voffB); PG8_STAGE(PG8_SB(0, 1), b2 + hstep, voffB); PG8_STAGE(PG8_SA(0, 0), a2, voffA);
            PG8_WAIT_V(8); PG8_WAIT_L(0); PG8_BAR; PG8_MMA(1, 0, At, B0); PG8_MMA(1, 1, At, B1); PG8_BAR; PG8_SCHED;
            PG8_LDB(B0, 1, 0); PG8_LDB(B1, 1, 1); PG8_SCHED; PG8_LDA(At, 1, 0); PG8_STAGE(PG8_SA(0, 1), a2 + hstep, voffA);
            PG8_WAIT_V(8); PG8_WAIT_L(0); PG8_BAR; PG8_MMA(0, 0, At, B0); PG8_MMA(0, 1, At, B1); PG8_BAR; PG8_SCHED;
            PG8_LDA(At, 1, 1); PG8_STAGE(PG8_SB(1, 0), b3, voffB); PG8_STAGE(PG8_SB(1, 1), b3 + hstep, voffB); PG8_STAGE(PG8_SA(1, 0), a3, voffA);
            PG8_WAIT_V(8); PG8_WAIT_L(0); PG8_BAR; PG8_MMA(1, 0, At, B0); PG8_MMA(1, 1, At, B1); PG8_BAR; PG8_SCHED;
            } else {
            PG8_LDB(B0, 0, 0); PG8_SCHED; PG8_LDA(At, 0, 0); PG8_STAGE(PG8_SA(1, 1), a1 + hstep, voffA);
            PG8_WAIT_L(8); PG8_BAR; PG8_WAIT_L(0); PG8_MMA(0, 0, At, B0); PG8_BAR; PG8_SCHED;
            PG8_LDB(B1, 0, 1); PG8_STAGE(PG8_SB(0, 0), b2, voffB);
            PG8_BAR; PG8_WAIT_L(0); PG8_MMA(0, 1, At, B1); PG8_BAR;
            PG8_LDA(At, 0, 1); PG8_STAGE(PG8_SA(0, 0), a2, voffA);
            PG8_BAR; PG8_WAIT_L(0); PG8_MMA(1, 0, At, B0); PG8_BAR; PG8_SCHED;
            PG8_STAGE(PG8_SB(0, 1), b2 + hstep, voffB);
            PG8_WAIT_V(6); PG8_BAR; PG8_MMA(1, 1, At, B1); PG8_BAR;
            PG8_LDB(B0, 1, 0); PG8_SCHED; PG8_LDA(At, 1, 0); PG8_STAGE(PG8_SA(0, 1), a2 + hstep, voffA);
            PG8_WAIT_L(8); PG8_BAR; PG8_WAIT_L(0); PG8_MMA(0, 0, At, B0); PG8_BAR; PG8_SCHED;
            PG8_LDB(B1, 1, 1); PG8_STAGE(PG8_SB(1, 0), b3, voffB);
            PG8_BAR; PG8_WAIT_L(0); PG8_MMA(0, 1, At, B1); PG8_BAR;
            PG8_LDA(At, 1, 1); PG8_STAGE(PG8_SA(1, 0), a3, voffA);
            PG8_BAR; PG8_WAIT_L(0); PG8_MMA(1, 0, At, B0); PG8_BAR; PG8_SCHED;
            PG8_STAGE(PG8_SB(1, 1), b3 + hstep, voffB);
            PG8_WAIT_V(6); PG8_BAR; PG8_MMA(1, 1, At, B1); PG8_BAR;
            }
        }
        if constexpr (ALIGN_EPI) { if (wr == 0) PG8_BAR; }
        if constexpr (!Epi::AFTER_DRAIN) { E(acc, cur, wr, wc, fr, fq); }
        if (!has_next) break;
#pragma unroll
        for (int a = 0; a < 2; ++a)
#pragma unroll
            for (int b = 0; b < 2; ++b)
#pragma unroll
                for (int m = 0; m < 4; ++m)
#pragma unroll
                    for (int n = 0; n < 2; ++n) acc[a][b][m][n] = (f32x4){0.f, 0.f, 0.f, 0.f};
        cur = nxt; cA = nA; cB = nB; ++ui;
        if constexpr (ALIGN_EPI) { if (wr == 1) PG8_BAR; }
    }
    PG8_WAIT_V(0);
    if constexpr (!ALIGN_EPI) { if (wr == 0) PG8_BAR; }
    PG8_BAR;
    if constexpr (Epi::AFTER_DRAIN) { E.fused(acc, cur, wr, wc, fr, fq, lds, wid, lane); }
#undef PG8_SA
#undef PG8_SB
#undef PG8_STAGE
#undef PG8_LDA
#undef PG8_LDB
#undef PG8_MMA
#undef PG8_WAIT_V
#undef PG8_WAIT_L
#undef PG8_BAR
#undef PG8_SCHED
}
}
using pg8::Unit; using pg8::cvt_pk_bf16;
typedef f32x4 AccT[2][2][4][2];

__device__ __forceinline__ u32x4 pack8(const f32x4 v0, const f32x4 v1) { u32x4 w; w.x = cvt_pk_bf16(v0[0], v0[1]); w.y = cvt_pk_bf16(v0[2], v0[3]); w.z = cvt_pk_bf16(v1[0], v1[1]); w.w = cvt_pk_bf16(v1[2], v1[3]); return w; }

struct EpiProj {
    static constexpr bool AFTER_DRAIN = false;
    bf16_t *uv, *zs, *xbc;
    __device__ __forceinline__ void operator()(const AccT& acc, const Unit& u, int wr, int wc, int fr, int fq) const {
        const int row0 = u.pm * 256 + wr * 64 + fr; const int ct = wc * 32 + 8 * fq;
        bf16_t* base; int ld, mode;
        if (u.pn < 16) { base = uv + u.pn * 256; ld = DMIX; mode = 0; }
        else if (u.pn < 24) { base = zs + (u.pn - 16) * 256; ld = DSSM; mode = 1; }
        else { base = xbc + (u.pn - 24) * 256; ld = DXBC; mode = 2; }
#pragma unroll
        for (int ai = 0; ai < 2; ++ai)
#pragma unroll
            for (int m = 0; m < 4; ++m) { bf16_t* rowp = base + (size_t)(row0 + ai * 128 + m * 16) * ld + ct;
#pragma unroll
                for (int bj = 0; bj < 2; ++bj) { f32x4 v0 = acc[ai][bj][m][0], v1 = acc[ai][bj][m][1];
                    if (mode == 0) {
#pragma unroll
                        for (int j = 0; j < 4; ++j) { v0[j] = gelu_tanh_f(v0[j]); v1[j] = gelu_tanh_f(v1[j]); } }
                    else if (mode == 1) {
#pragma unroll
                        for (int j = 0; j < 4; ++j) { v0[j] = silu_f(v0[j]); v1[j] = silu_f(v1[j]); } }
                    *(u32x4*)(rowp + bj * 128) = pack8(v0, v1); } }
    }
};
struct EpiPlain {
    static constexpr bool AFTER_DRAIN = false;
    bf16_t* O; int ld;
    __device__ __forceinline__ void operator()(const AccT& acc, const Unit& u, int wr, int wc, int fr, int fq) const {
        const int row0 = u.pm * 256 + wr * 64 + fr; const int col0 = u.pn * 256 + wc * 32 + 8 * fq;
#pragma unroll
        for (int ai = 0; ai < 2; ++ai)
#pragma unroll
            for (int m = 0; m < 4; ++m) { bf16_t* rowp = O + (size_t)(row0 + ai * 128 + m * 16) * ld + col0;
#pragma unroll
                for (int bj = 0; bj < 2; ++bj) *(u32x4*)(rowp + bj * 128) = pack8(acc[ai][bj][m][0], acc[ai][bj][m][1]); }
    }
};
struct EpiResid {
    static constexpr bool AFTER_DRAIN = true;
    const float* base; float* out; bf16_t* hn; bf16_t* halo; const float* gain; float* ssq;
    __device__ __forceinline__ void fused(AccT& acc, const Unit& u, int wr, int wc, int fr, int fq, LAS unsigned char* lds, int wid, int lane) const {
        asm volatile("" : "+v"(fr), "+v"(fq));
        LAS float* P = (LAS float*)lds;
        const int col0 = u.pn * 256 + wc * 32 + 8 * fq;
#pragma unroll
        for (int ai = 0; ai < 2; ++ai)
#pragma unroll
            for (int m = 0; m < 4; ++m) { const int rl = ai * 128 + wr * 64 + m * 16 + fr; const int row = u.pm * 256 + rl; const size_t off = (size_t)row * D + col0;
                float ss = 0.f;
                bf16_t* hrow = nullptr;
                if (halo) { const int r6 = row & 63; if (r6 >= 62) { if ((row >> 6) <= 126) hrow = halo + (size_t)(4 * (row >> 6) + (row & 1)) * D; } else if (r6 < 2 && row >= 64) hrow = halo + (size_t)(4 * ((row >> 6) - 1) + 2 + (row & 1)) * D; }
#pragma unroll
                for (int bj = 0; bj < 2; ++bj) { const f32x4 b0 = *(const f32x4*)(base + off + bj * 128), b1 = *(const f32x4*)(base + off + bj * 128 + 4);
                    const f32x4 v0 = acc[ai][bj][m][0] + b0, v1 = acc[ai][bj][m][1] + b1;
                    *(f32x4*)(out + off + bj * 128) = v0; *(f32x4*)(out + off + bj * 128 + 4) = v1;
                    ss += (v0[0] * v0[0] + v0[1] * v0[1]) + (v0[2] * v0[2] + v0[3] * v0[3]) + (v1[0] * v1[0] + v1[1] * v1[1]) + (v1[2] * v1[2] + v1[3] * v1[3]);
                    const f32x4 g0 = *(const f32x4*)(gain + col0 + bj * 128), g1 = *(const f32x4*)(gain + col0 + bj * 128 + 4);
                    const u32x4 w = pack8(v0 * g0, v1 * g1);
                    *(u32x4*)(hn + off + bj * 128) = w;
                    if (hrow) *(u32x4*)(hrow + col0 + bj * 128) = w; }
                ss += __shfl_xor(ss, 16); ss += __shfl_xor(ss, 32);
                if (fq == 0) P[rl * 4 + wc] = ss;
                asm volatile("" ::: "memory"); }
        __syncthreads();
        if (threadIdx.x < 256) { const int t = threadIdx.x; ssq[(size_t)(u.pm * 256 + t) * 8 + u.pn] = (P[t * 4 + 0] + P[t * 4 + 1]) + (P[t * 4 + 2] + P[t * 4 + 3]); }
        __syncthreads();
    }
};
struct EpiPle {
    static constexpr bool AFTER_DRAIN = true;
    float* out; const bf16_t* Eb; const float* ssq_in; float* ssq;
    __device__ __forceinline__ void fused(AccT& acc, const Unit& u, int wr, int wc, int fr, int fq, LAS unsigned char* lds, int wid, int lane) const {
        asm volatile("" : "+v"(fr), "+v"(fq));
        LAS float* P = (LAS float*)lds;
        const int col0 = u.pn * 256 + wc * 32 + 8 * fq;
#pragma unroll
        for (int ai = 0; ai < 2; ++ai)
#pragma unroll
            for (int m = 0; m < 4; ++m) { const int rl = ai * 128 + wr * 64 + m * 16 + fr; const int row = u.pm * 256 + rl; const size_t off = (size_t)row * D + col0;
                const f32x4 q0 = *(const f32x4*)(ssq_in + (size_t)row * 8), q1 = *(const f32x4*)(ssq_in + (size_t)row * 8 + 4);
                const float rinv = 1.0f / sqrtf(((q0[0] + q0[1]) + (q0[2] + q0[3]) + (q1[0] + q1[1]) + (q1[2] + q1[3])) * (1.0f / D) + EPS);
                float ss = 0.f;
#pragma unroll
                for (int bj = 0; bj < 2; ++bj) { const f32x4 b0 = *(const f32x4*)(out + off + bj * 128), b1 = *(const f32x4*)(out + off + bj * 128 + 4);
                    const u32x4 ew = *(const u32x4*)(Eb + off + bj * 128);
                    f32x4 e0 = {bflo(ew.x), bfhi(ew.x), bflo(ew.y), bfhi(ew.y)}, e1 = {bflo(ew.z), bfhi(ew.z), bflo(ew.w), bfhi(ew.w)};
                    f32x4 v0, v1;
#pragma unroll
                    for (int j = 0; j < 4; ++j) { v0[j] = b0[j] + fast_sigmoid(acc[ai][bj][m][0][j] * rinv) * e0[j]; v1[j] = b1[j] + fast_sigmoid(acc[ai][bj][m][1][j] * rinv) * e1[j]; }
                    *(f32x4*)(out + off + bj * 128) = v0; *(f32x4*)(out + off + bj * 128 + 4) = v1;
                    ss += (v0[0] * v0[0] + v0[1] * v0[1]) + (v0[2] * v0[2] + v0[3] * v0[3]) + (v1[0] * v1[0] + v1[1] * v1[1]) + (v1[2] * v1[2] + v1[3] * v1[3]); }
                ss += __shfl_xor(ss, 16); ss += __shfl_xor(ss, 32);
                if (fq == 0) P[rl * 4 + wc] = ss;
                asm volatile("" ::: "memory"); }
        __syncthreads();
        if (threadIdx.x < 256) { const int t = threadIdx.x; ssq[(size_t)(u.pm * 256 + t) * 8 + u.pn] = (P[t * 4 + 0] + P[t * 4 + 1]) + (P[t * 4 + 2] + P[t * 4 + 3]); }
        __syncthreads();
    }
};
struct EpiFfn {
    static constexpr bool AFTER_DRAIN = false;
    bf16_t* act; const float* ssq1; const float* cw; const float* cb;
    __device__ __forceinline__ int grow_of(const Unit& u, int rl) const {
        if (u.pm < 32) return u.pm * 256 + rl;
        const int R = (u.pm - 32) * 256 + rl; int q = (R >> 2) + 1; if (q > 127) q = 127; return 64 * q - 2 + (R & 3);
    }
    __device__ __forceinline__ void operator()(AccT& acc, const Unit& u, int wr, int wc, int fr, int fq) const {
        asm volatile("" : "+v"(fr), "+v"(fq));
        const bool halo = u.pm >= 32;
        const int lane = fq * 16 + fr;
        const int s1 = (lane & 48) | ((fr + 15) & 15), s2 = (lane & 48) | ((fr + 14) & 15);
#pragma unroll
        for (int ai = 0; ai < 2; ++ai)
#pragma unroll
            for (int m = 0; m < 4; ++m) {
                const int gr = grow_of(u, ai * 128 + wr * 64 + m * 16 + fr);
                const f32x4 q0 = *(const f32x4*)(ssq1 + (size_t)gr * 8), q1 = *(const f32x4*)(ssq1 + (size_t)gr * 8 + 4);
                const float rinv = 1.0f / sqrtf(((q0[0] + q0[1]) + (q0[2] + q0[3]) + (q1[0] + q1[1]) + (q1[2] + q1[3])) * (1.0f / D) + EPS);
#pragma unroll
                for (int bj = 0; bj < 2; ++bj)
#pragma unroll
                    for (int n = 0; n < 2; ++n) acc[ai][bj][m][n] = acc[ai][bj][m][n] * rinv;
                asm volatile("" ::: "memory");
            }
#pragma unroll
        for (int n = 0; n < 2; ++n) {
            const int gc = u.pn * 128 + wc * 32 + 8 * fq + 4 * n;
#pragma unroll
            for (int bj = 0; bj < 2; ++bj) {
                const int cc = bj * DFF + gc;
                asm volatile("" ::: "memory");
                const f32x4 w0 = *(const f32x4*)(cw + cc), w1 = *(const f32x4*)(cw + 2 * DFF + cc), w2 = *(const f32x4*)(cw + 4 * DFF + cc), bb = *(const f32x4*)(cb + cc);
#pragma unroll
                for (int ai = 0; ai < 2; ++ai) {
                    f32x4 p1 = {0.f, 0.f, 0.f, 0.f}, p2 = p1;
#pragma unroll
                    for (int m = 0; m < 4; ++m) {
                        f32x4 v = acc[ai][bj][m][n];
                        asm volatile("" : "+v"(v));
                        f32x4 r1, r2, hh;
#pragma unroll
                        for (int j = 0; j < 4; ++j) { r1[j] = __shfl(v[j], s1); r2[j] = __shfl(v[j], s2); }
#pragma unroll
                        for (int j = 0; j < 4; ++j) { const float x1 = fr >= 1 ? r1[j] : p1[j], x2 = fr >= 2 ? r2[j] : p2[j]; hh[j] = bb[j] + w2[j] * v[j] + w1[j] * x1 + w0[j] * x2; }
                        asm volatile("" : "+v"(hh));
                        acc[ai][bj][m][n] = hh; p1 = r1; p2 = r2;
                    }
                }
            }
            asm volatile("" ::: "memory");
#pragma unroll
            for (int ai = 0; ai < 2; ++ai)
#pragma unroll
                for (int m = 0; m < 4; ++m) {
                    const int rl = ai * 128 + wr * 64 + m * 16 + fr;
                    bool st;
                    if (!halo) st = !(m == 0 && fr < 2) || (u.pm == 0 && ai == 0 && wr == 0);
                    else st = ((fr & 3) >= 2) && ((((u.pm - 32) * 256 + rl) >> 2) + 1 <= 127);
                    if (st) { const f32x4 hg_ = acc[ai][0][m][n], hu_ = acc[ai][1][m][n];
                        u32x2 w; w.x = cvt_pk_bf16(silu_f(hg_[0]) * hu_[0], silu_f(hg_[1]) * hu_[1]); w.y = cvt_pk_bf16(silu_f(hg_[2]) * hu_[2], silu_f(hg_[3]) * hu_[3]);
                        *(u32x2*)(act + (size_t)grow_of(u, rl) * DFF + gc) = w; }
                }
        }
    }
};

struct Ctx {
    LAS unsigned char* lds;
    int tid, lane, wave, nb, bid;
    const float* const* in;
    float* out;
    unsigned char* ws;
};

template <int MODE>
__device__ __forceinline__ void prep_w_item(const float* __restrict__ W, int K, int N, bf16_t* __restrict__ Wt, LAS float* scr, int item, int lane) {
    const int nblk = N / 32, kb = item / nblk, nb = item % nblk, k0 = 64 * kb, n0 = 32 * nb;
    int orow = n0;
    if (MODE == 1) orow = (n0 < DFF) ? 256 * (n0 >> 7) + (n0 & 127) : 256 * ((n0 - DFF) >> 7) + 128 + ((n0 - DFF) & 127);
    const float* src = W + (size_t)(k0 + (lane >> 5)) * N + n0 + (lane & 31);
    float v[32];
#pragma unroll
    for (int i = 0; i < 32; ++i) v[i] = __builtin_nontemporal_load(src + (size_t)(2 * i) * N);
#pragma unroll
    for (int i = 0; i < 32; ++i) scr[(2 * i + (lane >> 5)) * 33 + (lane & 31)] = v[i];
    asm volatile("s_waitcnt lgkmcnt(0)" ::: "memory");
    const int cchunk = lane & 7;
#pragma unroll
    for (int j = 0; j < 4; ++j) { const int n = (lane >> 3) + 8 * j; const LAS float* sp = scr + (8 * cchunk) * 33 + n;
        u32x4 o; o.x = pk2(sp[0 * 33], sp[1 * 33]); o.y = pk2(sp[2 * 33], sp[3 * 33]); o.z = pk2(sp[4 * 33], sp[5 * 33]); o.w = pk2(sp[6 * 33], sp[7 * 33]);
        *(u32x4*)(Wt + (size_t)(orow + n) * K + k0 + 8 * cchunk) = o; }
    asm volatile("s_waitcnt lgkmcnt(0)" ::: "memory");
}
__device__ __forceinline__ void phase_prep(const Ctx& c) {
    const int gw = c.bid * 8 + c.wave, NGW = c.nb * 8;
    const float* w_in = c.in[3]; const float* w_out = c.in[15]; const float* w_up = c.in[17]; const float* w_dn = c.in[20]; const float* w_pg = c.in[22]; const float* w_ple = c.in[23];
    LAS float* scr = (LAS float*)(c.lds + c.wave * 16384);
    constexpr int I_IN = (D / 64) * (DIN / 32), I_OUT = (DMIX / 64) * (D / 32), I_UP = (D / 64) * (2 * DFF / 32), I_DN = (DFF / 64) * (D / 32), I_PG = (D / 64) * (D / 32), I_PLE = (DPLE / 64) * (D / 32);
    constexpr int NIT = I_IN + I_OUT + I_UP + I_DN + I_PG + I_PLE;
#pragma unroll 1
    for (int it = gw; it < NIT; it += NGW) {
        int r = it;
        if (r < I_IN) { prep_w_item<0>(w_in, D, DIN, (bf16_t*)(c.ws + WS_WIN), scr, r, c.lane); continue; } r -= I_IN;
        if (r < I_UP) { prep_w_item<1>(w_up, D, 2 * DFF, (bf16_t*)(c.ws + WS_WUP), scr, r, c.lane); continue; } r -= I_UP;
        if (r < I_OUT) { prep_w_item<0>(w_out, DMIX, D, (bf16_t*)(c.ws + WS_WOUT), scr, r, c.lane); continue; } r -= I_OUT;
        if (r < I_DN) { prep_w_item<0>(w_dn, DFF, D, (bf16_t*)(c.ws + WS_WDN), scr, r, c.lane); continue; } r -= I_DN;
        if (r < I_PG) { prep_w_item<0>(w_pg, D, D, (bf16_t*)(c.ws + WS_WPG), scr, r, c.lane); continue; } r -= I_PG;
        prep_w_item<0>(w_ple, DPLE, D, (bf16_t*)(c.ws + WS_WPLE), scr, r, c.lane);
    }
    const float* x = c.in[0]; const float* g = c.in[2]; bf16_t* A = (bf16_t*)(c.ws + WS_A);
    for (int m = gw * 2; m < S; m += NGW * 2) {
        const float* xr = x + (size_t)m * D + 8 * c.lane; f32x4 v[2][4][2]; float s0 = 0.f, s1 = 0.f;
#pragma unroll
        for (int rr = 0; rr < 2; ++rr)
#pragma unroll
            for (int j = 0; j < 4; ++j) { v[rr][j][0] = __builtin_nontemporal_load((const f32x4*)(xr + (size_t)rr * D + 512 * j)); v[rr][j][1] = __builtin_nontemporal_load((const f32x4*)(xr + (size_t)rr * D + 512 * j + 4)); }
#pragma unroll
        for (int j = 0; j < 4; ++j)
#pragma unroll
            for (int e = 0; e < 4; ++e) { s0 += v[0][j][0][e] * v[0][j][0][e] + v[0][j][1][e] * v[0][j][1][e]; s1 += v[1][j][0][e] * v[1][j][0][e] + v[1][j][1][e] * v[1][j][1][e]; }
#pragma unroll
        for (int o = 1; o < 64; o <<= 1) { s0 += __shfl_xor(s0, o); s1 += __shfl_xor(s1, o); }
        const float ri[2] = {1.0f / sqrtf(s0 * (1.0f / D) + EPS), 1.0f / sqrtf(s1 * (1.0f / D) + EPS)};
#pragma unroll
        for (int j = 0; j < 4; ++j) { const f32x4 g0 = *(const f32x4*)(g + 8 * c.lane + 512 * j), g1 = *(const f32x4*)(g + 8 * c.lane + 512 * j + 4);
#pragma unroll
            for (int rr = 0; rr < 2; ++rr) { const f32x4 a0 = v[rr][j][0] * ri[rr] * g0, a1 = v[rr][j][1] * ri[rr] * g1;
                u32x4 o; o.x = pk2(a0[0], a0[1]); o.y = pk2(a0[2], a0[3]); o.z = pk2(a1[0], a1[1]); o.w = pk2(a1[2], a1[3]);
                *(u32x4*)(A + (size_t)(m + rr) * D + 8 * c.lane + 512 * j) = o; } }
    }
    const float* p = c.in[1]; bf16_t* P16 = (bf16_t*)(c.ws + WS_P16);
    for (size_t i = ((size_t)c.bid * 512 + c.tid) * 8; i < (size_t)S * DPLE; i += (size_t)c.nb * 512 * 8) {
        const f32x4 a0 = *(const f32x4*)(p + i), a1 = *(const f32x4*)(p + i + 4);
        u32x4 o; o.x = pk2(a0[0], a0[1]); o.y = pk2(a0[2], a0[3]); o.z = pk2(a1[0], a1[1]); o.w = pk2(a1[2], a1[3]);
        *(u32x4*)(P16 + i) = o;
    }
}

__device__ __forceinline__ void phase_dt(const Ctx& c) {
    const bf16_t* A = (const bf16_t*)(c.ws + WS_A); const bf16_t* Wdt = (const bf16_t*)(c.ws + WS_WIN) + (size_t)10240 * D;
    float* dt = (float*)(c.ws + WS_DT); const float* dtb = c.in[11];
    LAS float* red = (LAS float*)c.lds;
    const int r = c.lane & 31, h = c.lane >> 5;
    for (int item = c.bid; item < S / 32; item += c.nb) {
        const int row0 = item * 32;
        f32x16 acc; for (int i = 0; i < 16; ++i) acc[i] = 0.f;
        const bf16_t* ap = A + (size_t)(row0 + r) * D + c.wave * 256 + 8 * h;
        const bf16_t* bp = Wdt + (size_t)r * D + c.wave * 256 + 8 * h;
#pragma unroll 4
        for (int s = 0; s < 16; ++s) { const bf16x8 af = *(const bf16x8*)(ap + 16 * s), bfr = *(const bf16x8*)(bp + 16 * s);
            acc = __builtin_amdgcn_mfma_f32_32x32x16_bf16(af, bfr, acc, 0, 0, 0); }
#pragma unroll
        for (int i = 0; i < 16; ++i) red[(c.wave * 32 + ((i & 3) + 8 * (i >> 2) + 4 * h)) * 32 + r] = acc[i];
        __syncthreads();
        for (int o = c.tid; o < 1024; o += 512) { float s = 0.f;
#pragma unroll
            for (int w = 0; w < 8; ++w) s += red[w * 1024 + o];
            const int hd = o & 31; const float xv = s + dtb[hd];
            const float sp = xv > 20.f ? xv : log1pf(__expf(xv));
            dt[(size_t)(row0 + (o >> 5)) * 32 + hd] = sp; }
        __syncthreads();
    }
}

template <int W>
__device__ __forceinline__ void stage_conv_tile(const Ctx& c, LAS unsigned char* dst, int pitchB, int col0, int t0, const LAS float* scale) {
    const bf16_t* xbc = (const bf16_t*)(c.ws + WS_XBC); const float* cw = c.in[9]; const float* cb = c.in[10];
    constexpr int NCHK = W / 8, NGRPS = 512 / NCHK, RPT = 128 / NGRPS;
    const int ch = c.tid % NCHK, grp = c.tid / NCHK; const int cc = col0 + ch * 8;
    float w[4][8], b[8];
#pragma unroll
    for (int k = 0; k < 4; ++k) { const f32x4 a0 = *(const f32x4*)(cw + (size_t)k * DXBC + cc), a1 = *(const f32x4*)(cw + (size_t)k * DXBC + cc + 4);
#pragma unroll
        for (int e = 0; e < 4; ++e) { w[k][e] = a0[e]; w[k][4 + e] = a1[e]; } }
    { const f32x4 a0 = *(const f32x4*)(cb + cc), a1 = *(const f32x4*)(cb + cc + 4);
#pragma unroll
      for (int e = 0; e < 4; ++e) { b[e] = a0[e]; b[4 + e] = a1[e]; } }
    const int r0 = grp * RPT;
    float x0[8], x1[8], x2[8];
#pragma unroll
    for (int e = 0; e < 8; ++e) { x0[e] = 0.f; x1[e] = 0.f; x2[e] = 0.f; }
    {
        const int t = t0 + r0;
        if (t - 3 >= 0) { const u32x4 q = *(const u32x4*)(xbc + (size_t)(t - 3) * DXBC + cc); x0[0] = bflo(q.x); x0[1] = bfhi(q.x); x0[2] = bflo(q.y); x0[3] = bfhi(q.y); x0[4] = bflo(q.z); x0[5] = bfhi(q.z); x0[6] = bflo(q.w); x0[7] = bfhi(q.w); }
        if (t - 2 >= 0) { const u32x4 q = *(const u32x4*)(xbc + (size_t)(t - 2) * DXBC + cc); x1[0] = bflo(q.x); x1[1] = bfhi(q.x); x1[2] = bflo(q.y); x1[3] = bfhi(q.y); x1[4] = bflo(q.z); x1[5] = bfhi(q.z); x1[6] = bflo(q.w); x1[7] = bfhi(q.w); }
        if (t - 1 >= 0) { const u32x4 q = *(const u32x4*)(xbc + (size_t)(t - 1) * DXBC + cc); x2[0] = bflo(q.x); x2[1] = bfhi(q.x); x2[2] = bflo(q.y); x2[3] = bfhi(q.y); x2[4] = bflo(q.z); x2[5] = bfhi(q.z); x2[6] = bflo(q.w); x2[7] = bfhi(q.w); }
    }
#pragma unroll
    for (int i = 0; i < RPT; ++i) {
        const int rl = r0 + i, t = t0 + rl;
        const u32x4 q = *(const u32x4*)(xbc + (size_t)t * DXBC + cc);
        float x3[8]; x3[0] = bflo(q.x); x3[1] = bfhi(q.x); x3[2] = bflo(q.y); x3[3] = bfhi(q.y); x3[4] = bflo(q.z); x3[5] = bfhi(q.z); x3[6] = bflo(q.w); x3[7] = bfhi(q.w);
        float sc = 1.f; if (scale) sc = scale[rl * 4 + (ch * 8) / 64];
        float o[8];
#pragma unroll
        for (int e = 0; e < 8; ++e) { const float hsum = b[e] + w[0][e] * x0[e] + w[1][e] * x1[e] + w[2][e] * x2[e] + w[3][e] * x3[e]; o[e] = silu_f(hsum) * sc; x0[e] = x1[e]; x1[e] = x2[e]; x2[e] = x3[e]; }
        u32x4 ov; ov.x = pk2(o[0], o[1]); ov.y = pk2(o[2], o[3]); ov.z = pk2(o[4], o[5]); ov.w = pk2(o[6], o[7]);
        *(LAS u32x4*)(dst + rl * pitchB + ch * 16) = ov;
    }
}

__device__ __forceinline__ void ssd_tables(const Ctx& c, int ck, int g, LAS float* sdt, LAS float* sacs) {
    const float* dt = (const float*)(c.ws + WS_DT); const float* alog = c.in[12];
    { const int l = c.tid >> 2, h = c.tid & 3; const float dv = dt[(size_t)(ck * 128 + l) * 32 + g * 4 + h]; sdt[l * 4 + h] = dv; sacs[l * 4 + h] = dv * (-__expf(alog[g * 4 + h])); }
    __syncthreads();
    if (c.wave < 4) { const int h = c.wave; const float v0 = sacs[(2 * c.lane) * 4 + h], v1 = sacs[(2 * c.lane + 1) * 4 + h]; float s = v0 + v1;
#pragma unroll
        for (int d = 1; d < 64; d <<= 1) { const float t = __shfl_up(s, d); if (c.lane >= d) s += t; }
        const float ex = s - (v0 + v1);
        sacs[(2 * c.lane) * 4 + h] = ex + v0; sacs[(2 * c.lane + 1) * 4 + h] = s; }
    __syncthreads();
}

constexpr int XS_PITCH = 576, BC_PITCH = 320;
constexpr int L_XS = 0, L_B = 128 * XS_PITCH, L_C = L_B + 128 * BC_PITCH, L_TAB = L_C + 128 * BC_PITCH;
constexpr int L_SDT = L_TAB, L_SACS = L_TAB + 2048, L_SW = L_TAB + 4096, L_MISC = L_TAB + 6144;
static_assert(L_MISC + 2048 <= LDS_BYTES, "mixer LDS map");

__device__ __forceinline__ void ssd_a_item(const Ctx& c, int ck, int g) {
    LAS float* sdt = (LAS float*)(c.lds + L_SDT); LAS float* sacs = (LAS float*)(c.lds + L_SACS); LAS float* sw = (LAS float*)(c.lds + L_SW);
    ssd_tables(c, ck, g, sdt, sacs);
    { const int l = c.tid >> 2, h = c.tid & 3; sw[l * 4 + h] = sdt[l * 4 + h] * __expf(sacs[127 * 4 + h] - sacs[l * 4 + h]); }
    if (c.tid < 4) ((float*)(c.ws + WS_CDEC))[ck * 32 + g * 4 + c.tid] = __expf(sacs[127 * 4 + c.tid]);
    __syncthreads();
    stage_conv_tile<256>(c, c.lds + L_XS, XS_PITCH, g * 256, ck * 128, sw);
    stage_conv_tile<128>(c, c.lds + L_B, BC_PITCH, DSSM + g * 128, ck * 128, nullptr);
    __syncthreads();
    bf16_t* st = (bf16_t*)(c.ws + WS_ST) + (size_t)(ck * 32 + g * 4) * 64 * 128;
    for (int o = c.tid; o < 4 * 64 * 128; o += 512) { const int n = o & 127, hp = o >> 7; float s = 0.f;
        for (int l = 0; l < 128; ++l) s += bf2f(*(LAS bf16_t*)(c.lds + L_B + l * BC_PITCH + n * 2)) * bf2f(*(LAS bf16_t*)(c.lds + L_XS + l * XS_PITCH + hp * 2));
        st[o] = (bf16_t)f2bf(s); }
    __syncthreads();
}

__device__ __forceinline__ void gmlp_item(const Ctx& c, int ck, int g) {
    bf16_t* uv = (bf16_t*)(c.ws + WS_UV);
    LAS float* vn = (LAS float*)c.lds;
    LAS float* ssq = (LAS float*)(c.lds + 65536);
    const float* lng = c.in[4] + g * 128; const float* lnb = c.in[5] + g * 128; const float* Ws = c.in[6] + (size_t)g * 128 * 128; const float* bs = c.in[7] + g * 128; const float* nag = c.in[8] + g * 128;
    for (int s = c.wave; s < 128; s += 8) {
        const bf16_t* vr = uv + (size_t)(ck * 128 + s) * DMIX + DA + g * 128;
        const float a0 = bf2f(vr[c.lane]), a1 = bf2f(vr[c.lane + 64]);
        const float mu = wave_sum(a0 + a1) * (1.0f / 128.0f); const float d0 = a0 - mu, d1 = a1 - mu;
        const float var = wave_sum(d0 * d0 + d1 * d1) * (1.0f / 128.0f); const float rs = 1.0f / sqrtf(var + EPS);
        vn[s * 128 + c.lane] = d0 * rs * lng[c.lane] + lnb[c.lane]; vn[s * 128 + c.lane + 64] = d1 * rs * lng[c.lane + 64] + lnb[c.lane + 64];
    }
    __syncthreads();
    const int d = c.tid & 127;
    for (int j = 0; j < 32; ++j) {
        const int t = (c.tid >> 7) + 4 * j; float sg = bs[t]; const float* wr_ = Ws + t * 128;
        for (int s = 0; s <= t; ++s) sg += wr_[s] * vn[s * 128 + d];
        bf16_t* up = uv + (size_t)(ck * 128 + t) * DMIX + g * 128 + d;
        const float y = bf2f(*up) * sg;
        *up = (bf16_t)f2bf(y * nag[d]);
        const float q = wave_sum(y * y);
        if (c.lane == 0) ssq[t * 2 + (c.wave & 1)] = q;
    }
    __syncthreads();
    if (c.tid < 128) ((float*)(c.ws + WS_SSQA))[(size_t)(ck * 128 + c.tid) * 16 + g] = ssq[c.tid * 2] + ssq[c.tid * 2 + 1];
    __syncthreads();
}

typedef short s16x4 __attribute__((ext_vector_type(4)));
typedef short v4i16_t __attribute__((ext_vector_type(4)));
__device__ __forceinline__ s16x4 ds_tr(LAS const unsigned char* p) { return __builtin_bit_cast(s16x4, __builtin_amdgcn_ds_read_tr16_b64_v4i16((LAS v4i16_t*)p)); }
__device__ __forceinline__ bf16x8 frag_tr(LAS const unsigned char* tile, int pitch, int k0, int c0, int lane) {
    const int hh = lane >> 5, blk = (lane >> 4) & 1, q = (lane & 15) >> 2, p = lane & 3;
    LAS const unsigned char* a = tile + (k0 + 8 * hh + q) * pitch + (c0 + 16 * blk + 4 * p) * 2;
    const s16x4 lo = ds_tr(a), hi = ds_tr(a + 4 * pitch);
    return __builtin_shufflevector(lo, hi, 0, 1, 2, 3, 4, 5, 6, 7);
}
__device__ __forceinline__ bf16x8 frag_tr_perm(LAS const unsigned char* tile, int pitch, int k0, int c0, int lane) {
    const int hh = lane >> 5, blk = (lane >> 4) & 1, q = (lane & 15) >> 2, p = lane & 3;
    LAS const unsigned char* a = tile + (k0 + 4 * hh + q) * pitch + (c0 + 16 * blk + 4 * p) * 2;
    const s16x4 lo = ds_tr(a), hi = ds_tr(a + 8 * pitch);
    return __builtin_shufflevector(lo, hi, 0, 1, 2, 3, 4, 5, 6, 7);
}
__device__ __forceinline__ bf16x8 frag_row(LAS const unsigned char* tile, int pitch, int r0, int k0, int lane) {
    return *(LAS const bf16x8*)(tile + (r0 + (lane & 31)) * pitch + (k0 + 8 * (lane >> 5)) * 2);
}
__device__ __forceinline__ bf16x8 pack_frag(const float* v) {
    u32x4 w; w.x = cvt_pk_bf16(v[0], v[1]); w.y = cvt_pk_bf16(v[2], v[3]); w.z = cvt_pk_bf16(v[4], v[5]); w.w = cvt_pk_bf16(v[6], v[7]);
    return __builtin_bit_cast(bf16x8, w);
}
#define MFMA32(a, b, c) __builtin_amdgcn_mfma_f32_32x32x16_bf16((a), (b), (c), 0, 0, 0)

constexpr int G_WP = 272, G_VP = 320, G_SGP = 528, GL_WS = 0, GL_VT = 128 * G_WP, GL_SG = GL_VT + 128 * G_VP;
static_assert(GL_SG + 128 * G_SGP <= 155648, "gMLP LDS map");
__device__ __forceinline__ void gmlp_stage_ws(const Ctx& c, int g) {
    const float* Ws = c.in[6] + (size_t)g * 128 * 128;
#pragma unroll
    for (int i = 0; i < 4; ++i) { const int idx = c.tid + 512 * i, t = idx >> 4, s8 = (idx & 15) * 8;
        const f32x4 w0 = *(const f32x4*)(Ws + t * 128 + s8), w1 = *(const f32x4*)(Ws + t * 128 + s8 + 4);
        float wv[8];
#pragma unroll
        for (int j = 0; j < 4; ++j) { wv[j] = (s8 + j <= t) ? w0[j] : 0.f; wv[4 + j] = (s8 + 4 + j <= t) ? w1[j] : 0.f; }
        *(LAS bf16x8*)(c.lds + GL_WS + t * G_WP + s8 * 2) = pack_frag(wv); }
}
__device__ __forceinline__ void gmlp_load_v(const Ctx& c, int ck, int g, u32x4 (&vr)[4]) {
    const bf16_t* uv = (const bf16_t*)(c.ws + WS_UV);
#pragma unroll
    for (int i = 0; i < 4; ++i) { const int row = (c.tid >> 4) + 32 * i; vr[i] = *(const u32x4*)(uv + (size_t)(ck * 128 + row) * DMIX + DA + g * 128 + (c.tid & 15) * 8); }
}
__device__ __forceinline__ void gmlp_items(const Ctx& c, int g, int ck0, int ckstep, int nitems) {
    bf16_t* uv = (bf16_t*)(c.ws + WS_UV);
    LAS unsigned char* vt = c.lds + GL_VT;
    const float* lng = c.in[4] + g * 128; const float* lnb = c.in[5] + g * 128; const float* bs = c.in[7] + g * 128; const float* nag = c.in[8] + g * 128;
    const int lane = c.lane, d8 = (c.tid & 15) * 8;
    gmlp_stage_ws(c, g);
    const f32x4 lg0 = *(const f32x4*)(lng + d8), lg1 = *(const f32x4*)(lng + d8 + 4), lb0 = *(const f32x4*)(lnb + d8), lb1 = *(const f32x4*)(lnb + d8 + 4);
    u32x4 vr[4];
    gmlp_load_v(c, ck0, g, vr);
    const int db = c.wave & 3, hh = lane >> 5, r = lane & 31;
    for (int it = 0; it < nitems; ++it) {
        const int ck = ck0 + it * ckstep;
#pragma unroll
        for (int i = 0; i < 4; ++i) { const int row = (c.tid >> 4) + 32 * i;
            float x[8] = {bflo(vr[i].x), bfhi(vr[i].x), bflo(vr[i].y), bfhi(vr[i].y), bflo(vr[i].z), bfhi(vr[i].z), bflo(vr[i].w), bfhi(vr[i].w)};
            float s1 = 0.f, s2 = 0.f;
#pragma unroll
            for (int j = 0; j < 8; ++j) { s1 += x[j]; s2 += x[j] * x[j]; }
#pragma unroll
            for (int o = 1; o < 16; o <<= 1) { s1 += __shfl_xor(s1, o); s2 += __shfl_xor(s2, o); }
            const float mu = s1 * (1.0f / 128.0f); const float var = fmaxf(s2 * (1.0f / 128.0f) - mu * mu, 0.f); const float rs = 1.0f / sqrtf(var + EPS);
            float y[8];
#pragma unroll
            for (int j = 0; j < 4; ++j) { y[j] = (x[j] - mu) * rs * lg0[j] + lb0[j]; y[4 + j] = (x[4 + j] - mu) * rs * lg1[j] + lb1[j]; }
            *(LAS bf16x8*)(vt + row * G_VP + d8 * 2) = pack_frag(y); }
        __syncthreads();
        u32x4 ur[4];
#pragma unroll
        for (int i = 0; i < 4; ++i) { const int t = c.wave * 16 + 4 * i + (lane >> 4); ur[i] = *(const u32x4*)(uv + (size_t)(ck * 128 + t) * DMIX + g * 128 + (lane & 15) * 8); }
        if (it + 1 < nitems) gmlp_load_v(c, ck + ckstep, g, vr);
#pragma unroll
        for (int tt = 0; tt < 2; ++tt) {
            const int tb = (c.wave < 4) ? (tt ? 3 : 0) : (tt ? 2 : 1);
            f32x16 acc; for (int i = 0; i < 16; ++i) acc[i] = 0.f;
            for (int ks = 0; ks < 2 * (tb + 1); ++ks)
                acc = MFMA32(frag_tr(vt, G_VP, 16 * ks, db * 32, lane), frag_row(c.lds + GL_WS, G_WP, tb * 32, 16 * ks, lane), acc);
#pragma unroll
            for (int gq = 0; gq < 4; ++gq) *(LAS f32x4*)(c.lds + GL_SG + (tb * 32 + r) * G_SGP + (db * 32 + 8 * gq + 4 * hh) * 4) = (f32x4){acc[4 * gq], acc[4 * gq + 1], acc[4 * gq + 2], acc[4 * gq + 3]};
        }
        __syncthreads();
#pragma unroll
        for (int i = 0; i < 4; ++i) {
            const int t = c.wave * 16 + 4 * i + (lane >> 4), dd = (lane & 15) * 8;
            const f32x4 g0 = *(LAS const f32x4*)(c.lds + GL_SG + t * G_SGP + dd * 4), g1 = *(LAS const f32x4*)(c.lds + GL_SG + t * G_SGP + dd * 4 + 16);
            const float bst = bs[t];
            const f32x4 na0 = *(const f32x4*)(nag + dd), na1 = *(const f32x4*)(nag + dd + 4);
            float y[8] = {bflo(ur[i].x) * (g0[0] + bst), bfhi(ur[i].x) * (g0[1] + bst), bflo(ur[i].y) * (g0[2] + bst), bfhi(ur[i].y) * (g0[3] + bst),
                          bflo(ur[i].z) * (g1[0] + bst), bfhi(ur[i].z) * (g1[1] + bst), bflo(ur[i].w) * (g1[2] + bst), bfhi(ur[i].w) * (g1[3] + bst)};
            float ss = 0.f;
#pragma unroll
            for (int j = 0; j < 8; ++j) ss += y[j] * y[j];
#pragma unroll
            for (int o = 1; o < 16; o <<= 1) ss += __shfl_xor(ss, o);
            u32x4 o4; o4.x = pk2(y[0] * na0[0], y[1] * na0[1]); o4.y = pk2(y[2] * na0[2], y[3] * na0[3]); o4.z = pk2(y[4] * na1[0], y[5] * na1[1]); o4.w = pk2(y[6] * na1[2], y[7] * na1[3]);
            *(u32x4*)(uv + (size_t)(ck * 128 + t) * DMIX + g * 128 + dd) = o4;
            if ((lane & 15) == 0) ((float*)(c.ws + WS_SSQA))[(size_t)(ck * 128 + t) * 16 + g] = ss;
        }
    }
    __syncthreads();
}

__device__ __forceinline__ void ssd_a_item_mfma(const Ctx& c, int ck, int g) {
    LAS float* sdt = (LAS float*)(c.lds + L_SDT); LAS float* sacs = (LAS float*)(c.lds + L_SACS); LAS float* sw = (LAS float*)(c.lds + L_SW);
    ssd_tables(c, ck, g, sdt, sacs);
    { const int l = c.tid >> 2, h = c.tid & 3; sw[l * 4 + h] = sdt[l * 4 + h] * __expf(sacs[127 * 4 + h] - sacs[l * 4 + h]); }
    if (c.tid < 4) ((float*)(c.ws + WS_CDEC))[ck * 32 + g * 4 + c.tid] = __expf(sacs[127 * 4 + c.tid]);
    __syncthreads();
    stage_conv_tile<256>(c, c.lds + L_XS, XS_PITCH, g * 256, ck * 128, sw);
    stage_conv_tile<128>(c, c.lds + L_B, BC_PITCH, DSSM + g * 128, ck * 128, nullptr);
    __syncthreads();
    const int lane = c.lane, h = c.wave >> 1, pb = c.wave & 1, hh = lane >> 5, r = lane & 31;
    f32x16 acc[4];
#pragma unroll
    for (int nb = 0; nb < 4; ++nb) for (int i = 0; i < 16; ++i) acc[nb][i] = 0.f;
#pragma unroll 2
    for (int ks = 0; ks < 8; ++ks) {
        const bf16x8 xf = frag_tr(c.lds + L_XS, XS_PITCH, 16 * ks, h * 64 + pb * 32, lane);
#pragma unroll
        for (int nb = 0; nb < 4; ++nb) { const bf16x8 bfg = frag_tr(c.lds + L_B, BC_PITCH, 16 * ks, nb * 32, lane); acc[nb] = MFMA32(bfg, xf, acc[nb]); }
    }
    __syncthreads();
    LAS unsigned char* stg = c.lds + L_XS + c.wave * (32 * 272);
#pragma unroll
    for (int nb = 0; nb < 4; ++nb)
#pragma unroll
        for (int gq = 0; gq < 4; ++gq) { u32x2 o; o.x = pk2(acc[nb][4 * gq], acc[nb][4 * gq + 1]); o.y = pk2(acc[nb][4 * gq + 2], acc[nb][4 * gq + 3]);
            *(LAS u32x2*)(stg + r * 272 + (nb * 32 + 8 * gq + 4 * hh) * 2) = o; }
    bf16_t* st = (bf16_t*)(c.ws + WS_ST) + ((size_t)(ck * 32 + g * 4 + h) * 64 + pb * 32) * 128;
#pragma unroll
    for (int i = 0; i < 8; ++i) { const int prow = 4 * i + (lane >> 4), chk = lane & 15;
        *(u32x4*)(st + (size_t)prow * 128 + chk * 8) = *(LAS const u32x4*)(stg + prow * 272 + chk * 16); }
    __syncthreads();
}

constexpr int BC2_PITCH = 272;
__device__ __forceinline__ void ssd_c_item_mfma(const Ctx& c, int ck, int g) {
    LAS float* sdt = (LAS float*)(c.lds + L_SDT); LAS float* sacs = (LAS float*)(c.lds + L_SACS); LAS float* part = (LAS float*)(c.lds + L_SW);
    ssd_tables(c, ck, g, sdt, sacs);
    stage_conv_tile<256>(c, c.lds + L_XS, XS_PITCH, g * 256, ck * 128, nullptr);
    stage_conv_tile<128>(c, c.lds + L_B, BC2_PITCH, DSSM + g * 128, ck * 128, nullptr);
    stage_conv_tile<128>(c, c.lds + L_C, BC2_PITCH, DSSM + NGRP * NST + g * 128, ck * 128, nullptr);
    __syncthreads();
    const int lane = c.lane, h = c.wave >> 1, hh = lane >> 5, r = lane & 31;
    const float Dh = c.in[13][g * 4 + h];
    const bf16_t* hin = (const bf16_t*)(c.ws + WS_ST) + (size_t)(ck * 32 + g * 4 + h) * 64 * 128;
    LAS const unsigned char* xs = c.lds + L_XS; LAS const unsigned char* bt = c.lds + L_B; LAS const unsigned char* ct = c.lds + L_C;
    f32x16 acc[2][2];
#pragma unroll
    for (int lbi = 0; lbi < 2; ++lbi) {
        const int lb = (c.wave & 1) ? (lbi ? 2 : 1) : (lbi ? 3 : 0);
        const int l = lb * 32 + r;
        bf16x8 cf[8];
#pragma unroll
        for (int ks = 0; ks < 8; ++ks) cf[ks] = frag_row(ct, BC2_PITCH, lb * 32, 16 * ks, lane);
        f32x16 a0, a1; for (int i = 0; i < 16; ++i) { a0[i] = 0.f; a1[i] = 0.f; }
#pragma unroll
        for (int ks = 0; ks < 8; ++ks) {
            const bf16x8 h0 = *(const bf16x8*)(hin + (size_t)r * 128 + 16 * ks + 8 * hh), h1 = *(const bf16x8*)(hin + (size_t)(32 + r) * 128 + 16 * ks + 8 * hh);
            a0 = MFMA32(h0, cf[ks], a0); a1 = MFMA32(h1, cf[ks], a1);
        }
        const float al = sacs[l * 4 + h]; const float ea = __expf(al);
        a0 = a0 * ea; a1 = a1 * ea;
        for (int sb = 0; sb <= lb; ++sb) {
            f32x16 X; for (int i = 0; i < 16; ++i) X[i] = 0.f;
#pragma unroll
            for (int ks = 0; ks < 8; ++ks) X = MFMA32(frag_row(bt, BC2_PITCH, sb * 32, 16 * ks, lane), cf[ks], X);
            bf16x8 mf[2];
#pragma unroll
            for (int kk = 0; kk < 2; ++kk) {
                float mv[8];
#pragma unroll
                for (int j = 0; j < 8; ++j) {
                    const int sidx = sb * 32 + 16 * kk + 8 * (j >> 2) + 4 * hh + (j & 3);
                    float v = X[8 * kk + j] * __expf(al - sacs[sidx * 4 + h]) * sdt[sidx * 4 + h];
                    v = (sidx <= l) ? v : 0.f;
                    mv[j] = (sidx == l) ? v + Dh : v;
                }
                mf[kk] = pack_frag(mv);
            }
#pragma unroll
            for (int kk = 0; kk < 2; ++kk) {
                const bf16x8 x0 = frag_tr_perm(xs, XS_PITCH, sb * 32 + 16 * kk, h * 64, lane), x1 = frag_tr_perm(xs, XS_PITCH, sb * 32 + 16 * kk, h * 64 + 32, lane);
                a0 = MFMA32(x0, mf[kk], a0); a1 = MFMA32(x1, mf[kk], a1);
            }
        }
        acc[lbi][0] = a0; acc[lbi][1] = a1;
    }
    const bf16_t* zs = (const bf16_t*)(c.ws + WS_ZS); bf16_t* cat = (bf16_t*)(c.ws + WS_UV); const float* ng = c.in[14] + g * 256;
    constexpr int YP = 528;
    u32x4 zr[8];
#pragma unroll
    for (int i = 0; i < 8; ++i) { const int l = c.wave * 16 + 2 * i + hh; zr[i] = *(const u32x4*)(zs + ((size_t)ck * 128 + l) * DSSM + g * 256 + r * 8); }
    __syncthreads();
    LAS unsigned char* yt = c.lds + L_XS;
#pragma unroll
    for (int lbi = 0; lbi < 2; ++lbi) {
        const int lb = (c.wave & 1) ? (lbi ? 2 : 1) : (lbi ? 3 : 0);
        const int l = lb * 32 + r;
#pragma unroll
        for (int pb = 0; pb < 2; ++pb)
#pragma unroll
            for (int gq = 0; gq < 4; ++gq) { u32x2 o; o.x = cvt_pk_bf16(acc[lbi][pb][4 * gq], acc[lbi][pb][4 * gq + 1]); o.y = cvt_pk_bf16(acc[lbi][pb][4 * gq + 2], acc[lbi][pb][4 * gq + 3]);
                *(LAS u32x2*)(yt + l * YP + (h * 64 + pb * 32 + 8 * gq + 4 * hh) * 2) = o; }
    }
    __syncthreads();
    const f32x4 gg0 = *(const f32x4*)(ng + r * 8), gg1 = *(const f32x4*)(ng + r * 8 + 4);
#pragma unroll
    for (int i = 0; i < 8; ++i) {
        const int l = c.wave * 16 + 2 * i + hh; const size_t row = (size_t)ck * 128 + l;
        const u32x4 yw = *(LAS const u32x4*)(yt + l * YP + r * 16);
        float y[8] = {bflo(yw.x) * bflo(zr[i].x), bfhi(yw.x) * bfhi(zr[i].x), bflo(yw.y) * bflo(zr[i].y), bfhi(yw.y) * bfhi(zr[i].y),
                      bflo(yw.z) * bflo(zr[i].z), bfhi(yw.z) * bfhi(zr[i].z), bflo(yw.w) * bflo(zr[i].w), bfhi(yw.w) * bfhi(zr[i].w)};
        float ss = 0.f;
#pragma unroll
        for (int j = 0; j < 8; ++j) ss += y[j] * y[j];
#pragma unroll
        for (int o = 1; o < 32; o <<= 1) ss += __shfl_xor(ss, o);
        const float rinv = 1.0f / sqrtf(ss * (1.0f / 256.0f) + EPS);
        u32x4 o4; o4.x = pk2(y[0] * rinv * gg0[0], y[1] * rinv * gg0[1]); o4.y = pk2(y[2] * rinv * gg0[2], y[3] * rinv * gg0[3]); o4.z = pk2(y[4] * rinv * gg1[0], y[5] * rinv * gg1[1]); o4.w = pk2(y[6] * rinv * gg1[2], y[7] * rinv * gg1[3]);
        *(u32x4*)(cat + row * DMIX + DA + g * 256 + r * 8) = o4;
    }
    __syncthreads();
}

#ifndef MIX_GMLP_MFMA
#define MIX_GMLP_MFMA 1
#endif
#ifndef MIX_SSDA_MFMA
#define MIX_SSDA_MFMA 1
#endif
#ifndef MIX_SSDC_MFMA
#define MIX_SSDC_MFMA 1
#endif

__device__ __forceinline__ void phase_mix_a(const Ctx& c) {
    if (MIX_GMLP_MFMA && (c.nb % NGA) == 0 && (NCH * NGA) % c.nb == 0) {
        gmlp_items(c, c.bid & 15, c.bid >> 4, c.nb >> 4, (NCH * NGA) / c.nb);
    } else {
        for (int it = c.bid; it < NCH * NGA; it += c.nb) gmlp_item(c, it >> 4, it & 15);
    }
    for (int it = c.bid; it < NCH * NGRP; it += c.nb) { if (MIX_SSDA_MFMA) ssd_a_item_mfma(c, it >> 3, it & 7); else ssd_a_item(c, it >> 3, it & 7); }
}

__device__ __forceinline__ void phase_scan(const Ctx& c) {
    unsigned* st = (unsigned*)(c.ws + WS_ST); const float* cdec = (const float*)(c.ws + WS_CDEC);
    for (int e = c.bid * 512 + c.tid; e < 32 * 64 * 64; e += c.nb * 512) {
        const int head = e >> 12; float h0 = 0.f, h1 = 0.f;
#pragma unroll 8
        for (int ck = 0; ck < NCH; ++ck) { const size_t idx = (size_t)ck * (32 * 64 * 64) + e; const unsigned w = st[idx]; const float dc = cdec[ck * 32 + head];
            st[idx] = pk2(h0, h1); h0 = dc * h0 + bflo(w); h1 = dc * h1 + bfhi(w); }
    }
    bf16_t* uv = (bf16_t*)(c.ws + WS_UV); const float* sq = (const float*)(c.ws + WS_SSQA);
    for (int i = c.bid * 512 + c.tid; i < S * (DA / 8); i += c.nb * 512) { const int row = i >> 8, ch = i & 255;
        const f32x4 q0 = *(const f32x4*)(sq + row * 16), q1 = *(const f32x4*)(sq + row * 16 + 4), q2 = *(const f32x4*)(sq + row * 16 + 8), q3 = *(const f32x4*)(sq + row * 16 + 12);
        float s = 0.f;
#pragma unroll
        for (int e = 0; e < 4; ++e) s += q0[e] + q1[e] + q2[e] + q3[e];
        const float rinv = 1.0f / sqrtf(s * (1.0f / DA) + EPS);
        u32x4* pp = (u32x4*)(uv + (size_t)row * DMIX + ch * 8); const u32x4 w = *pp; u32x4 o;
        o.x = pk2(bflo(w.x) * rinv, bfhi(w.x) * rinv); o.y = pk2(bflo(w.y) * rinv, bfhi(w.y) * rinv); o.z = pk2(bflo(w.z) * rinv, bfhi(w.z) * rinv); o.w = pk2(bflo(w.w) * rinv, bfhi(w.w) * rinv);
        *pp = o; }
}

__device__ __forceinline__ void ssd_c_item(const Ctx& c, int ck, int g) {
    LAS float* sdt = (LAS float*)(c.lds + L_SDT); LAS float* sacs = (LAS float*)(c.lds + L_SACS); LAS float* part = (LAS float*)(c.lds + L_SW);
    ssd_tables(c, ck, g, sdt, sacs);
    stage_conv_tile<256>(c, c.lds + L_XS, XS_PITCH, g * 256, ck * 128, nullptr);
    stage_conv_tile<128>(c, c.lds + L_B, BC_PITCH, DSSM + g * 128, ck * 128, nullptr);
    stage_conv_tile<128>(c, c.lds + L_C, BC_PITCH, DSSM + NGRP * NST + g * 128, ck * 128, nullptr);
    __syncthreads();
    float* G = (float*)(c.ws + WS_GSCR) + (size_t)c.bid * 16384;
    for (int o = c.tid; o < 16384; o += 512) { const int s = o & 127, l = o >> 7; float a = 0.f;
        if (s <= l) for (int n = 0; n < 128; ++n) a += bf2f(*(LAS bf16_t*)(c.lds + L_C + l * BC_PITCH + n * 2)) * bf2f(*(LAS bf16_t*)(c.lds + L_B + s * BC_PITCH + n * 2));
        __hip_atomic_store(G + o, a, __ATOMIC_RELAXED, __HIP_MEMORY_SCOPE_AGENT); }
    asm volatile("s_waitcnt vmcnt(0)" ::: "memory");
    __syncthreads();
    const bf16_t* hin = (const bf16_t*)(c.ws + WS_ST) + (size_t)(ck * 32 + g * 4) * 64 * 128;
    const bf16_t* zs = (const bf16_t*)(c.ws + WS_ZS); bf16_t* cat = (bf16_t*)(c.ws + WS_UV); const float* dsk = c.in[13]; const float* ng = c.in[14];
    const int hp = c.tid & 255, h = hp >> 6; const float Dh = dsk[g * 4 + h];
    for (int j = 0; j < 64; ++j) { const int l = (c.tid >> 8) + 2 * j; const float al = sacs[l * 4 + h];
        float y = 0.f;
        for (int s = 0; s <= l; ++s) y += __hip_atomic_load(G + l * 128 + s, __ATOMIC_RELAXED, __HIP_MEMORY_SCOPE_AGENT) * __expf(al - sacs[s * 4 + h]) * sdt[s * 4 + h] * bf2f(*(LAS bf16_t*)(c.lds + L_XS + s * XS_PITCH + hp * 2));
        float yo = 0.f;
        for (int n = 0; n < 128; ++n) yo += bf2f(*(LAS bf16_t*)(c.lds + L_C + l * BC_PITCH + n * 2)) * bf2f(hin[hp * 128 + n]);
        y += __expf(al) * yo + Dh * bf2f(*(LAS bf16_t*)(c.lds + L_XS + l * XS_PITCH + hp * 2));
        const size_t row = (size_t)ck * 128 + l;
        y *= bf2f(zs[row * DSSM + g * 256 + hp]);
        const float q = wave_sum(y * y);
        if (c.lane == 0) part[l * 4 + (c.wave & 3)] = q;
        cat[row * DMIX + DA + g * 256 + hp] = (bf16_t)f2bf(y);
    }
    __syncthreads();
    for (int j = 0; j < 64; ++j) { const int l = (c.tid >> 8) + 2 * j; const size_t row = (size_t)ck * 128 + l;
        const float rinv = 1.0f / sqrtf(((part[l * 4] + part[l * 4 + 1]) + (part[l * 4 + 2] + part[l * 4 + 3])) * (1.0f / 256.0f) + EPS);
        bf16_t* pp = cat + row * DMIX + DA + g * 256 + hp;
        *pp = (bf16_t)f2bf(bf2f(*pp) * rinv * ng[g * 256 + hp]); }
    __syncthreads();
}

__device__ __forceinline__ void phase_mix_c(const Ctx& c) {
    for (int it = c.bid; it < NCH * NGRP; it += c.nb) { if (MIX_SSDC_MFMA) ssd_c_item_mfma(c, it >> 3, it & 7); else ssd_c_item(c, it >> 3, it & 7); }
}

__device__ __forceinline__ void phase_final(const Ctx& c) {
    const int gw = c.bid * 8 + c.wave, NGW = c.nb * 8; const float* g = c.in[24]; const float* sq = (const float*)(c.ws + WS_SSQ3);
    for (int m = gw; m < S; m += NGW) {
        const f32x4 q0 = *(const f32x4*)(sq + (size_t)m * 8), q1 = *(const f32x4*)(sq + (size_t)m * 8 + 4);
        const float rinv = 1.0f / sqrtf(((q0[0] + q0[1]) + (q0[2] + q0[3]) + (q1[0] + q1[1]) + (q1[2] + q1[3])) * (1.0f / D) + EPS);
        float* orow = c.out + (size_t)m * D + 4 * c.lane;
#pragma unroll
        for (int j = 0; j < 8; ++j) { const f32x4 v = *(const f32x4*)(orow + 256 * j), gg = *(const f32x4*)(g + 4 * c.lane + 256 * j); *(f32x4*)(orow + 256 * j) = v * rinv * gg; }
    }
}

#define XB_TMO      128
#define XB_XCNT(j)  (256  + 64 * (j))
#define XB_XSUB(j)  (1280 + 64 * (j))
#define XB_XGEN(j)  (2304 + 64 * (j))
#define XB_TOP      3328
#define XB_TOPGEN   3392
#define XCD_BAR_WORDS 3456
#define XB_SPIN_CAP (1u << 20)
__device__ __forceinline__ unsigned xb_ld(unsigned* p)              { return __hip_atomic_load(p, __ATOMIC_RELAXED, __HIP_MEMORY_SCOPE_AGENT); }
__device__ __forceinline__ unsigned xb_add(unsigned* p, unsigned v) { return __hip_atomic_fetch_add(p, v, __ATOMIC_RELAXED, __HIP_MEMORY_SCOPE_AGENT); }
__device__ __forceinline__ unsigned xb_xcc_id() { return (unsigned)__builtin_amdgcn_s_getreg((3 << 11) | 20) & 0xFu; }
#define XB_SPIN(cond, bar) do { unsigned _sp = 0; while (cond) { __builtin_amdgcn_s_sleep(1); \
    if ((++_sp & 255u) == 0u) { if (xb_ld(&(bar)[XB_TMO])) break; if (_sp > XB_SPIN_CAP) { atomicAdd(&(bar)[XB_TMO], 1u); break; } } } } while (0)
struct XcdBarrier { unsigned* bar; unsigned x; volatile LAS unsigned* st; };
__device__ __forceinline__ XcdBarrier xcd_barrier_post(unsigned* bar, volatile LAS unsigned* st) {
    XcdBarrier b; b.bar = bar; b.x = xb_xcc_id(); b.st = st;
    if (threadIdx.x == 0) (void)xb_add(&bar[XB_XCNT(b.x)], 1u);
    return b;
}
__device__ __forceinline__ void xcd_barrier_complete(unsigned* bar, unsigned x, unsigned& nloc, unsigned& nx) {
    const unsigned G = gridDim.x * gridDim.y * gridDim.z;
    unsigned sum, cnt, mine, sp = 0u;
    for (;;) {
        sum = 0u; cnt = 0u; mine = 0u;
#pragma unroll
        for (unsigned j = 0; j < 16; ++j) { const unsigned c = xb_ld(&bar[XB_XCNT(j)]); sum += c; cnt += (c > 0u) ? 1u : 0u; mine = (j == x) ? c : mine; }
        if (sum == G) break;
        __builtin_amdgcn_s_sleep(1);
        if ((++sp & 255u) == 0u) { if (xb_ld(&bar[XB_TMO])) break; if (sp > XB_SPIN_CAP) { atomicAdd(&bar[XB_TMO], 1u); break; } }
    }
    nloc = mine > 0u ? mine : 1u; nx = cnt > 0u ? cnt : 1u;
}
__device__ __forceinline__ void xcd_barrier(const XcdBarrier& b) {
    asm volatile("s_waitcnt vmcnt(0)" ::: "memory");
    __syncthreads();
    if (threadIdx.x == 0) {
        unsigned* bar = b.bar;
        __builtin_amdgcn_s_waitcnt(0);
        unsigned nloc = b.st[0], nx = b.st[1];
        if (nloc == 0u) { xcd_barrier_complete(bar, b.x, nloc, nx); b.st[0] = nloc; b.st[1] = nx; }
        const unsigned old = xb_add(&bar[XB_XSUB(b.x)], 1u);
        const unsigned gen = old / nloc;
        if (old + 1u == (gen + 1u) * nloc) {
            __builtin_amdgcn_fence(__ATOMIC_RELEASE, "agent");
            asm volatile("s_waitcnt vmcnt(0)" ::: "memory");
            const unsigned og = xb_add(&bar[XB_TOP], 1u);
            const unsigned tg = og / nx;
            if (og + 1u == (tg + 1u) * nx) xb_add(&bar[XB_TOPGEN], 1u);
            else XB_SPIN(xb_ld(&bar[XB_TOPGEN]) == tg, bar);
            __builtin_amdgcn_fence(__ATOMIC_ACQUIRE, "agent");
            xb_add(&bar[XB_XGEN(b.x)], 1u);
            asm volatile("s_waitcnt vmcnt(0)" ::: "memory");
        } else {
            XB_SPIN(xb_ld(&bar[XB_XGEN(b.x)]) == gen, bar);
            __builtin_amdgcn_fence(__ATOMIC_ACQUIRE, "agent");
            asm volatile("s_waitcnt vmcnt(0)" ::: "memory");
        }
    }
    __syncthreads();
}

__global__ void __launch_bounds__(512, 2) mega_fwd(Params P, int ph_lo, int ph_hi) {
    extern __shared__ __attribute__((aligned(16))) unsigned char lds_raw[];
    Ctx c;
    c.lds = (LAS unsigned char*)lds_raw; c.tid = threadIdx.x; c.lane = c.tid & 63; c.wave = __builtin_amdgcn_readfirstlane(c.tid >> 6);
    c.nb = gridDim.x; c.bid = blockIdx.x; c.in = P.in; c.out = P.out; c.ws = P.ws;
    unsigned char* ws = P.ws;
    volatile LAS unsigned* bst = (volatile LAS unsigned*)(c.lds + L_MISC);
    if (c.tid < 2) bst[c.tid] = 0u;
    __syncthreads();
    const XcdBarrier xbar = xcd_barrier_post((unsigned*)ws, bst);
#ifndef PH_MASK
#define PH_MASK 0x3ff
#endif
#define IN(k) (((PH_MASK >> (k)) & 1) && ph_lo <= (k) && (k) < ph_hi)
#ifndef CG_SEAM
#define CG_SEAM -1
#endif
#ifndef TPROBE
#define TPROBE -1
#endif
#ifndef TAMP
#define TAMP 4
#endif
    volatile LAS unsigned long long* tsl = (volatile LAS unsigned long long*)(c.lds + L_MISC + 64);
    if (TPROBE >= 0 && c.bid == 0 && c.tid == 0) tsl[0] = __builtin_amdgcn_s_memrealtime();
#define SEAM(k) do { if (IN(k) && IN((k) + 1)) { if ((k) == CG_SEAM) cg::this_grid().sync(); else xcd_barrier(xbar); } \
        if (TPROBE >= 0 && c.bid == 0 && c.tid == 0) tsl[(k) + 1] = __builtin_amdgcn_s_memrealtime(); } while (0)
    if (IN(0)) phase_prep(c);
    SEAM(0);
    if (IN(1)) {
        pg8::Gemm g{(const bf16_t*)(ws + WS_A), (const bf16_t*)(ws + WS_WIN), D}; pg8::StaticOrder So; So.init(32, 40, c.nb, c.bid);
        EpiProj E{(bf16_t*)(ws + WS_UV), (bf16_t*)(ws + WS_ZS), (bf16_t*)(ws + WS_XBC)};
        pg8::gemm_phase<EpiProj, true, true>(c.lds, g, So, E);
        phase_dt(c);
    }
    SEAM(1);
    if (IN(2)) phase_mix_a(c);
    SEAM(2);
    if (IN(3)) phase_scan(c);
    SEAM(3);
    if (IN(4)) phase_mix_c(c);
    SEAM(4);
    if (IN(5)) {
        { pg8::Gemm g{(const bf16_t*)(ws + WS_UV), (const bf16_t*)(ws + WS_WOUT), DMIX}; pg8::StaticOrder So; So.init(32, 8, c.nb, c.bid);
          EpiResid E{P.in[0], P.out, (bf16_t*)(ws + WS_HG), (bf16_t*)(ws + WS_HG) + (size_t)S * D, P.in[16], (float*)(ws + WS_SSQ1)};
          pg8::gemm_phase<EpiResid, false, true>(c.lds, g, So, E); }
        { pg8::Gemm g{(const bf16_t*)(ws + WS_P16), (const bf16_t*)(ws + WS_WPLE), DPLE}; pg8::StaticOrder So; So.init(32, 8, c.nb, c.bid);
          EpiPlain E{(bf16_t*)(ws + WS_E), D};
          pg8::gemm_phase<EpiPlain, true, true>(c.lds, g, So, E); }
    }
    SEAM(5);
    if (IN(6)) {
        pg8::Gemm g{(const bf16_t*)(ws + WS_HG), (const bf16_t*)(ws + WS_WUP), D}; pg8::StaticOrder So; So.init(34, 44, c.nb, c.bid);
        EpiFfn E{(bf16_t*)(ws + WS_ACT), (const float*)(ws + WS_SSQ1), P.in[18], P.in[19]};
        pg8::gemm_phase<EpiFfn, true, true>(c.lds, g, So, E);
    }
    SEAM(6);
    if (IN(7)) {
        pg8::Gemm g{(const bf16_t*)(ws + WS_ACT), (const bf16_t*)(ws + WS_WDN), DFF}; pg8::StaticOrder So; So.init(32, 8, c.nb, c.bid);
        EpiResid E{P.out, P.out, (bf16_t*)(ws + WS_H2G), nullptr, P.in[21], (float*)(ws + WS_SSQ2)};
        pg8::gemm_phase<EpiResid, false, true>(c.lds, g, So, E);
    }
    SEAM(7);
    if (IN(8)) {
        pg8::Gemm g{(const bf16_t*)(ws + WS_H2G), (const bf16_t*)(ws + WS_WPG), D}; pg8::StaticOrder So; So.init(32, 8, c.nb, c.bid);
        EpiPle E{P.out, (const bf16_t*)(ws + WS_E), (const float*)(ws + WS_SSQ2), (float*)(ws + WS_SSQ3)};
        pg8::gemm_phase<EpiPle, false, true>(c.lds, g, So, E);
    }
    SEAM(8);
    if (IN(9)) phase_final(c);
    if (TPROBE >= 0 && c.bid == 0) {
        asm volatile("s_waitcnt vmcnt(0)" ::: "memory"); __syncthreads();
        if (c.tid == 0) { tsl[10] = __builtin_amdgcn_s_memrealtime(); const unsigned long long d = (tsl[TPROBE + 1] - tsl[TPROBE]) * TAMP; const unsigned long long t0 = __builtin_amdgcn_s_memrealtime();
            while (__builtin_amdgcn_s_memrealtime() - t0 < d) __builtin_amdgcn_s_sleep(8); }
    }
#undef IN
#undef SEAM
}

extern "C" void kernel_launch(void* const* d_in, const int* in_sizes, int n_in, void* d_out, int out_size, void* d_ws, size_t ws_size, hipStream_t stream) {
    static int grid = 0;
    if (grid == 0) {
        if (n_in != 25 || out_size != S * D || ws_size < WS_END) { fprintf(stderr, "kernel_launch: unexpected shapes (n_in %d out %d ws %zu)\n", n_in, out_size, ws_size); grid = -1; return; }
        int dev = 0, cus = 0, per_cu = 0;
        (void)hipGetDevice(&dev); (void)hipDeviceGetAttribute(&cus, hipDeviceAttributeMultiprocessorCount, dev);
        if (hipFuncSetAttribute((const void*)mega_fwd, hipFuncAttributeMaxDynamicSharedMemorySize, LDS_BYTES) != hipSuccess) { fprintf(stderr, "kernel_launch: hipFuncSetAttribute failed\n"); grid = -1; return; }
        (void)hipOccupancyMaxActiveBlocksPerMultiprocessor(&per_cu, (const void*)mega_fwd, 512, LDS_BYTES);
        if (per_cu < 1) { fprintf(stderr, "kernel_launch: occupancy query says %d blocks/CU\n", per_cu); per_cu = 1; }
        (void)hipGetLastError();
        grid = cus;
        fprintf(stderr, "kernel_launch: grid %d (cus %d, per_cu %d)\n", grid, cus, per_cu);
    }
    if (grid < 0) return;
    if (hipMemsetAsync(d_ws, 0, 16384, stream) != hipSuccess) { fprintf(stderr, "kernel_launch: memset failed\n"); return; }
    Params P{};
    for (int i = 0; i < 25; ++i) P.in[i] = (const float*)d_in[i];
    P.out = (float*)d_out; P.ws = (unsigned char*)d_ws;
#if MK_LAUNCHES == 1
    int lo = 0, hi = NPH;
    void* args[] = {&P, &lo, &hi};
#if CG_SEAM >= 0
    hipError_t e = hipLaunchCooperativeKernel((const void*)mega_fwd, dim3(grid), dim3(512), args, LDS_BYTES, stream);
#else
    (void)args;
    hipLaunchKernelGGL(mega_fwd, dim3(grid), dim3(512), LDS_BYTES, stream, P, lo, hi);
    hipError_t e = hipPeekAtLastError();
#endif
    if (e != hipSuccess) fprintf(stderr, "kernel_launch: launch failed: %s\n", hipGetErrorString(e));
#else
    for (int k = 0; k < NPH; ++k) {
        int lo = k, hi = k + 1;
        void* args[] = {&P, &lo, &hi};
        hipError_t e = hipLaunchCooperativeKernel((const void*)mega_fwd, dim3(grid), dim3(512), args, LDS_BYTES, stream);
        if (e != hipSuccess) { fprintf(stderr, "kernel_launch: launch %d failed: %s\n", k, hipGetErrorString(e)); break; }
    }
#endif
}
```

```cpp
#include <hip/hip_runtime.h>
#include <hip/hip_cooperative_groups.h>
#include <cstdio>
#include <cstdint>
namespace cg = cooperative_groups;

#ifndef MK_LAUNCHES
#define MK_LAUNCHES 1
#endif

#define LAS __attribute__((address_space(3)))
typedef unsigned short bf16_t;
typedef short bf16x8 __attribute__((ext_vector_type(8)));
typedef float f32x4 __attribute__((ext_vector_type(4)));
typedef float f32x2 __attribute__((ext_vector_type(2)));
typedef float f32x16 __attribute__((ext_vector_type(16)));
typedef unsigned u32x4 __attribute__((ext_vector_type(4)));
typedef unsigned u32x2 __attribute__((ext_vector_type(2)));

constexpr int S = 8192, D = 2048, DIN = 10272, DA = 2048, DSSM = 2048, DXBC = 4096, NH = 32, NGRP = 8, NST = 128;
constexpr int DFF = 5632, DPLE = 256, DMIX = 4096, NCH = 64, CH = 128, NGA = 16;
constexpr float EPS = 1e-6f;
constexpr int NPH = 10;

constexpr size_t MiB = 1u << 20;
constexpr size_t WS_WUP = 1 * MiB;
constexpr size_t WS_WDN = 45 * MiB;
constexpr size_t WS_WPG = 67 * MiB;
constexpr size_t WS_WPLE = 75 * MiB;
constexpr size_t WS_WIN = 76 * MiB;
constexpr size_t WS_WOUT = 117 * MiB;
constexpr size_t WS_UV = 133 * MiB;
constexpr size_t WS_ACT = 133 * MiB;
constexpr size_t WS_ZS = 197 * MiB;
constexpr size_t WS_XBC = 229 * MiB;
constexpr size_t WS_HG = 229 * MiB;
constexpr size_t WS_H2G = 229 * MiB;
constexpr size_t WS_A = 293 * MiB;
constexpr size_t WS_ST = 293 * MiB;
constexpr size_t WS_E = 293 * MiB;
constexpr size_t WS_P16 = 325 * MiB;
constexpr size_t WS_DT = 329 * MiB;
constexpr size_t WS_SSQA = 330 * MiB;
constexpr size_t WS_SSQ1 = 331 * MiB;
constexpr size_t WS_SSQ2 = WS_SSQ1 + 256 * 1024;
constexpr size_t WS_SSQ3 = WS_SSQ2 + 256 * 1024;
constexpr size_t WS_CDEC = WS_SSQ3 + 256 * 1024;
constexpr size_t WS_GSCR = 332 * MiB;
constexpr size_t WS_END = 348 * MiB;

constexpr int LDS_BYTES = 163840;

struct Params {
    const float* in[25];
    float* out;
    unsigned char* ws;
};

__device__ __forceinline__ unsigned f2bf(float f) { unsigned u = __builtin_bit_cast(unsigned, f); return (u + 0x7fffu + ((u >> 16) & 1u)) >> 16; }
__device__ __forceinline__ unsigned pk2(float lo, float hi) { return f2bf(lo) | (f2bf(hi) << 16); }
__device__ __forceinline__ float bf2f(unsigned short b) { return __builtin_bit_cast(float, ((unsigned)b) << 16); }
__device__ __forceinline__ float bflo(unsigned w) { return __builtin_bit_cast(float, w << 16); }
__device__ __forceinline__ float bfhi(unsigned w) { return __builtin_bit_cast(float, w & 0xffff0000u); }
__device__ __forceinline__ float fast_sigmoid(float x) { return __builtin_amdgcn_rcpf(1.0f + __builtin_amdgcn_exp2f(-1.4426950408889634f * x)); }
__device__ __forceinline__ float silu_f(float x) { return x * fast_sigmoid(x); }
__device__ __forceinline__ float gelu_tanh_f(float x) { const float t = x + 0.044715f * x * x * x; return x * __builtin_amdgcn_rcpf(1.0f + __builtin_amdgcn_exp2f(-2.3022081986f * t)); }
__device__ __forceinline__ float wave_sum(float v) {
#pragma unroll
    for (int o = 1; o < 64; o <<= 1) v += __shfl_xor(v, o);
    return v;
}

namespace pg8 {
constexpr int BM = 256, BK = 64, HALF = 128, HTB = HALF * BK * 2, STAGE_BYTES = 8 * HTB, NXCD = 8, WGM = 8;
__host__ __device__ __forceinline__ int lds_byte(int r, int c) { const int st = (r >> 4) * 2 + (c >> 5), rr = r & 15, cc = c & 31, ob = rr * 64 + cc * 2; return st * 1024 + (ob ^ (((ob >> 9) & 1) << 5)); }
__host__ __device__ __forceinline__ void stage_rc(int b, int& R, int& C) { const int st = b / 1024, sb = b % 1024, swz = sb ^ (((sb >> 9) & 1) << 5); R = (st >> 1) * 16 + swz / 64; C = (st & 1) * 32 + (swz % 64) / 2; }
__host__ __device__ __forceinline__ int perm32(int rho) { const int n = rho >> 4, i = rho & 15; return 8 * (i >> 2) + 4 * n + (i & 3); }

struct Unit { int pm, pn; };
struct Gemm { const bf16_t* A; const bf16_t* Bt; int K; };

struct StaticOrder {
    int nM, nN, nwg, G, c;
    __device__ void init(int nM_, int nN_, int G_, int c_) { nM = nM_; nN = nN_; nwg = nM * nN; G = G_; c = c_; }
    __device__ bool next(int i, Unit& u) const {
        const long L = (long)i * G + c; if (L >= nwg) return false;
        int wgid = (int)L; { const int q = nwg / NXCD, r = nwg % NXCD, xcd = wgid % NXCD, off = wgid / NXCD; wgid = (xcd < r ? xcd * (q + 1) : r * (q + 1) + (xcd - r) * q) + off; }
        const int nig = WGM * nN, gid = wgid / nig, fm = gid * WGM, gsz = (nM - fm) < WGM ? (nM - fm) : WGM;
        u.pm = fm + ((wgid % nig) % gsz); u.pn = (wgid % nig) / gsz; return true;
    }
};

__device__ __forceinline__ unsigned cvt_pk_bf16(float lo, float hi) { unsigned r; asm volatile("v_cvt_pk_bf16_f32 %0, %1, %2" : "=v"(r) : "v"(lo), "v"(hi)); return r; }

template <class Epi, bool ALIGN_EPI, bool SP2>
__device__ __forceinline__ void gemm_phase(LAS unsigned char* lds, const Gemm g, const StaticOrder& S, const Epi& E) {
    const int tid = threadIdx.x, wid = __builtin_amdgcn_readfirstlane(tid >> 6), lane = tid & 63, wr = wid >> 2, wc = wid & 3, fr = lane & 15, fq = lane >> 4;
    const int K = g.K, nt = K / BK;
    unsigned voffA[2], voffB[2];
#pragma unroll
    for (int i = 0; i < 2; ++i) { int R, C; stage_rc(tid * 16 + i * 8192, R, C); const int Rb = (R & ~31) + perm32(R & 31);
        voffA[i] = (unsigned)(R * K + C) * 2u; voffB[i] = (unsigned)(Rb * K + C) * 2u; }
    const size_t kstep = (size_t)(BK * 2);
    const size_t hstep = (size_t)HALF * K * 2;
    const size_t tstep = 2 * hstep;
    const unsigned ldsw = (unsigned)wid * 1024u;
    const int aoff = lds_byte(wr * 64 + fr, fq * 8), boff = lds_byte(wc * 32 + fr, fq * 8);
#define PG8_SA(b, h) (((b) * 2 + (h)) * HTB)
#define PG8_SB(b, h) ((4 + (b) * 2 + (h)) * HTB)
#define PG8_STAGE(bufoff, gbase, voff) do { _Pragma("unroll") for (int _i = 0; _i < 2; ++_i) \
        __builtin_amdgcn_global_load_lds((const unsigned*)((const char*)(gbase) + (voff)[_i]), (LAS unsigned*)(lds + (bufoff) + ldsw + _i * 8192), 16, 0, 0); } while (0)
#define PG8_LDA(dst, b, h) do { _Pragma("unroll") for (int m = 0; m < 4; ++m) _Pragma("unroll") for (int k = 0; k < 2; ++k) dst[m][k] = *(const LAS bf16x8*)(lds + PG8_SA(b, h) + aoff + m * 2048 + k * 1024); } while (0)
#define PG8_LDB(dst, b, h) do { _Pragma("unroll") for (int n = 0; n < 2; ++n) _Pragma("unroll") for (int k = 0; k < 2; ++k) dst[n][k] = *(const LAS bf16x8*)(lds + PG8_SB(b, h) + boff + n * 2048 + k * 1024); } while (0)
#define PG8_MMA(ai, bj, At, Bt) do { __builtin_amdgcn_s_setprio(1); _Pragma("unroll") for (int m = 0; m < 4; ++m) _Pragma("unroll") for (int n = 0; n < 2; ++n) _Pragma("unroll") for (int k = 0; k < 2; ++k) \
        acc[ai][bj][m][n] = __builtin_amdgcn_mfma_f32_16x16x32_bf16(Bt[n][k], At[m][k], acc[ai][bj][m][n], 0, 0, 0); __builtin_amdgcn_s_setprio(0); } while (0)
#define PG8_WAIT_V(n) asm volatile("s_waitcnt vmcnt(" #n ")" ::: "memory")
#define PG8_WAIT_L(n) asm volatile("s_waitcnt lgkmcnt(" #n ")" ::: "memory")
#define PG8_BAR __builtin_amdgcn_s_barrier()
#define PG8_SCHED __builtin_amdgcn_sched_barrier(0)
    Unit cur, nxt; int ui = 0;
    if (!S.next(0, cur)) return;
    f32x4 acc[2][2][4][2];
#pragma unroll
    for (int a = 0; a < 2; ++a)
#pragma unroll
        for (int b = 0; b < 2; ++b)
#pragma unroll
            for (int m = 0; m < 4; ++m)
#pragma unroll
                for (int n = 0; n < 2; ++n) acc[a][b][m][n] = (f32x4){0.f, 0.f, 0.f, 0.f};
    bf16x8 At[4][2], B0[2][2], B1[2][2];
    const char* cA = (const char*)g.A + (size_t)cur.pm * tstep; const char* cB = (const char*)g.Bt + (size_t)cur.pn * tstep;
    if constexpr (SP2) {
        PG8_STAGE(PG8_SB(0, 0), cB, voffB); PG8_STAGE(PG8_SB(0, 1), cB + hstep, voffB); PG8_STAGE(PG8_SA(0, 0), cA, voffA); PG8_STAGE(PG8_SA(0, 1), cA + hstep, voffA);
        if (wr == 1) PG8_BAR;
        PG8_WAIT_V(2); PG8_BAR;
        PG8_STAGE(PG8_SB(1, 0), cB + kstep, voffB); PG8_STAGE(PG8_SA(1, 0), cA + kstep, voffA); PG8_STAGE(PG8_SB(1, 1), cB + hstep + kstep, voffB);
        PG8_WAIT_V(6); PG8_BAR;
    } else {
        PG8_STAGE(PG8_SB(0, 0), cB, voffB); PG8_STAGE(PG8_SA(0, 0), cA, voffA); PG8_STAGE(PG8_SB(0, 1), cB + hstep, voffB); PG8_STAGE(PG8_SA(0, 1), cA + hstep, voffA);
        if (wr == 1) PG8_BAR;
        PG8_WAIT_V(4); PG8_BAR;
        PG8_STAGE(PG8_SB(1, 0), cB + kstep, voffB); PG8_STAGE(PG8_SA(1, 0), cA + kstep, voffA); PG8_STAGE(PG8_SB(1, 1), cB + hstep + kstep, voffB);
        PG8_WAIT_V(6); PG8_BAR;
    }
    for (;;) {
        const bool has_next = S.next(ui + 1, nxt);
        const char* nA = has_next ? (const char*)g.A + (size_t)nxt.pm * tstep : cA; const char* nB = has_next ? (const char*)g.Bt + (size_t)nxt.pn * tstep : cB;
#pragma nounroll
        for (int t = 0; t < nt; t += 2) {
            const bool last = (t == nt - 2);
            const char* a1 = cA + (size_t)(t + 1) * kstep;
            const char* a2 = last ? nA : cA + (size_t)(t + 2) * kstep; const char* b2 = last ? nB : cB + (size_t)(t + 2) * kstep;
            const char* a3 = a2 + kstep; const char* b3 = b2 + kstep;
            if constexpr (SP2) {
            PG8_LDB(B0, 0, 0); PG8_LDB(B1, 0, 1); PG8_SCHED; PG8_LDA(At, 0, 0); PG8_STAGE(PG8_SA(1, 1), a1 + hstep, voffA);
            PG8_WAIT_V(8); PG8_WAIT_L(0); PG8_BAR; PG8_MMA(0, 0, At, B0); PG8_MMA(0, 1, At, B1); PG8_BAR; PG8_SCHED;
            PG8_LDA(At, 0, 1); PG8_STAGE(PG8_SB(0, 0), b2, voffB); PG8_STAGE(PG8_SB(0, 1), b2 + hstep, voffB); PG8_STAGE(PG8_SA(0, 0), a2, voffA);
            PG8_WAIT_V(8); PG8_WAIT_L(0); PG8_BAR; PG8_MMA(1, 0, At, B0); PG8_MMA(1, 1, At, B1); PG8_BAR; PG8_SCHED;
            PG8_LDB(B0, 1, 0); PG8_LDB(B1, 1, 1); PG8_SCHED; PG8_LDA(At, 1, 0); PG8_STAGE(PG8_SA(0, 1), a2 + hstep, voffA);
            PG8_WAIT_V(8); PG8_WAIT_L(0); PG8_BAR; PG8_MMA(0, 0, At, B0); PG8_MMA(0, 1, At, B1); PG8_BAR; PG8_SCHED;
            PG8_LDA(At, 1, 1); PG8_STAGE(PG8_SB(1, 0), b3, voffB); PG8_STAGE(PG8_SB(1, 1), b3 + hstep, voffB); PG8_STAGE(PG8_SA(1, 0), a3, voffA);
            PG8_WAIT_V(8); PG8_WAIT_L(0); PG8_BAR; PG8_MMA(1, 0, At, B0); PG8_MMA(1, 1, At, B1); PG8_BAR; PG8_SCHED;
            } else {
            PG8_LDB(B0, 0, 0); PG8_SCHED; PG8_LDA(At, 0, 0); PG8_STAGE(PG8_SA(1, 1), a1 + hstep, voffA);
            PG8_WAIT_L(8); PG8_BAR; PG8_WAIT_L(0); PG8_MMA(0, 0, At, B0); PG8_BAR; PG8_SCHED;
            PG8_LDB(B1, 0, 1); PG8_STAGE(PG8_SB(0, 0), b2, voffB);
            PG8_BAR; PG8_WAIT_L(0); PG8_MMA(0, 1, At, B1); PG8_BAR;
            PG8_LDA(At, 0, 1); PG8_STAGE(PG8_SA(0, 0), a2, voffA);
            PG8_BAR; PG8_WAIT_L(0); PG8_MMA(1, 0, At, B0); PG8_BAR; PG8_SCHED;
            PG8_STAGE(PG8_SB(0, 1), b2 + hstep, voffB);
            PG8_WAIT_V(6); PG8_BAR; PG8_MMA(1, 1, At, B1); PG8_BAR;
            PG8_LDB(B0, 1, 0); PG8_SCHED; PG8_LDA(At, 1, 0); PG8_STAGE(PG8_SA(0, 1), a2 + hstep, voffA);
            PG8_WAIT_L(8); PG8_BAR; PG8_WAIT_L(0); PG8_MMA(0, 0, At, B0); PG8_BAR; PG8_SCHED;
            PG8_LDB(B1, 1, 1); PG8_STAGE(PG8_SB(1, 0), b3, voffB);
            PG8_BAR; PG8_WAIT_L(0); PG8_MMA(0, 1, At, B1); PG8_BAR;
            PG8_LDA(At, 1, 1); PG8_STAGE(PG8_SA(1, 0), a3, voffA);
            PG8_BAR; PG8_WAIT_L(0); PG8_MMA(1, 0, At, B0); PG8_BAR; PG8_SCHED;
            PG8_STAGE(PG8_SB(1, 1), b3 + hstep, voffB);
            PG8_WAIT_V(6); PG8_BAR; PG8_MMA(1, 1, At, B1); PG8_BAR;
            }
        }
        if constexpr (ALIGN_EPI) { if (wr == 0) PG8_BAR; }
        if constexpr (!Epi::AFTER_DRAIN) { E(acc, cur, wr, wc, fr, fq); }
        if (!has_next) break;
#pragma unroll
        for (int a = 0; a < 2; ++a)
#pragma unroll
            for (int b = 0; b < 2; ++b)
#pragma unroll
                for (int m = 0; m < 4; ++m)
#pragma unroll
                    for (int n = 0; n < 2; ++n) acc[a][b][m][n] = (f32x4){0.f, 0.f, 0.f, 0.f};
        cur = nxt; cA = nA; cB = nB; ++ui;
        if constexpr (ALIGN_EPI) { if (wr == 1) PG8_BAR; }
    }
    PG8_WAIT_V(0);
    if constexpr (!ALIGN_EPI) { if (wr == 0) PG8_BAR; }
    PG8_BAR;
    if constexpr (Epi::AFTER_DRAIN) { E.fused(acc, cur, wr, wc, fr, fq, lds, wid, lane); }
#undef PG8_SA
#undef PG8_SB
#undef PG8_STAGE
#undef PG8_LDA
#undef PG8_LDB
#undef PG8_MMA
#undef PG8_WAIT_V
#undef PG8_WAIT_L
#undef PG8_BAR
#undef PG8_SCHED
}
}
using pg8::Unit; using pg8::cvt_pk_bf16;
typedef f32x4 AccT[2][2][4][2];

__device__ __forceinline__ u32x4 pack8(const f32x4 v0, const f32x4 v1) { u32x4 w; w.x = cvt_pk_bf16(v0[0], v0[1]); w.y = cvt_pk_bf16(v0[2], v0[3]); w.z = cvt_pk_bf16(v1[0], v1[1]); w.w = cvt_pk_bf16(v1[2], v1[3]); return w; }

struct EpiProj {
    static constexpr bool AFTER_DRAIN = false;
    bf16_t *uv, *zs, *xbc;
    __device__ __forceinline__ void operator()(const AccT& acc, const Unit& u, int wr, int wc, int fr, int fq) const {
        const int row0 = u.pm * 256 + wr * 64 + fr; const int ct = wc * 32 + 8 * fq;
        bf16_t* base; int ld, mode;
        if (u.pn < 16) { base = uv + u.pn * 256; ld = DMIX; mode = 0; }
        else if (u.pn < 24) { base = zs + (u.pn - 16) * 256; ld = DSSM; mode = 1; }
        else { base = xbc + (u.pn - 24) * 256; ld = DXBC; mode = 2; }
#pragma unroll
        for (int ai = 0; ai < 2; ++ai)
#pragma unroll
            for (int m = 0; m < 4; ++m) { bf16_t* rowp = base + (size_t)(row0 + ai * 128 + m * 16) * ld + ct;
#pragma unroll
                for (int bj = 0; bj < 2; ++bj) { f32x4 v0 = acc[ai][bj][m][0], v1 = acc[ai][bj][m][1];
                    if (mode == 0) {
#pragma unroll
                        for (int j = 0; j < 4; ++j) { v0[j] = gelu_tanh_f(v0[j]); v1[j] = gelu_tanh_f(v1[j]); } }
                    else if (mode == 1) {
#pragma unroll
                        for (int j = 0; j < 4; ++j) { v0[j] = silu_f(v0[j]); v1[j] = silu_f(v1[j]); } }
                    *(u32x4*)(rowp + bj * 128) = pack8(v0, v1); } }
    }
};
struct EpiPlain {
    static constexpr bool AFTER_DRAIN = false;
    bf16_t* O; int ld;
    __device__ __forceinline__ void operator()(const AccT& acc, const Unit& u, int wr, int wc, int fr, int fq) const {
        const int row0 = u.pm * 256 + wr * 64 + fr; const int col0 = u.pn * 256 + wc * 32 + 8 * fq;
#pragma unroll
        for (int ai = 0; ai < 2; ++ai)
#pragma unroll
            for (int m = 0; m < 4; ++m) { bf16_t* rowp = O + (size_t)(row0 + ai * 128 + m * 16) * ld + col0;
#pragma unroll
                for (int bj = 0; bj < 2; ++bj) *(u32x4*)(rowp + bj * 128) = pack8(acc[ai][bj][m][0], acc[ai][bj][m][1]); }
    }
};
struct EpiResid {
    static constexpr bool AFTER_DRAIN = true;
    const float* base; float* out; bf16_t* hn; bf16_t* halo; const float* gain; float* ssq;
    __device__ __forceinline__ void fused(AccT& acc, const Unit& u, int wr, int wc, int fr, int fq, LAS unsigned char* lds, int wid, int lane) const {
        asm volatile("" : "+v"(fr), "+v"(fq));
        LAS float* P = (LAS float*)lds;
        const int col0 = u.pn * 256 + wc * 32 + 8 * fq;
#pragma unroll
        for (int ai = 0; ai < 2; ++ai)
#pragma unroll
            for (int m = 0; m < 4; ++m) { const int rl = ai * 128 + wr * 64 + m * 16 + fr; const int row = u.pm * 256 + rl; const size_t off = (size_t)row * D + col0;
                float ss = 0.f;
                bf16_t* hrow = nullptr;
                if (halo) { const int r6 = row & 63; if (r6 >= 62) { if ((row >> 6) <= 126) hrow = halo + (size_t)(4 * (row >> 6) + (row & 1)) * D; } else if (r6 < 2 && row >= 64) hrow = halo + (size_t)(4 * ((row >> 6) - 1) + 2 + (row & 1)) * D; }
#pragma unroll
                for (int bj = 0; bj < 2; ++bj) { const f32x4 b0 = *(const f32x4*)(base + off + bj * 128), b1 = *(const f32x4*)(base + off + bj * 128 + 4);
                    const f32x4 v0 = acc[ai][bj][m][0] + b0, v1 = acc[ai][bj][m][1] + b1;
                    *(f32x4*)(out + off + bj * 128) = v0; *(f32x4*)(out + off + bj * 128 + 4) = v1;
                    ss += (v0[0] * v0[0] + v0[1] * v0[1]) + (v0[2] * v0[2] + v0[3] * v0[3]) + (v1[0] * v1[0] + v1[1] * v1[1]) + (v1[2] * v1[2] + v1[3] * v1[3]);
                    const f32x4 g0 = *(const f32x4*)(gain + col0 + bj * 128), g1 = *(const f32x4*)(gain + col0 + bj * 128 + 4);
                    const u32x4 w = pack8(v0 * g0, v1 * g1);
                    *(u32x4*)(hn + off + bj * 128) = w;
                    if (hrow) *(u32x4*)(hrow + col0 + bj * 128) = w; }
                ss += __shfl_xor(ss, 16); ss += __shfl_xor(ss, 32);
                if (fq == 0) P[rl * 4 + wc] = ss;
                asm volatile("" ::: "memory"); }
        __syncthreads();
        if (threadIdx.x < 256) { const int t = threadIdx.x; ssq[(size_t)(u.pm * 256 + t) * 8 + u.pn] = (P[t * 4 + 0] + P[t * 4 + 1]) + (P[t * 4 + 2] + P[t * 4 + 3]); }
        __syncthreads();
    }
};
struct EpiPle {
    static constexpr bool AFTER_DRAIN = true;
    float* out; const bf16_t* Eb; const float* ssq_in; float* ssq;
    __device__ __forceinline__ void fused(AccT& acc, const Unit& u, int wr, int wc, int fr, int fq, LAS unsigned char* lds, int wid, int lane) const {
        asm volatile("" : "+v"(fr), "+v"(fq));
        LAS float* P = (LAS float*)lds;
        const int col0 = u.pn * 256 + wc * 32 + 8 * fq;
#pragma unroll
        for (int ai = 0; ai < 2; ++ai)
#pragma unroll
            for (int m = 0; m < 4; ++m) { const int rl = ai * 128 + wr * 64 + m * 16 + fr; const int row = u.pm * 256 + rl; const size_t off = (size_t)row * D + col0;
                const f32x4 q0 = *(const f32x4*)(ssq_in + (size_t)row * 8), q1 = *(const f32x4*)(ssq_in + (size_t)row * 8 + 4);
                const float rinv = 1.0f / sqrtf(((q0[0] + q0[1]) + (q0[2] + q0[3]) + (q1[0] + q1[1]) + (q1[2] + q1[3])) * (1.0f / D) + EPS);
                float ss = 0.f;
#pragma unroll
                for (int bj = 0; bj < 2; ++bj) { const f32x4 b0 = *(const f32x4*)(out + off + bj * 128), b1 = *(const f32x4*)(out + off + bj * 128 + 4);
                    const u32x4 ew = *(const u32x4*)(Eb + off + bj * 128);
                    f32x4 e0 = {bflo(ew.x), bfhi(ew.x), bflo(ew.y), bfhi(ew.y)}, e1 = {bflo(ew.z), bfhi(ew.z), bflo(ew.w), bfhi(ew.w)};
                    f32x4 v0, v1;
#pragma unroll
                    for (int j = 0; j < 4; ++j) { v0[j] = b0[j] + fast_sigmoid(acc[ai][bj][m][0][j] * rinv) * e0[j]; v1[j] = b1[j] + fast_sigmoid(acc[ai][bj][m][1][j] * rinv) * e1[j]; }
                    *(f32x4*)(out + off + bj * 128) = v0; *(f32x4*)(out + off + bj * 128 + 4) = v1;
                    ss += (v0[0] * v0[0] + v0[1] * v0[1]) + (v0[2] * v0[2] + v0[3] * v0[3]) + (v1[0] * v1[0] + v1[1] * v1[1]) + (v1[2] * v1[2] + v1[3] * v1[3]); }
                ss += __shfl_xor(ss, 16); ss += __shfl_xor(ss, 32);
                if (fq == 0) P[rl * 4 + wc] = ss;
                asm volatile("" ::: "memory"); }
        __syncthreads();
        if (threadIdx.x < 256) { const int t = threadIdx.x; ssq[(size_t)(u.pm * 256 + t) * 8 + u.pn] = (P[t * 4 + 0] + P[t * 4 + 1]) + (P[t * 4 + 2] + P[t * 4 + 3]); }
        __syncthreads();
    }
};
template <int CTRL> __device__ __forceinline__ float dpp_ror(float x) { int r = __builtin_amdgcn_update_dpp(0, __builtin_bit_cast(int, x), CTRL, 0xf, 0xf, false); asm volatile("" : "+v"(r)); return __builtin_bit_cast(float, r); }
struct EpiFfn {
    static constexpr bool AFTER_DRAIN = false;
    bf16_t* act; const float* ssq1; const float* cw; const float* cb;
    __device__ __forceinline__ int grow_of(const Unit& u, int rl) const {
        if (u.pm < 32) return u.pm * 256 + rl;
        const int R = (u.pm - 32) * 256 + rl; int q = (R >> 2) + 1; if (q > 127) q = 127; return 64 * q - 2 + (R & 3);
    }
    __device__ __forceinline__ void operator()(AccT& acc, const Unit& u, int wr, int wc, int fr, int fq) const {
        asm volatile("" : "+v"(fr), "+v"(fq));
        const bool halo = u.pm >= 32;
#pragma unroll
        for (int ai = 0; ai < 2; ++ai)
#pragma unroll
            for (int m = 0; m < 4; ++m) {
                const int gr = grow_of(u, ai * 128 + wr * 64 + m * 16 + fr);
                const f32x4 q0 = *(const f32x4*)(ssq1 + (size_t)gr * 8), q1 = *(const f32x4*)(ssq1 + (size_t)gr * 8 + 4);
                const float rinv = 1.0f / sqrtf(((q0[0] + q0[1]) + (q0[2] + q0[3]) + (q1[0] + q1[1]) + (q1[2] + q1[3])) * (1.0f / D) + EPS);
#pragma unroll
                for (int bj = 0; bj < 2; ++bj)
#pragma unroll
                    for (int n = 0; n < 2; ++n) acc[ai][bj][m][n] = acc[ai][bj][m][n] * rinv;
                asm volatile("" ::: "memory");
            }
        const int gc0 = u.pn * 128 + wc * 32 + 8 * fq;
#pragma unroll
        for (int bj = 0; bj < 2; ++bj)
#pragma unroll
            for (int n = 0; n < 2; ++n) {
                const int cc = bj * DFF + gc0 + 4 * n;
                asm volatile("" ::: "memory");
                const f32x4 w0 = *(const f32x4*)(cw + cc), w1 = *(const f32x4*)(cw + 2 * DFF + cc), w2 = *(const f32x4*)(cw + 4 * DFF + cc), bb = *(const f32x4*)(cb + cc);
#pragma unroll
                for (int ai = 0; ai < 2; ++ai) {
                    f32x4 p1 = {0.f, 0.f, 0.f, 0.f}, p2 = p1;
#pragma unroll
                    for (int m = 0; m < 4; ++m) {
                        f32x4 v = acc[ai][bj][m][n];
                        asm volatile("" : "+v"(v));
                        f32x4 r1, r2, hh;
#pragma unroll
                        for (int j = 0; j < 4; ++j) {
                            r1[j] = dpp_ror<0x121>(v[j]);
                            r2[j] = dpp_ror<0x122>(v[j]);
                        }
#pragma unroll
                        for (int j = 0; j < 4; ++j) { const float x1 = fr >= 1 ? r1[j] : p1[j], x2 = fr >= 2 ? r2[j] : p2[j]; hh[j] = bb[j] + w2[j] * v[j] + w1[j] * x1 + w0[j] * x2; }
                        asm volatile("" : "+v"(hh));
                        acc[ai][bj][m][n] = hh; p1 = r1; p2 = r2;
                    }
                }
            }
        asm volatile("" ::: "memory");
#pragma unroll
        for (int ai = 0; ai < 2; ++ai)
#pragma unroll
            for (int m = 0; m < 4; ++m) {
                const int rl = ai * 128 + wr * 64 + m * 16 + fr;
                bool st;
                if (!halo) st = !(m == 0 && fr < 2) || (u.pm == 0 && ai == 0 && wr == 0);
                else st = ((fr & 3) >= 2) && ((((u.pm - 32) * 256 + rl) >> 2) + 1 <= 127);
                if (st) { const f32x4 g0 = acc[ai][0][m][0], g1 = acc[ai][0][m][1], u0 = acc[ai][1][m][0], u1 = acc[ai][1][m][1];
                    u32x4 w; w.x = cvt_pk_bf16(silu_f(g0[0]) * u0[0], silu_f(g0[1]) * u0[1]); w.y = cvt_pk_bf16(silu_f(g0[2]) * u0[2], silu_f(g0[3]) * u0[3]);
                    w.z = cvt_pk_bf16(silu_f(g1[0]) * u1[0], silu_f(g1[1]) * u1[1]); w.w = cvt_pk_bf16(silu_f(g1[2]) * u1[2], silu_f(g1[3]) * u1[3]);
                    *(u32x4*)(act + (size_t)grow_of(u, rl) * DFF + gc0) = w; }
            }
    }
};

struct Ctx {
    LAS unsigned char* lds;
    int tid, lane, wave, nb, bid;
    const float* const* in;
    float* out;
    unsigned char* ws;
};

template <int MODE>
__device__ __forceinline__ void prep_w_item(const float* __restrict__ W, int K, int N, bf16_t* __restrict__ Wt, LAS float* scr, int item, int lane) {
    const int nblk = N / 32, kb = item / nblk, nb = item % nblk, k0 = 64 * kb, n0 = 32 * nb;
    int orow = n0;
    if (MODE == 1) orow = (n0 < DFF) ? 256 * (n0 >> 7) + (n0 & 127) : 256 * ((n0 - DFF) >> 7) + 128 + ((n0 - DFF) & 127);
    const float* src = W + (size_t)(k0 + (lane >> 5)) * N + n0 + (lane & 31);
    float v[32];
#pragma unroll
    for (int i = 0; i < 32; ++i) v[i] = __builtin_nontemporal_load(src + (size_t)(2 * i) * N);
#pragma unroll
    for (int i = 0; i < 32; ++i) scr[(2 * i + (lane >> 5)) * 33 + (lane & 31)] = v[i];
    asm volatile("s_waitcnt lgkmcnt(0)" ::: "memory");
    const int cchunk = lane & 7;
#pragma unroll
    for (int j = 0; j < 4; ++j) { const int n = (lane >> 3) + 8 * j; const LAS float* sp = scr + (8 * cchunk) * 33 + n;
        u32x4 o; o.x = pk2(sp[0 * 33], sp[1 * 33]); o.y = pk2(sp[2 * 33], sp[3 * 33]); o.z = pk2(sp[4 * 33], sp[5 * 33]); o.w = pk2(sp[6 * 33], sp[7 * 33]);
        *(u32x4*)(Wt + (size_t)(orow + n) * K + k0 + 8 * cchunk) = o; }
    asm volatile("s_waitcnt lgkmcnt(0)" ::: "memory");
}
__device__ __forceinline__ void phase_prep(const Ctx& c) {
    const int gw = c.bid * 8 + c.wave, NGW = c.nb * 8;
    const float* w_in = c.in[3]; const float* w_out = c.in[15]; const float* w_up = c.in[17]; const float* w_dn = c.in[20]; const float* w_pg = c.in[22]; const float* w_ple = c.in[23];
    LAS float* scr = (LAS float*)(c.lds + c.wave * 16384);
    constexpr int I_IN = (D / 64) * (DIN / 32), I_OUT = (DMIX / 64) * (D / 32), I_UP = (D / 64) * (2 * DFF / 32), I_DN = (DFF / 64) * (D / 32), I_PG = (D / 64) * (D / 32), I_PLE = (DPLE / 64) * (D / 32);
    constexpr int NIT = I_IN + I_OUT + I_UP + I_DN + I_PG + I_PLE;
#pragma unroll 1
    for (int it = gw; it < NIT; it += NGW) {
        int r = it;
        if (r < I_IN) { prep_w_item<0>(w_in, D, DIN, (bf16_t*)(c.ws + WS_WIN), scr, r, c.lane); continue; } r -= I_IN;
        if (r < I_UP) { prep_w_item<1>(w_up, D, 2 * DFF, (bf16_t*)(c.ws + WS_WUP), scr, r, c.lane); continue; } r -= I_UP;
        if (r < I_OUT) { prep_w_item<0>(w_out, DMIX, D, (bf16_t*)(c.ws + WS_WOUT), scr, r, c.lane); continue; } r -= I_OUT;
        if (r < I_DN) { prep_w_item<0>(w_dn, DFF, D, (bf16_t*)(c.ws + WS_WDN), scr, r, c.lane); continue; } r -= I_DN;
        if (r < I_PG) { prep_w_item<0>(w_pg, D, D, (bf16_t*)(c.ws + WS_WPG), scr, r, c.lane); continue; } r -= I_PG;
        prep_w_item<0>(w_ple, DPLE, D, (bf16_t*)(c.ws + WS_WPLE), scr, r, c.lane);
    }
    const float* x = c.in[0]; const float* g = c.in[2]; bf16_t* A = (bf16_t*)(c.ws + WS_A);
    for (int m = gw * 2; m < S; m += NGW * 2) {
        const float* xr = x + (size_t)m * D + 8 * c.lane; f32x4 v[2][4][2]; float s0 = 0.f, s1 = 0.f;
#pragma unroll
        for (int rr = 0; rr < 2; ++rr)
#pragma unroll
            for (int j = 0; j < 4; ++j) { v[rr][j][0] = __builtin_nontemporal_load((const f32x4*)(xr + (size_t)rr * D + 512 * j)); v[rr][j][1] = __builtin_nontemporal_load((const f32x4*)(xr + (size_t)rr * D + 512 * j + 4)); }
#pragma unroll
        for (int j = 0; j < 4; ++j)
#pragma unroll
            for (int e = 0; e < 4; ++e) { s0 += v[0][j][0][e] * v[0][j][0][e] + v[0][j][1][e] * v[0][j][1][e]; s1 += v[1][j][0][e] * v[1][j][0][e] + v[1][j][1][e] * v[1][j][1][e]; }
#pragma unroll
        for (int o = 1; o < 64; o <<= 1) { s0 += __shfl_xor(s0, o); s1 += __shfl_xor(s1, o); }
        const float ri[2] = {1.0f / sqrtf(s0 * (1.0f / D) + EPS), 1.0f / sqrtf(s1 * (1.0f / D) + EPS)};
#pragma unroll
        for (int j = 0; j < 4; ++j) { const f32x4 g0 = *(const f32x4*)(g + 8 * c.lane + 512 * j), g1 = *(const f32x4*)(g + 8 * c.lane + 512 * j + 4);
#pragma unroll
            for (int rr = 0; rr < 2; ++rr) { const f32x4 a0 = v[rr][j][0] * ri[rr] * g0, a1 = v[rr][j][1] * ri[rr] * g1;
                u32x4 o; o.x = pk2(a0[0], a0[1]); o.y = pk2(a0[2], a0[3]); o.z = pk2(a1[0], a1[1]); o.w = pk2(a1[2], a1[3]);
                *(u32x4*)(A + (size_t)(m + rr) * D + 8 * c.lane + 512 * j) = o; } }
    }
    const float* p = c.in[1]; bf16_t* P16 = (bf16_t*)(c.ws + WS_P16);
    for (size_t i = ((size_t)c.bid * 512 + c.tid) * 8; i < (size_t)S * DPLE; i += (size_t)c.nb * 512 * 8) {
        const f32x4 a0 = *(const f32x4*)(p + i), a1 = *(const f32x4*)(p + i + 4);
        u32x4 o; o.x = pk2(a0[0], a0[1]); o.y = pk2(a0[2], a0[3]); o.z = pk2(a1[0], a1[1]); o.w = pk2(a1[2], a1[3]);
        *(u32x4*)(P16 + i) = o;
    }
}

__device__ __forceinline__ void phase_dt(const Ctx& c) {
    const bf16_t* A = (const bf16_t*)(c.ws + WS_A); const bf16_t* Wdt = (const bf16_t*)(c.ws + WS_WIN) + (size_t)10240 * D;
    float* dt = (float*)(c.ws + WS_DT); const float* dtb = c.in[11];
    LAS float* red = (LAS float*)c.lds;
    const int r = c.lane & 31, h = c.lane >> 5;
    for (int item = c.bid; item < S / 32; item += c.nb) {
        const int row0 = item * 32;
        f32x16 acc; for (int i = 0; i < 16; ++i) acc[i] = 0.f;
        const bf16_t* ap = A + (size_t)(row0 + r) * D + c.wave * 256 + 8 * h;
        const bf16_t* bp = Wdt + (size_t)r * D + c.wave * 256 + 8 * h;
#pragma unroll 4
        for (int s = 0; s < 16; ++s) { const bf16x8 af = *(const bf16x8*)(ap + 16 * s), bfr = *(const bf16x8*)(bp + 16 * s);
            acc = __builtin_amdgcn_mfma_f32_32x32x16_bf16(af, bfr, acc, 0, 0, 0); }
#pragma unroll
        for (int i = 0; i < 16; ++i) red[(c.wave * 32 + ((i & 3) + 8 * (i >> 2) + 4 * h)) * 32 + r] = acc[i];
        __syncthreads();
        for (int o = c.tid; o < 1024; o += 512) { float s = 0.f;
#pragma unroll
            for (int w = 0; w < 8; ++w) s += red[w * 1024 + o];
            const int hd = o & 31; const float xv = s + dtb[hd];
            const float sp = xv > 20.f ? xv : log1pf(__expf(xv));
            dt[(size_t)(row0 + (o >> 5)) * 32 + hd] = sp; }
        __syncthreads();
    }
}

template <int W>
__device__ __forceinline__ void stage_conv_tile(const Ctx& c, LAS unsigned char* dst, int pitchB, int col0, int t0, const LAS float* scale) {
    const bf16_t* xbc = (const bf16_t*)(c.ws + WS_XBC); const float* cw = c.in[9]; const float* cb = c.in[10];
    constexpr int NCHK = W / 8, NGRPS = 512 / NCHK, RPT = 128 / NGRPS;
    const int ch = c.tid % NCHK, grp = c.tid / NCHK; const int cc = col0 + ch * 8;
    float w[4][8], b[8];
#pragma unroll
    for (int k = 0; k < 4; ++k) { const f32x4 a0 = *(const f32x4*)(cw + (size_t)k * DXBC + cc), a1 = *(const f32x4*)(cw + (size_t)k * DXBC + cc + 4);
#pragma unroll
        for (int e = 0; e < 4; ++e) { w[k][e] = a0[e]; w[k][4 + e] = a1[e]; } }
    { const f32x4 a0 = *(const f32x4*)(cb + cc), a1 = *(const f32x4*)(cb + cc + 4);
#pragma unroll
      for (int e = 0; e < 4; ++e) { b[e] = a0[e]; b[4 + e] = a1[e]; } }
    const int r0 = grp * RPT;
    float x0[8], x1[8], x2[8];
#pragma unroll
    for (int e = 0; e < 8; ++e) { x0[e] = 0.f; x1[e] = 0.f; x2[e] = 0.f; }
    {
        const int t = t0 + r0;
        if (t - 3 >= 0) { const u32x4 q = *(const u32x4*)(xbc + (size_t)(t - 3) * DXBC + cc); x0[0] = bflo(q.x); x0[1] = bfhi(q.x); x0[2] = bflo(q.y); x0[3] = bfhi(q.y); x0[4] = bflo(q.z); x0[5] = bfhi(q.z); x0[6] = bflo(q.w); x0[7] = bfhi(q.w); }
        if (t - 2 >= 0) { const u32x4 q = *(const u32x4*)(xbc + (size_t)(t - 2) * DXBC + cc); x1[0] = bflo(q.x); x1[1] = bfhi(q.x); x1[2] = bflo(q.y); x1[3] = bfhi(q.y); x1[4] = bflo(q.z); x1[5] = bfhi(q.z); x1[6] = bflo(q.w); x1[7] = bfhi(q.w); }
        if (t - 1 >= 0) { const u32x4 q = *(const u32x4*)(xbc + (size_t)(t - 1) * DXBC + cc); x2[0] = bflo(q.x); x2[1] = bfhi(q.x); x2[2] = bflo(q.y); x2[3] = bfhi(q.y); x2[4] = bflo(q.z); x2[5] = bfhi(q.z); x2[6] = bflo(q.w); x2[7] = bfhi(q.w); }
    }
#pragma unroll
    for (int i = 0; i < RPT; ++i) {
        const int rl = r0 + i, t = t0 + rl;
        const u32x4 q = *(const u32x4*)(xbc + (size_t)t * DXBC + cc);
        float x3[8]; x3[0] = bflo(q.x); x3[1] = bfhi(q.x); x3[2] = bflo(q.y); x3[3] = bfhi(q.y); x3[4] = bflo(q.z); x3[5] = bfhi(q.z); x3[6] = bflo(q.w); x3[7] = bfhi(q.w);
        float sc = 1.f; if (scale) sc = scale[rl * 4 + (ch * 8) / 64];
        float o[8];
#pragma unroll
        for (int e = 0; e < 8; ++e) { const float hsum = b[e] + w[0][e] * x0[e] + w[1][e] * x1[e] + w[2][e] * x2[e] + w[3][e] * x3[e]; o[e] = silu_f(hsum) * sc; x0[e] = x1[e]; x1[e] = x2[e]; x2[e] = x3[e]; }
        u32x4 ov; ov.x = pk2(o[0], o[1]); ov.y = pk2(o[2], o[3]); ov.z = pk2(o[4], o[5]); ov.w = pk2(o[6], o[7]);
        *(LAS u32x4*)(dst + rl * pitchB + ch * 16) = ov;
    }
}

__device__ __forceinline__ void ssd_tables(const Ctx& c, int ck, int g, LAS float* sdt, LAS float* sacs) {
    const float* dt = (const float*)(c.ws + WS_DT); const float* alog = c.in[12];
    { const int l = c.tid >> 2, h = c.tid & 3; const float dv = dt[(size_t)(ck * 128 + l) * 32 + g * 4 + h]; sdt[l * 4 + h] = dv; sacs[l * 4 + h] = dv * (-__expf(alog[g * 4 + h])); }
    __syncthreads();
    if (c.wave < 4) { const int h = c.wave; const float v0 = sacs[(2 * c.lane) * 4 + h], v1 = sacs[(2 * c.lane + 1) * 4 + h]; float s = v0 + v1;
#pragma unroll
        for (int d = 1; d < 64; d <<= 1) { const float t = __shfl_up(s, d); if (c.lane >= d) s += t; }
        const float ex = s - (v0 + v1);
        sacs[(2 * c.lane) * 4 + h] = ex + v0; sacs[(2 * c.lane + 1) * 4 + h] = s; }
    __syncthreads();
}

constexpr int XS_PITCH = 576, BC_PITCH = 320;
constexpr int L_XS = 0, L_B = 128 * XS_PITCH, L_C = L_B + 128 * BC_PITCH, L_TAB = L_C + 128 * BC_PITCH;
constexpr int L_SDT = L_TAB, L_SACS = L_TAB + 2048, L_SW = L_TAB + 4096, L_MISC = L_TAB + 6144;
static_assert(L_MISC + 2048 <= LDS_BYTES, "mixer LDS map");

__device__ __forceinline__ void ssd_a_item(const Ctx& c, int ck, int g) {
    LAS float* sdt = (LAS float*)(c.lds + L_SDT); LAS float* sacs = (LAS float*)(c.lds + L_SACS); LAS float* sw = (LAS float*)(c.lds + L_SW);
    ssd_tables(c, ck, g, sdt, sacs);
    { const int l = c.tid >> 2, h = c.tid & 3; sw[l * 4 + h] = sdt[l * 4 + h] * __expf(sacs[127 * 4 + h] - sacs[l * 4 + h]); }
    if (c.tid < 4) ((float*)(c.ws + WS_CDEC))[ck * 32 + g * 4 + c.tid] = __expf(sacs[127 * 4 + c.tid]);
    __syncthreads();
    stage_conv_tile<256>(c, c.lds + L_XS, XS_PITCH, g * 256, ck * 128, sw);
    stage_conv_tile<128>(c, c.lds + L_B, BC_PITCH, DSSM + g * 128, ck * 128, nullptr);
    __syncthreads();
    bf16_t* st = (bf16_t*)(c.ws + WS_ST) + (size_t)(ck * 32 + g * 4) * 64 * 128;
    for (int o = c.tid; o < 4 * 64 * 128; o += 512) { const int n = o & 127, hp = o >> 7; float s = 0.f;
        for (int l = 0; l < 128; ++l) s += bf2f(*(LAS bf16_t*)(c.lds + L_B + l * BC_PITCH + n * 2)) * bf2f(*(LAS bf16_t*)(c.lds + L_XS + l * XS_PITCH + hp * 2));
        st[o] = (bf16_t)f2bf(s); }
    __syncthreads();
}

__device__ __forceinline__ void gmlp_item(const Ctx& c, int ck, int g) {
    bf16_t* uv = (bf16_t*)(c.ws + WS_UV);
    LAS float* vn = (LAS float*)c.lds;
    LAS float* ssq = (LAS float*)(c.lds + 65536);
    const float* lng = c.in[4] + g * 128; const float* lnb = c.in[5] + g * 128; const float* Ws = c.in[6] + (size_t)g * 128 * 128; const float* bs = c.in[7] + g * 128; const float* nag = c.in[8] + g * 128;
    for (int s = c.wave; s < 128; s += 8) {
        const bf16_t* vr = uv + (size_t)(ck * 128 + s) * DMIX + DA + g * 128;
        const float a0 = bf2f(vr[c.lane]), a1 = bf2f(vr[c.lane + 64]);
        const float mu = wave_sum(a0 + a1) * (1.0f / 128.0f); const float d0 = a0 - mu, d1 = a1 - mu;
        const float var = wave_sum(d0 * d0 + d1 * d1) * (1.0f / 128.0f); const float rs = 1.0f / sqrtf(var + EPS);
        vn[s * 128 + c.lane] = d0 * rs * lng[c.lane] + lnb[c.lane]; vn[s * 128 + c.lane + 64] = d1 * rs * lng[c.lane + 64] + lnb[c.lane + 64];
    }
    __syncthreads();
    const int d = c.tid & 127;
    for (int j = 0; j < 32; ++j) {
        const int t = (c.tid >> 7) + 4 * j; float sg = bs[t]; const float* wr_ = Ws + t * 128;
        for (int s = 0; s <= t; ++s) sg += wr_[s] * vn[s * 128 + d];
        bf16_t* up = uv + (size_t)(ck * 128 + t) * DMIX + g * 128 + d;
        const float y = bf2f(*up) * sg;
        *up = (bf16_t)f2bf(y * nag[d]);
        const float q = wave_sum(y * y);
        if (c.lane == 0) ssq[t * 2 + (c.wave & 1)] = q;
    }
    __syncthreads();
    if (c.tid < 128) ((float*)(c.ws + WS_SSQA))[(size_t)(ck * 128 + c.tid) * 16 + g] = ssq[c.tid * 2] + ssq[c.tid * 2 + 1];
    __syncthreads();
}

typedef short s16x4 __attribute__((ext_vector_type(4)));
typedef short v4i16_t __attribute__((ext_vector_type(4)));
__device__ __forceinline__ s16x4 ds_tr(LAS const unsigned char* p) { return __builtin_bit_cast(s16x4, __builtin_amdgcn_ds_read_tr16_b64_v4i16((LAS v4i16_t*)p)); }
__device__ __forceinline__ bf16x8 frag_tr(LAS const unsigned char* tile, int pitch, int k0, int c0, int lane) {
    const int hh = lane >> 5, blk = (lane >> 4) & 1, q = (lane & 15) >> 2, p = lane & 3;
    LAS const unsigned char* a = tile + (k0 + 8 * hh + q) * pitch + (c0 + 16 * blk + 4 * p) * 2;
    const s16x4 lo = ds_tr(a), hi = ds_tr(a + 4 * pitch);
    return __builtin_shufflevector(lo, hi, 0, 1, 2, 3, 4, 5, 6, 7);
}
__device__ __forceinline__ bf16x8 frag_tr_perm(LAS const unsigned char* tile, int pitch, int k0, int c0, int lane) {
    const int hh = lane >> 5, blk = (lane >> 4) & 1, q = (lane & 15) >> 2, p = lane & 3;
    LAS const unsigned char* a = tile + (k0 + 4 * hh + q) * pitch + (c0 + 16 * blk + 4 * p) * 2;
    const s16x4 lo = ds_tr(a), hi = ds_tr(a + 8 * pitch);
    return __builtin_shufflevector(lo, hi, 0, 1, 2, 3, 4, 5, 6, 7);
}
__device__ __forceinline__ bf16x8 frag_row(LAS const unsigned char* tile, int pitch, int r0, int k0, int lane) {
    return *(LAS const bf16x8*)(tile + (r0 + (lane & 31)) * pitch + (k0 + 8 * (lane >> 5)) * 2);
}
__device__ __forceinline__ bf16x8 pack_frag(const float* v) {
    u32x4 w; w.x = cvt_pk_bf16(v[0], v[1]); w.y = cvt_pk_bf16(v[2], v[3]); w.z = cvt_pk_bf16(v[4], v[5]); w.w = cvt_pk_bf16(v[6], v[7]);
    return __builtin_bit_cast(bf16x8, w);
}
#define MFMA32(a, b, c) __builtin_amdgcn_mfma_f32_32x32x16_bf16((a), (b), (c), 0, 0, 0)

constexpr int G_WP = 272, G_VP = 320, G_SGP = 528, GL_WS = 0, GL_VT = 128 * G_WP, GL_SG = GL_VT + 128 * G_VP;
static_assert(GL_SG + 128 * G_SGP <= 155648, "gMLP LDS map");
__device__ __forceinline__ void gmlp_stage_ws(const Ctx& c, int g) {
    const float* Ws = c.in[6] + (size_t)g * 128 * 128;
#pragma unroll
    for (int i = 0; i < 4; ++i) { const int idx = c.tid + 512 * i, t = idx >> 4, s8 = (idx & 15) * 8;
        const f32x4 w0 = *(const f32x4*)(Ws + t * 128 + s8), w1 = *(const f32x4*)(Ws + t * 128 + s8 + 4);
        float wv[8];
#pragma unroll
        for (int j = 0; j < 4; ++j) { wv[j] = (s8 + j <= t) ? w0[j] : 0.f; wv[4 + j] = (s8 + 4 + j <= t) ? w1[j] : 0.f; }
        *(LAS bf16x8*)(c.lds + GL_WS + t * G_WP + s8 * 2) = pack_frag(wv); }
}
__device__ __forceinline__ void gmlp_load_v(const Ctx& c, int ck, int g, u32x4 (&vr)[4]) {
    const bf16_t* uv = (const bf16_t*)(c.ws + WS_UV);
#pragma unroll
    for (int i = 0; i < 4; ++i) { const int row = (c.tid >> 4) + 32 * i; vr[i] = *(const u32x4*)(uv + (size_t)(ck * 128 + row) * DMIX + DA + g * 128 + (c.tid & 15) * 8); }
}
__device__ __forceinline__ void gmlp_items(const Ctx& c, int g, int ck0, int ckstep, int nitems) {
    bf16_t* uv = (bf16_t*)(c.ws + WS_UV);
    LAS unsigned char* vt = c.lds + GL_VT;
    const float* lng = c.in[4] + g * 128; const float* lnb = c.in[5] + g * 128; const float* bs = c.in[7] + g * 128; const float* nag = c.in[8] + g * 128;
    const int lane = c.lane, d8 = (c.tid & 15) * 8;
    gmlp_stage_ws(c, g);
    const f32x4 lg0 = *(const f32x4*)(lng + d8), lg1 = *(const f32x4*)(lng + d8 + 4), lb0 = *(const f32x4*)(lnb + d8), lb1 = *(const f32x4*)(lnb + d8 + 4);
    u32x4 vr[4];
    gmlp_load_v(c, ck0, g, vr);
    const int db = c.wave & 3, hh = lane >> 5, r = lane & 31;
    for (int it = 0; it < nitems; ++it) {
        const int ck = ck0 + it * ckstep;
#pragma unroll
        for (int i = 0; i < 4; ++i) { const int row = (c.tid >> 4) + 32 * i;
            float x[8] = {bflo(vr[i].x), bfhi(vr[i].x), bflo(vr[i].y), bfhi(vr[i].y), bflo(vr[i].z), bfhi(vr[i].z), bflo(vr[i].w), bfhi(vr[i].w)};
            float s1 = 0.f, s2 = 0.f;
#pragma unroll
            for (int j = 0; j < 8; ++j) { s1 += x[j]; s2 += x[j] * x[j]; }
#pragma unroll
            for (int o = 1; o < 16; o <<= 1) { s1 += __shfl_xor(s1, o); s2 += __shfl_xor(s2, o); }
            const float mu = s1 * (1.0f / 128.0f); const float var = fmaxf(s2 * (1.0f / 128.0f) - mu * mu, 0.f); const float rs = 1.0f / sqrtf(var + EPS);
            float y[8];
#pragma unroll
            for (int j = 0; j < 4; ++j) { y[j] = (x[j] - mu) * rs * lg0[j] + lb0[j]; y[4 + j] = (x[4 + j] - mu) * rs * lg1[j] + lb1[j]; }
            *(LAS bf16x8*)(vt + row * G_VP + d8 * 2) = pack_frag(y); }
        __syncthreads();
        u32x4 ur[4];
#pragma unroll
        for (int i = 0; i < 4; ++i) { const int t = c.wave * 16 + 4 * i + (lane >> 4); ur[i] = *(const u32x4*)(uv + (size_t)(ck * 128 + t) * DMIX + g * 128 + (lane & 15) * 8); }
        if (it + 1 < nitems) gmlp_load_v(c, ck + ckstep, g, vr);
#pragma unroll
        for (int tt = 0; tt < 2; ++tt) {
            const int tb = (c.wave < 4) ? (tt ? 3 : 0) : (tt ? 2 : 1);
            f32x16 acc; for (int i = 0; i < 16; ++i) acc[i] = 0.f;
            for (int ks = 0; ks < 2 * (tb + 1); ++ks)
                acc = MFMA32(frag_tr(vt, G_VP, 16 * ks, db * 32, lane), frag_row(c.lds + GL_WS, G_WP, tb * 32, 16 * ks, lane), acc);
#pragma unroll
            for (int gq = 0; gq < 4; ++gq) *(LAS f32x4*)(c.lds + GL_SG + (tb * 32 + r) * G_SGP + (db * 32 + 8 * gq + 4 * hh) * 4) = (f32x4){acc[4 * gq], acc[4 * gq + 1], acc[4 * gq + 2], acc[4 * gq + 3]};
        }
        __syncthreads();
#pragma unroll
        for (int i = 0; i < 4; ++i) {
            const int t = c.wave * 16 + 4 * i + (lane >> 4), dd = (lane & 15) * 8;
            const f32x4 g0 = *(LAS const f32x4*)(c.lds + GL_SG + t * G_SGP + dd * 4), g1 = *(LAS const f32x4*)(c.lds + GL_SG + t * G_SGP + dd * 4 + 16);
            const float bst = bs[t];
            const f32x4 na0 = *(const f32x4*)(nag + dd), na1 = *(const f32x4*)(nag + dd + 4);
            float y[8] = {bflo(ur[i].x) * (g0[0] + bst), bfhi(ur[i].x) * (g0[1] + bst), bflo(ur[i].y) * (g0[2] + bst), bfhi(ur[i].y) * (g0[3] + bst),
                          bflo(ur[i].z) * (g1[0] + bst), bfhi(ur[i].z) * (g1[1] + bst), bflo(ur[i].w) * (g1[2] + bst), bfhi(ur[i].w) * (g1[3] + bst)};
            float ss = 0.f;
#pragma unroll
            for (int j = 0; j < 8; ++j) ss += y[j] * y[j];
#pragma unroll
            for (int o = 1; o < 16; o <<= 1) ss += __shfl_xor(ss, o);
            u32x4 o4; o4.x = pk2(y[0] * na0[0], y[1] * na0[1]); o4.y = pk2(y[2] * na0[2], y[3] * na0[3]); o4.z = pk2(y[4] * na1[0], y[5] * na1[1]); o4.w = pk2(y[6] * na1[2], y[7] * na1[3]);
            *(u32x4*)(uv + (size_t)(ck * 128 + t) * DMIX + g * 128 + dd) = o4;
            if ((lane & 15) == 0) ((float*)(c.ws + WS_SSQA))[(size_t)(ck * 128 + t) * 16 + g] = ss;
        }
    }
    __syncthreads();
}

__device__ __forceinline__ void ssd_a_item_mfma(const Ctx& c, int ck, int g) {
    LAS float* sdt = (LAS float*)(c.lds + L_SDT); LAS float* sacs = (LAS float*)(c.lds + L_SACS); LAS float* sw = (LAS float*)(c.lds + L_SW);
    ssd_tables(c, ck, g, sdt, sacs);
    { const int l = c.tid >> 2, h = c.tid & 3; sw[l * 4 + h] = sdt[l * 4 + h] * __expf(sacs[127 * 4 + h] - sacs[l * 4 + h]); }
    if (c.tid < 4) ((float*)(c.ws + WS_CDEC))[ck * 32 + g * 4 + c.tid] = __expf(sacs[127 * 4 + c.tid]);
    __syncthreads();
    stage_conv_tile<256>(c, c.lds + L_XS, XS_PITCH, g * 256, ck * 128, sw);
    stage_conv_tile<128>(c, c.lds + L_B, BC_PITCH, DSSM + g * 128, ck * 128, nullptr);
    __syncthreads();
    const int lane = c.lane, h = c.wave >> 1, pb = c.wave & 1, hh = lane >> 5, r = lane & 31;
    f32x16 acc[4];
#pragma unroll
    for (int nb = 0; nb < 4; ++nb) for (int i = 0; i < 16; ++i) acc[nb][i] = 0.f;
#pragma unroll 2
    for (int ks = 0; ks < 8; ++ks) {
        const bf16x8 xf = frag_tr(c.lds + L_XS, XS_PITCH, 16 * ks, h * 64 + pb * 32, lane);
#pragma unroll
        for (int nb = 0; nb < 4; ++nb) { const bf16x8 bfg = frag_tr(c.lds + L_B, BC_PITCH, 16 * ks, nb * 32, lane); acc[nb] = MFMA32(bfg, xf, acc[nb]); }
    }
    __syncthreads();
    LAS unsigned char* stg = c.lds + L_XS + c.wave * (32 * 272);
#pragma unroll
    for (int nb = 0; nb < 4; ++nb)
#pragma unroll
        for (int gq = 0; gq < 4; ++gq) { u32x2 o; o.x = pk2(acc[nb][4 * gq], acc[nb][4 * gq + 1]); o.y = pk2(acc[nb][4 * gq + 2], acc[nb][4 * gq + 3]);
            *(LAS u32x2*)(stg + r * 272 + (nb * 32 + 8 * gq + 4 * hh) * 2) = o; }
    bf16_t* st = (bf16_t*)(c.ws + WS_ST) + ((size_t)(ck * 32 + g * 4 + h) * 64 + pb * 32) * 128;
#pragma unroll
    for (int i = 0; i < 8; ++i) { const int prow = 4 * i + (lane >> 4), chk = lane & 15;
        *(u32x4*)(st + (size_t)prow * 128 + chk * 8) = *(LAS const u32x4*)(stg + prow * 272 + chk * 16); }
    __syncthreads();
}

constexpr int BC2_PITCH = 272;
__device__ __forceinline__ void ssd_c_item_mfma(const Ctx& c, int ck, int g) {
    LAS float* sdt = (LAS float*)(c.lds + L_SDT); LAS float* sacs = (LAS float*)(c.lds + L_SACS); LAS float* part = (LAS float*)(c.lds + L_SW);
    ssd_tables(c, ck, g, sdt, sacs);
    stage_conv_tile<256>(c, c.lds + L_XS, XS_PITCH, g * 256, ck * 128, nullptr);
    stage_conv_tile<128>(c, c.lds + L_B, BC2_PITCH, DSSM + g * 128, ck * 128, nullptr);
    stage_conv_tile<128>(c, c.lds + L_C, BC2_PITCH, DSSM + NGRP * NST + g * 128, ck * 128, nullptr);
    __syncthreads();
    const int lane = c.lane, h = c.wave >> 1, hh = lane >> 5, r = lane & 31;
    const float Dh = c.in[13][g * 4 + h];
    const bf16_t* hin = (const bf16_t*)(c.ws + WS_ST) + (size_t)(ck * 32 + g * 4 + h) * 64 * 128;
    LAS const unsigned char* xs = c.lds + L_XS; LAS const unsigned char* bt = c.lds + L_B; LAS const unsigned char* ct = c.lds + L_C;
    f32x16 acc[2][2];
#pragma unroll
    for (int lbi = 0; lbi < 2; ++lbi) {
        const int lb = (c.wave & 1) ? (lbi ? 2 : 1) : (lbi ? 3 : 0);
        const int l = lb * 32 + r;
        bf16x8 cf[8];
#pragma unroll
        for (int ks = 0; ks < 8; ++ks) cf[ks] = frag_row(ct, BC2_PITCH, lb * 32, 16 * ks, lane);
        f32x16 a0, a1; for (int i = 0; i < 16; ++i) { a0[i] = 0.f; a1[i] = 0.f; }
#pragma unroll
        for (int ks = 0; ks < 8; ++ks) {
            const bf16x8 h0 = *(const bf16x8*)(hin + (size_t)r * 128 + 16 * ks + 8 * hh), h1 = *(const bf16x8*)(hin + (size_t)(32 + r) * 128 + 16 * ks + 8 * hh);
            a0 = MFMA32(h0, cf[ks], a0); a1 = MFMA32(h1, cf[ks], a1);
        }
        const float al = sacs[l * 4 + h]; const float ea = __expf(al);
        a0 = a0 * ea; a1 = a1 * ea;
        for (int sb = 0; sb <= lb; ++sb) {
            f32x16 X; for (int i = 0; i < 16; ++i) X[i] = 0.f;
#pragma unroll
            for (int ks = 0; ks < 8; ++ks) X = MFMA32(frag_row(bt, BC2_PITCH, sb * 32, 16 * ks, lane), cf[ks], X);
            bf16x8 mf[2];
#pragma unroll
            for (int kk = 0; kk < 2; ++kk) {
                float mv[8];
#pragma unroll
                for (int j = 0; j < 8; ++j) {
                    const int sidx = sb * 32 + 16 * kk + 8 * (j >> 2) + 4 * hh + (j & 3);
                    float v = X[8 * kk + j] * __expf(al - sacs[sidx * 4 + h]) * sdt[sidx * 4 + h];
                    v = (sidx <= l) ? v : 0.f;
                    mv[j] = (sidx == l) ? v + Dh : v;
                }
                mf[kk] = pack_frag(mv);
            }
#pragma unroll
            for (int kk = 0; kk < 2; ++kk) {
                const bf16x8 x0 = frag_tr_perm(xs, XS_PITCH, sb * 32 + 16 * kk, h * 64, lane), x1 = frag_tr_perm(xs, XS_PITCH, sb * 32 + 16 * kk, h * 64 + 32, lane);
                a0 = MFMA32(x0, mf[kk], a0); a1 = MFMA32(x1, mf[kk], a1);
            }
        }
        acc[lbi][0] = a0; acc[lbi][1] = a1;
    }
    const bf16_t* zs = (const bf16_t*)(c.ws + WS_ZS); bf16_t* cat = (bf16_t*)(c.ws + WS_UV); const float* ng = c.in[14] + g * 256;
    constexpr int YP = 528;
    u32x4 zr[8];
#pragma unroll
    for (int i = 0; i < 8; ++i) { const int l = c.wave * 16 + 2 * i + hh; zr[i] = *(const u32x4*)(zs + ((size_t)ck * 128 + l) * DSSM + g * 256 + r * 8); }
    __syncthreads();
    LAS unsigned char* yt = c.lds + L_XS;
#pragma unroll
    for (int lbi = 0; lbi < 2; ++lbi) {
        const int lb = (c.wave & 1) ? (lbi ? 2 : 1) : (lbi ? 3 : 0);
        const int l = lb * 32 + r;
#pragma unroll
        for (int pb = 0; pb < 2; ++pb)
#pragma unroll
            for (int gq = 0; gq < 4; ++gq) { u32x2 o; o.x = cvt_pk_bf16(acc[lbi][pb][4 * gq], acc[lbi][pb][4 * gq + 1]); o.y = cvt_pk_bf16(acc[lbi][pb][4 * gq + 2], acc[lbi][pb][4 * gq + 3]);
                *(LAS u32x2*)(yt + l * YP + (h * 64 + pb * 32 + 8 * gq + 4 * hh) * 2) = o; }
    }
    __syncthreads();
    const f32x4 gg0 = *(const f32x4*)(ng + r * 8), gg1 = *(const f32x4*)(ng + r * 8 + 4);
#pragma unroll
    for (int i = 0; i < 8; ++i) {
        const int l = c.wave * 16 + 2 * i + hh; const size_t row = (size_t)ck * 128 + l;
        const u32x4 yw = *(LAS const u32x4*)(yt + l * YP + r * 16);
        float y[8] = {bflo(yw.x) * bflo(zr[i].x), bfhi(yw.x) * bfhi(zr[i].x), bflo(yw.y) * bflo(zr[i].y), bfhi(yw.y) * bfhi(zr[i].y),
                      bflo(yw.z) * bflo(zr[i].z), bfhi(yw.z) * bfhi(zr[i].z), bflo(yw.w) * bflo(zr[i].w), bfhi(yw.w) * bfhi(zr[i].w)};
        float ss = 0.f;
#pragma unroll
        for (int j = 0; j < 8; ++j) ss += y[j] * y[j];
#pragma unroll
        for (int o = 1; o < 32; o <<= 1) ss += __shfl_xor(ss, o);
        const float rinv = 1.0f / sqrtf(ss * (1.0f / 256.0f) + EPS);
        u32x4 o4; o4.x = pk2(y[0] * rinv * gg0[0], y[1] * rinv * gg0[1]); o4.y = pk2(y[2] * rinv * gg0[2], y[3] * rinv * gg0[3]); o4.z = pk2(y[4] * rinv * gg1[0], y[5] * rinv * gg1[1]); o4.w = pk2(y[6] * rinv * gg1[2], y[7] * rinv * gg1[3]);
        *(u32x4*)(cat + row * DMIX + DA + g * 256 + r * 8) = o4;
    }
    __syncthreads();
}

#ifndef MIX_GMLP_MFMA
#define MIX_GMLP_MFMA 1
#endif
#ifndef MIX_SSDA_MFMA
#define MIX_SSDA_MFMA 1
#endif
#ifndef MIX_SSDC_MFMA
#define MIX_SSDC_MFMA 1
#endif

__device__ __forceinline__ void phase_mix_a(const Ctx& c) {
    if (MIX_GMLP_MFMA && (c.nb % NGA) == 0 && (NCH * NGA) % c.nb == 0) {
        gmlp_items(c, c.bid & 15, c.bid >> 4, c.nb >> 4, (NCH * NGA) / c.nb);
    } else {
        for (int it = c.bid; it < NCH * NGA; it += c.nb) gmlp_item(c, it >> 4, it & 15);
    }
    for (int it = c.bid; it < NCH * NGRP; it += c.nb) { if (MIX_SSDA_MFMA) ssd_a_item_mfma(c, it >> 3, it & 7); else ssd_a_item(c, it >> 3, it & 7); }
}

__device__ __forceinline__ void phase_scan(const Ctx& c) {
    unsigned* st = (unsigned*)(c.ws + WS_ST); const float* cdec = (const float*)(c.ws + WS_CDEC);
    for (int e = c.bid * 512 + c.tid; e < 32 * 64 * 64; e += c.nb * 512) {
        const int head = e >> 12; float h0 = 0.f, h1 = 0.f;
#pragma unroll 8
        for (int ck = 0; ck < NCH; ++ck) { const size_t idx = (size_t)ck * (32 * 64 * 64) + e; const unsigned w = st[idx]; const float dc = cdec[ck * 32 + head];
            st[idx] = pk2(h0, h1); h0 = dc * h0 + bflo(w); h1 = dc * h1 + bfhi(w); }
    }
    bf16_t* uv = (bf16_t*)(c.ws + WS_UV); const float* sq = (const float*)(c.ws + WS_SSQA);
    for (int i = c.bid * 512 + c.tid; i < S * (DA / 8); i += c.nb * 512) { const int row = i >> 8, ch = i & 255;
        const f32x4 q0 = *(const f32x4*)(sq + row * 16), q1 = *(const f32x4*)(sq + row * 16 + 4), q2 = *(const f32x4*)(sq + row * 16 + 8), q3 = *(const f32x4*)(sq + row * 16 + 12);
        float s = 0.f;
#pragma unroll
        for (int e = 0; e < 4; ++e) s += q0[e] + q1[e] + q2[e] + q3[e];
        const float rinv = 1.0f / sqrtf(s * (1.0f / DA) + EPS);
        u32x4* pp = (u32x4*)(uv + (size_t)row * DMIX + ch * 8); const u32x4 w = *pp; u32x4 o;
        o.x = pk2(bflo(w.x) * rinv, bfhi(w.x) * rinv); o.y = pk2(bflo(w.y) * rinv, bfhi(w.y) * rinv); o.z = pk2(bflo(w.z) * rinv, bfhi(w.z) * rinv); o.w = pk2(bflo(w.w) * rinv, bfhi(w.w) * rinv);
        *pp = o; }
}

__device__ __forceinline__ void ssd_c_item(const Ctx& c, int ck, int g) {
    LAS float* sdt = (LAS float*)(c.lds + L_SDT); LAS float* sacs = (LAS float*)(c.lds + L_SACS); LAS float* part = (LAS float*)(c.lds + L_SW);
    ssd_tables(c, ck, g, sdt, sacs);
    stage_conv_tile<256>(c, c.lds + L_XS, XS_PITCH, g * 256, ck * 128, nullptr);
    stage_conv_tile<128>(c, c.lds + L_B, BC_PITCH, DSSM + g * 128, ck * 128, nullptr);
    stage_conv_tile<128>(c, c.lds + L_C, BC_PITCH, DSSM + NGRP * NST + g * 128, ck * 128, nullptr);
    __syncthreads();
    float* G = (float*)(c.ws + WS_GSCR) + (size_t)c.bid * 16384;
    for (int o = c.tid; o < 16384; o += 512) { const int s = o & 127, l = o >> 7; float a = 0.f;
        if (s <= l) for (int n = 0; n < 128; ++n) a += bf2f(*(LAS bf16_t*)(c.lds + L_C + l * BC_PITCH + n * 2)) * bf2f(*(LAS bf16_t*)(c.lds + L_B + s * BC_PITCH + n * 2));
        __hip_atomic_store(G + o, a, __ATOMIC_RELAXED, __HIP_MEMORY_SCOPE_AGENT); }
    asm volatile("s_waitcnt vmcnt(0)" ::: "memory");
    __syncthreads();
    const bf16_t* hin = (const bf16_t*)(c.ws + WS_ST) + (size_t)(ck * 32 + g * 4) * 64 * 128;
    const bf16_t* zs = (const bf16_t*)(c.ws + WS_ZS); bf16_t* cat = (bf16_t*)(c.ws + WS_UV); const float* dsk = c.in[13]; const float* ng = c.in[14];
    const int hp = c.tid & 255, h = hp >> 6; const float Dh = dsk[g * 4 + h];
    for (int j = 0; j < 64; ++j) { const int l = (c.tid >> 8) + 2 * j; const float al = sacs[l * 4 + h];
        float y = 0.f;
        for (int s = 0; s <= l; ++s) y += __hip_atomic_load(G + l * 128 + s, __ATOMIC_RELAXED, __HIP_MEMORY_SCOPE_AGENT) * __expf(al - sacs[s * 4 + h]) * sdt[s * 4 + h] * bf2f(*(LAS bf16_t*)(c.lds + L_XS + s * XS_PITCH + hp * 2));
        float yo = 0.f;
        for (int n = 0; n < 128; ++n) yo += bf2f(*(LAS bf16_t*)(c.lds + L_C + l * BC_PITCH + n * 2)) * bf2f(hin[hp * 128 + n]);
        y += __expf(al) * yo + Dh * bf2f(*(LAS bf16_t*)(c.lds + L_XS + l * XS_PITCH + hp * 2));
        const size_t row = (size_t)ck * 128 + l;
        y *= bf2f(zs[row * DSSM + g * 256 + hp]);
        const float q = wave_sum(y * y);
        if (c.lane == 0) part[l * 4 + (c.wave & 3)] = q;
        cat[row * DMIX + DA + g * 256 + hp] = (bf16_t)f2bf(y);
    }
    __syncthreads();
    for (int j = 0; j < 64; ++j) { const int l = (c.tid >> 8) + 2 * j; const size_t row = (size_t)ck * 128 + l;
        const float rinv = 1.0f / sqrtf(((part[l * 4] + part[l * 4 + 1]) + (part[l * 4 + 2] + part[l * 4 + 3])) * (1.0f / 256.0f) + EPS);
        bf16_t* pp = cat + row * DMIX + DA + g * 256 + hp;
        *pp = (bf16_t)f2bf(bf2f(*pp) * rinv * ng[g * 256 + hp]); }
    __syncthreads();
}

__device__ __forceinline__ void phase_mix_c(const Ctx& c) {
    for (int it = c.bid; it < NCH * NGRP; it += c.nb) { if (MIX_SSDC_MFMA) ssd_c_item_mfma(c, it >> 3, it & 7); else ssd_c_item(c, it >> 3, it & 7); }
}

__device__ __forceinline__ void phase_final(const Ctx& c) {
    const int gw = c.bid * 8 + c.wave, NGW = c.nb * 8; const float* g = c.in[24]; const float* sq = (const float*)(c.ws + WS_SSQ3);
    for (int m = gw; m < S; m += NGW) {
        const f32x4 q0 = *(const f32x4*)(sq + (size_t)m * 8), q1 = *(const f32x4*)(sq + (size_t)m * 8 + 4);
        const float rinv = 1.0f / sqrtf(((q0[0] + q0[1]) + (q0[2] + q0[3]) + (q1[0] + q1[1]) + (q1[2] + q1[3])) * (1.0f / D) + EPS);
        float* orow = c.out + (size_t)m * D + 4 * c.lane;
#pragma unroll
        for (int j = 0; j < 8; ++j) { const f32x4 v = *(const f32x4*)(orow + 256 * j), gg = *(const f32x4*)(g + 4 * c.lane + 256 * j); *(f32x4*)(orow + 256 * j) = v * rinv * gg; }
    }
}

#define XB_TMO      128
#define XB_XCNT(j)  (256  + 64 * (j))
#define XB_XSUB(j)  (1280 + 64 * (j))
#define XB_XGEN(j)  (2304 + 64 * (j))
#define XB_TOP      3328
#define XB_TOPGEN   3392
#define XCD_BAR_WORDS 3456
#define XB_SPIN_CAP (1u << 20)
__device__ __forceinline__ unsigned xb_ld(unsigned* p)              { return __hip_atomic_load(p, __ATOMIC_RELAXED, __HIP_MEMORY_SCOPE_AGENT); }
__device__ __forceinline__ unsigned xb_add(unsigned* p, unsigned v) { return __hip_atomic_fetch_add(p, v, __ATOMIC_RELAXED, __HIP_MEMORY_SCOPE_AGENT); }
__device__ __forceinline__ unsigned xb_xcc_id() { return (unsigned)__builtin_amdgcn_s_getreg((3 << 11) | 20) & 0xFu; }
#define XB_SPIN(cond, bar) do { unsigned _sp = 0; while (cond) { __builtin_amdgcn_s_sleep(1); \
    if ((++_sp & 255u) == 0u) { if (xb_ld(&(bar)[XB_TMO])) break; if (_sp > XB_SPIN_CAP) { atomicAdd(&(bar)[XB_TMO], 1u); break; } } } } while (0)
struct XcdBarrier { unsigned* bar; unsigned x; volatile LAS unsigned* st; };
__device__ __forceinline__ XcdBarrier xcd_barrier_post(unsigned* bar, volatile LAS unsigned* st) {
    XcdBarrier b; b.bar = bar; b.x = xb_xcc_id(); b.st = st;
    if (threadIdx.x == 0) (void)xb_add(&bar[XB_XCNT(b.x)], 1u);
    return b;
}
__device__ __forceinline__ void xcd_barrier_complete(unsigned* bar, unsigned x, unsigned& nloc, unsigned& nx) {
    const unsigned G = gridDim.x * gridDim.y * gridDim.z;
    unsigned sum, cnt, mine, sp = 0u;
    for (;;) {
        sum = 0u; cnt = 0u; mine = 0u;
#pragma unroll
        for (unsigned j = 0; j < 16; ++j) { const unsigned c = xb_ld(&bar[XB_XCNT(j)]); sum += c; cnt += (c > 0u) ? 1u : 0u; mine = (j == x) ? c : mine; }
        if (sum == G) break;
        __builtin_amdgcn_s_sleep(1);
        if ((++sp & 255u) == 0u) { if (xb_ld(&bar[XB_TMO])) break; if (sp > XB_SPIN_CAP) { atomicAdd(&bar[XB_TMO], 1u); break; } }
    }
    nloc = mine > 0u ? mine : 1u; nx = cnt > 0u ? cnt : 1u;
}
__device__ __forceinline__ void xcd_barrier(const XcdBarrier& b) {
    asm volatile("s_waitcnt vmcnt(0)" ::: "memory");
    __syncthreads();
    if (threadIdx.x == 0) {
        unsigned* bar = b.bar;
        __builtin_amdgcn_s_waitcnt(0);
        unsigned nloc = b.st[0], nx = b.st[1];
        if (nloc == 0u) { xcd_barrier_complete(bar, b.x, nloc, nx); b.st[0] = nloc; b.st[1] = nx; }
        const unsigned old = xb_add(&bar[XB_XSUB(b.x)], 1u);
        const unsigned gen = old / nloc;
        if (old + 1u == (gen + 1u) * nloc) {
            __builtin_amdgcn_fence(__ATOMIC_RELEASE, "agent");
            asm volatile("s_waitcnt vmcnt(0)" ::: "memory");
            const unsigned og = xb_add(&bar[XB_TOP], 1u);
            const unsigned tg = og / nx;
            if (og + 1u == (tg + 1u) * nx) xb_add(&bar[XB_TOPGEN], 1u);
            else XB_SPIN(xb_ld(&bar[XB_TOPGEN]) == tg, bar);
            __builtin_amdgcn_fence(__ATOMIC_ACQUIRE, "agent");
            xb_add(&bar[XB_XGEN(b.x)], 1u);
            asm volatile("s_waitcnt vmcnt(0)" ::: "memory");
        } else {
            XB_SPIN(xb_ld(&bar[XB_XGEN(b.x)]) == gen, bar);
            __builtin_amdgcn_fence(__ATOMIC_ACQUIRE, "agent");
            asm volatile("s_waitcnt vmcnt(0)" ::: "memory");
        }
    }
    __syncthreads();
}

__global__ void __launch_bounds__(512, 2) mega_fwd(Params P, int ph_lo, int ph_hi) {
    extern __shared__ __attribute__((aligned(16))) unsigned char lds_raw[];
    Ctx c;
    c.lds = (LAS unsigned char*)lds_raw; c.tid = threadIdx.x; c.lane = c.tid & 63; c.wave = __builtin_amdgcn_readfirstlane(c.tid >> 6);
    c.nb = gridDim.x; c.bid = blockIdx.x; c.in = P.in; c.out = P.out; c.ws = P.ws;
    unsigned char* ws = P.ws;
    volatile LAS unsigned* bst = (volatile LAS unsigned*)(c.lds + L_MISC);
    if (c.tid < 2) bst[c.tid] = 0u;
    __syncthreads();
    const XcdBarrier xbar = xcd_barrier_post((unsigned*)ws, bst);
#ifndef PH_MASK
#define PH_MASK 0x3ff
#endif
#define IN(k) (((PH_MASK >> (k)) & 1) && ph_lo <= (k) && (k) < ph_hi)
#ifndef CG_SEAM
#define CG_SEAM -1
#endif
#ifndef TPROBE
#define TPROBE -1
#endif
#ifndef TAMP
#define TAMP 4
#endif
    volatile LAS unsigned long long* tsl = (volatile LAS unsigned long long*)(c.lds + L_MISC + 64);
    if (TPROBE >= 0 && c.bid == 0 && c.tid == 0) tsl[0] = __builtin_amdgcn_s_memrealtime();
#define SEAM(k) do { if (IN(k) && IN((k) + 1)) { if ((k) == CG_SEAM) cg::this_grid().sync(); else xcd_barrier(xbar); } \
        if (TPROBE >= 0 && c.bid == 0 && c.tid == 0) tsl[(k) + 1] = __builtin_amdgcn_s_memrealtime(); } while (0)
    if (IN(0)) phase_prep(c);
    SEAM(0);
    if (IN(1)) {
        pg8::Gemm g{(const bf16_t*)(ws + WS_A), (const bf16_t*)(ws + WS_WIN), D}; pg8::StaticOrder So; So.init(32, 40, c.nb, c.bid);
        EpiProj E{(bf16_t*)(ws + WS_UV), (bf16_t*)(ws + WS_ZS), (bf16_t*)(ws + WS_XBC)};
        pg8::gemm_phase<EpiProj, true, true>(c.lds, g, So, E);
        phase_dt(c);
    }
    SEAM(1);
    if (IN(2)) phase_mix_a(c);
    SEAM(2);
    if (IN(3)) phase_scan(c);
    SEAM(3);
    if (IN(4)) phase_mix_c(c);
    SEAM(4);
    if (IN(5)) {
        { pg8::Gemm g{(const bf16_t*)(ws + WS_UV), (const bf16_t*)(ws + WS_WOUT), DMIX}; pg8::StaticOrder So; So.init(32, 8, c.nb, c.bid);
          EpiResid E{P.in[0], P.out, (bf16_t*)(ws + WS_HG), (bf16_t*)(ws + WS_HG) + (size_t)S * D, P.in[16], (float*)(ws + WS_SSQ1)};
          pg8::gemm_phase<EpiResid, false, true>(c.lds, g, So, E); }
        { pg8::Gemm g{(const bf16_t*)(ws + WS_P16), (const bf16_t*)(ws + WS_WPLE), DPLE}; pg8::StaticOrder So; So.init(32, 8, c.nb, c.bid);
          EpiPlain E{(bf16_t*)(ws + WS_E), D};
          pg8::gemm_phase<EpiPlain, true, true>(c.lds, g, So, E); }
    }
    SEAM(5);
    if (IN(6)) {
        pg8::Gemm g{(const bf16_t*)(ws + WS_HG), (const bf16_t*)(ws + WS_WUP), D}; pg8::StaticOrder So; So.init(34, 44, c.nb, c.bid);
        EpiFfn E{(bf16_t*)(ws + WS_ACT), (const float*)(ws + WS_SSQ1), P.in[18], P.in[19]};
        pg8::gemm_phase<EpiFfn, true, true>(c.lds, g, So, E);
    }
    SEAM(6);
    if (IN(7)) {
        pg8::Gemm g{(const bf16_t*)(ws + WS_ACT), (const bf16_t*)(ws + WS_WDN), DFF}; pg8::StaticOrder So; So.init(32, 8, c.nb, c.bid);
        EpiResid E{P.out, P.out, (bf16_t*)(ws + WS_H2G), nullptr, P.in[21], (float*)(ws + WS_SSQ2)};
        pg8::gemm_phase<EpiResid, false, true>(c.lds, g, So, E);
    }
    SEAM(7);
    if (IN(8)) {
        pg8::Gemm g{(const bf16_t*)(ws + WS_H2G), (const bf16_t*)(ws + WS_WPG), D}; pg8::StaticOrder So; So.init(32, 8, c.nb, c.bid);
        EpiPle E{P.out, (const bf16_t*)(ws + WS_E), (const float*)(ws + WS_SSQ2), (float*)(ws + WS_SSQ3)};
        pg8::gemm_phase<EpiPle, false, true>(c.lds, g, So, E);
    }
    SEAM(8);
    if (IN(9)) phase_final(c);
    if (TPROBE >= 0 && c.bid == 0) {
        asm volatile("s_waitcnt vmcnt(0)" ::: "memory"); __syncthreads();
        if (c.tid == 0) { tsl[10] = __builtin_amdgcn_s_memrealtime(); const unsigned long long d = (tsl[TPROBE + 1] - tsl[TPROBE]) * TAMP; const unsigned long long t0 = __builtin_amdgcn_s_memrealtime();
            while (__builtin_amdgcn_s_memrealtime() - t0 < d) __builtin_amdgcn_s_sleep(8); }
    }
#undef IN
#undef SEAM
}

extern "C" void kernel_launch(void* const* d_in, const int* in_sizes, int n_in, void* d_out, int out_size, void* d_ws, size_t ws_size, hipStream_t stream) {
    static int grid = 0;
    if (grid == 0) {
        if (n_in != 25 || out_size != S * D || ws_size < WS_END) { fprintf(stderr, "kernel_launch: unexpected shapes (n_in %d out %d ws %zu)\n", n_in, out_size, ws_size); grid = -1; return; }
        int dev = 0, cus = 0, per_cu = 0;
        (void)hipGetDevice(&dev); (void)hipDeviceGetAttribute(&cus, hipDeviceAttributeMultiprocessorCount, dev);
        if (hipFuncSetAttribute((const void*)mega_fwd, hipFuncAttributeMaxDynamicSharedMemorySize, LDS_BYTES) != hipSuccess) { fprintf(stderr, "kernel_launch: hipFuncSetAttribute failed\n"); grid = -1; return; }
        (void)hipOccupancyMaxActiveBlocksPerMultiprocessor(&per_cu, (const void*)mega_fwd, 512, LDS_BYTES);
        if (per_cu < 1) { fprintf(stderr, "kernel_launch: occupancy query says %d blocks/CU\n", per_cu); per_cu = 1; }
        (void)hipGetLastError();
        grid = cus;
        fprintf(stderr, "kernel_launch: grid %d (cus %d, per_cu %d)\n", grid, cus, per_cu);
    }
    if (grid < 0) return;
    if (hipMemsetAsync(d_ws, 0, 16384, stream) != hipSuccess) { fprintf(stderr, "kernel_launch: memset failed\n"); return; }
    Params P{};
    for (int i = 0; i < 25; ++i) P.in[i] = (const float*)d_in[i];
    P.out = (float*)d_out; P.ws = (unsigned char*)d_ws;
#if MK_LAUNCHES == 1
    int lo = 0, hi = NPH;
    void* args[] = {&P, &lo, &hi};
#if CG_SEAM >= 0
    hipError_t e = hipLaunchCooperativeKernel((const void*)mega_fwd, dim3(grid), dim3(512), args, LDS_BYTES, stream);
#else
    (void)args;
    hipLaunchKernelGGL(mega_fwd, dim3(grid), dim3(512), LDS_BYTES, stream, P, lo, hi);
    hipError_t e = hipPeekAtLastError();
#endif
    if (e != hipSuccess) fprintf(stderr, "kernel_launch: launch failed: %s\n", hipGetErrorString(e));
#else
    for (int k = 0; k < NPH; ++k) {
        int lo = k, hi = k + 1;
        void* args[] = {&P, &lo, &hi};
        hipError_t e = hipLaunchCooperativeKernel((const void*)mega_fwd, dim3(grid), dim3(512), args, LDS_BYTES, stream);
        if (e != hipSuccess) { fprintf(stderr, "kernel_launch: launch %d failed: %s\n", k, hipGetErrorString(e)); break; }
    }
#endif
}
```
